# Optimizing an MI355X kernel written in HIP

```python
import jax, jax.numpy as jnp
from jax import lax
import numpy as np

D_MODEL = 1024
BATCH = 4
SEQ = 8192
DEPTH = 1
DEC_BATCH = 8
DEC_SEQ = 32
PAST_LEN = 2048

CHUNK = 64
N_HEADS_ATT = 16
HEAD_DIM = 64
ATT_WIDTH = N_HEADS_ATT * HEAD_DIM
ATT_SCALE = HEAD_DIM ** -0.5
Q_BLOCK = 128
SSM_EXPAND = 2
D_INNER = SSM_EXPAND * D_MODEL
SSM_HEAD_DIM = 64
N_HEADS_SSM = D_INNER // SSM_HEAD_DIM
N_GROUPS = 8
D_STATE = 128
CONV_W = 4
CONV_DIM = D_INNER + 2 * N_GROUPS * D_STATE
D_FF = 4 * D_MODEL
D_PROJ = 3 * ATT_WIDTH + N_HEADS_ATT + D_INNER + CONV_DIM + N_HEADS_SSM + 2 * D_MODEL
EPS = 1e-6

kernel_name = 'fox_ssd_hybrid_stream_step'


def _rmsnorm(x, w):
    xf = x.astype(jnp.float32)
    y = xf * lax.rsqrt(jnp.mean(xf * xf, axis=-1, keepdims=True) + EPS)
    return (y * w.astype(jnp.float32)).astype(x.dtype)


def _split_proj(proj):
    sizes = (ATT_WIDTH, ATT_WIDTH, ATT_WIDTH, N_HEADS_ATT, D_INNER, CONV_DIM, N_HEADS_SSM, D_MODEL, D_MODEL)
    parts = []
    start = 0
    for s in sizes:
        parts.append(proj[..., start:start + s])
        start += s
    return parts


def _fox_attend(q, cq, qpos, k, v, ck, kpos):
    s = jnp.einsum('bqhd,bkhd->bhqk', q, k, preferred_element_type=jnp.float32) * ATT_SCALE
    bias = jnp.swapaxes(cq, 1, 2)[:, :, :, None] - jnp.swapaxes(ck, 1, 2)[:, :, None, :]
    mask = kpos[None, :] <= qpos[:, None]
    s = jnp.where(mask, s + bias, -jnp.inf)
    p = jax.nn.softmax(s, axis=-1)
    return jnp.einsum('bhqk,bkhd->bqhd', p.astype(v.dtype), v)


def _fox_prompt(q, k, v, logf):
    b, T, H, d = q.shape
    c = jnp.cumsum(logf, axis=1)
    pos = jnp.arange(T)
    nb = T // Q_BLOCK
    qs = q.reshape(b, nb, Q_BLOCK, H, d).swapaxes(0, 1)
    cs = c.reshape(b, nb, Q_BLOCK, H).swapaxes(0, 1)
    ps = pos.reshape(nb, Q_BLOCK)

    def blk(args):
        qb, cb, pb = args
        return _fox_attend(qb, cb, pb, k, v, c, pos)

    o = lax.map(blk, (qs, cs, ps))
    return o.swapaxes(0, 1).reshape(b, T, H, d)


def _causal_conv(xbc, conv_past, conv_w, conv_b):
    T = xbc.shape[1]
    xin = jnp.concatenate([conv_past.astype(xbc.dtype), xbc], axis=1)
    out = conv_b
    for i in range(CONV_W):
        out = out + xin[:, i:i + T] * conv_w[i]
    return jax.nn.silu(out), xin[:, T:]


def _ssd(x, dt, A, Bm, Cm, h0):
    b, T, H, P = x.shape
    G, N = Bm.shape[2], Bm.shape[3]
    R = H // G
    L = min(CHUNK, T)
    nc = T // L
    f32 = jnp.float32
    xc = x.astype(f32).reshape(b, nc, L, G, R, P)
    dtc = dt.astype(f32).reshape(b, nc, L, G, R)
    Bc = Bm.astype(f32).reshape(b, nc, L, G, N)
    Cc = Cm.astype(f32).reshape(b, nc, L, G, N)
    acum = jnp.cumsum(dtc * A.astype(f32).reshape(G, R), axis=2)
    tri = jnp.tril(jnp.ones((L, L), dtype=bool))[:, :, None, None]
    seg = acum[:, :, :, None] - acum[:, :, None, :]
    decay = jnp.exp(jnp.where(tri, seg, -jnp.inf))
    cb = jnp.einsum('bclgn,bcsgn->bclsg', Cc, Bc)
    m = cb[..., None] * decay * dtc[:, :, None]
    y_diag = jnp.einsum('bclsgr,bcsgrp->bclgrp', m, xc)
    w_state = jnp.exp(acum[:, :, -1:] - acum) * dtc
    states = jnp.einsum('bclgn,bclgrp->bcgrpn', Bc, xc * w_state[..., None])
    chunk_decay = jnp.exp(acum[:, :, -1])

    def step(h, inp):
        dec, st = inp
        return h * dec[..., None, None] + st, h

    h_last, h_prev = lax.scan(step, h0.astype(f32).reshape(b, G, R, P, N),
                              (jnp.moveaxis(chunk_decay, 1, 0), jnp.moveaxis(states, 1, 0)))
    h_prev = jnp.moveaxis(h_prev, 0, 1)
    y_off = jnp.einsum('bclgn,bcgrpn->bclgrp', Cc, h_prev) * jnp.exp(acum)[..., None]
    y = (y_diag + y_off).reshape(b, T, H, P)
    return y, h_last.reshape(b, H, P, N)


def _layer(x, past, params):
    (norm1_w, w_in, b_f, q_norm_w, k_norm_w, conv_w, conv_b, dt_bias, A_log, D_skip,
     ssm_norm_w, w_pa, w_pb, w_out, norm2_w, w_up, w_down) = params
    f32 = jnp.float32
    b, T, _ = x.shape
    xn = _rmsnorm(x, norm1_w)
    proj = xn @ w_in
    q, k, v, f_raw, z, xbc, dt_raw, g_att, g_ssm = _split_proj(proj)
    q = _rmsnorm(q.reshape(b, T, N_HEADS_ATT, HEAD_DIM), q_norm_w)
    k = _rmsnorm(k.reshape(b, T, N_HEADS_ATT, HEAD_DIM), k_norm_w)
    v = v.reshape(b, T, N_HEADS_ATT, HEAD_DIM)
    logf = jax.nn.log_sigmoid(f_raw.astype(f32) + b_f.astype(f32))
    if past is None:
        att = _fox_prompt(q, k, v, logf)
        conv_past = jnp.zeros((b, CONV_W - 1, CONV_DIM), x.dtype)
        h0 = jnp.zeros((b, N_HEADS_SSM, SSM_HEAD_DIM, D_STATE), f32)
    else:
        k_past, v_past, logf_past, conv_past, h0 = past
        n_past = k_past.shape[1]
        k_all = jnp.concatenate([k_past.astype(k.dtype), k], axis=1)
        v_all = jnp.concatenate([v_past.astype(v.dtype), v], axis=1)
        c_all = jnp.cumsum(jnp.concatenate([logf_past.astype(f32), logf], axis=1), axis=1)
        att = _fox_attend(q, c_all[:, n_past:], n_past + jnp.arange(T), k_all, v_all, c_all,
                          jnp.arange(n_past + T))
    xbc_c, conv_new = _causal_conv(xbc, conv_past, conv_w, conv_b)
    xs = xbc_c[..., :D_INNER]
    Bm = xbc_c[..., D_INNER:D_INNER + N_GROUPS * D_STATE].reshape(b, T, N_GROUPS, D_STATE)
    Cm = xbc_c[..., D_INNER + N_GROUPS * D_STATE:].reshape(b, T, N_GROUPS, D_STATE)
    dt = jax.nn.softplus(dt_raw.astype(f32) + dt_bias.astype(f32))
    A = -jnp.exp(A_log.astype(f32))
    xh = xs.reshape(b, T, N_HEADS_SSM, SSM_HEAD_DIM)
    y, h_new = _ssd(xh, dt, A, Bm, Cm, h0)
    y = y + xh.astype(f32) * D_skip.astype(f32)[:, None]
    y = y.reshape(b, T, D_INNER) * jax.nn.silu(z.astype(f32))
    yg = y.reshape(b, T, N_GROUPS, D_INNER // N_GROUPS)
    yg = yg * lax.rsqrt(jnp.mean(yg * yg, axis=-1, keepdims=True) + EPS)
    y_ssm = (yg.reshape(b, T, D_INNER) * ssm_norm_w.astype(f32)).astype(x.dtype)
    merged = (jax.nn.sigmoid(g_att) * (att.reshape(b, T, ATT_WIDTH) @ w_pa)
              + jax.nn.sigmoid(g_ssm) * (y_ssm @ w_pb))
    x = x + merged @ w_out
    h = _rmsnorm(x, norm2_w)
    x = x + jnp.square(jax.nn.relu(h @ w_up)) @ w_down
    new_state = (k, v, logf.astype(x.dtype), conv_new, h_new.astype(x.dtype))
    return x, new_state


def _stack(states, i):
    return jnp.stack([s[i] for s in states], axis=0)


def setup_inputs(seed: int = 0) -> dict:
    key = jax.random.key(seed)
    ks = jax.random.split(key, 32)
    f32 = jnp.float32

    def nrm(k, shape, scale):
        return jax.random.normal(k, shape, f32) * scale

    dt0 = jnp.exp(jax.random.uniform(ks[16], (DEPTH, N_HEADS_SSM), f32, np.log(1e-3), np.log(1e-1)))
    return {
        'x_prompt': nrm(ks[0], (BATCH, SEQ, D_MODEL), 1.0),
        'x_sample': nrm(ks[1], (DEC_BATCH, DEC_SEQ, D_MODEL), 1.0),
        'cache_k': nrm(ks[2], (DEPTH, DEC_BATCH, PAST_LEN, N_HEADS_ATT, HEAD_DIM), 1.0),
        'cache_v': nrm(ks[3], (DEPTH, DEC_BATCH, PAST_LEN, N_HEADS_ATT, HEAD_DIM), 1.0),
        'cache_logf': jax.nn.log_sigmoid(3.0 + nrm(ks[4], (DEPTH, DEC_BATCH, PAST_LEN, N_HEADS_ATT), 0.5)),
        'state_conv': nrm(ks[5], (DEPTH, DEC_BATCH, CONV_W - 1, CONV_DIM), 1.0),
        'state_ssm': nrm(ks[6], (DEPTH, DEC_BATCH, N_HEADS_SSM, SSM_HEAD_DIM, D_STATE), 0.1),
        'norm1_w': 1.0 + nrm(ks[7], (DEPTH, D_MODEL), 0.02),
        'w_in': nrm(ks[8], (DEPTH, D_MODEL, D_PROJ), D_MODEL ** -0.5),
        'b_f': 3.0 + nrm(ks[9], (DEPTH, N_HEADS_ATT), 0.3),
        'q_norm_w': 1.0 + nrm(ks[10], (DEPTH, HEAD_DIM), 0.02),
        'k_norm_w': 1.0 + nrm(ks[11], (DEPTH, HEAD_DIM), 0.02),
        'conv_w': nrm(ks[12], (DEPTH, CONV_W, CONV_DIM), 0.5),
        'conv_b': nrm(ks[13], (DEPTH, CONV_DIM), 0.02),
        'dt_bias': dt0 + jnp.log(-jnp.expm1(-dt0)),
        'A_log': jnp.log(jax.random.uniform(ks[14], (DEPTH, N_HEADS_SSM), f32, 1.0, 16.0)),
        'D_skip': 1.0 + nrm(ks[15], (DEPTH, N_HEADS_SSM), 0.1),
        'ssm_norm_w': 1.0 + nrm(ks[17], (DEPTH, D_INNER), 0.02),
        'w_pa': nrm(ks[18], (DEPTH, ATT_WIDTH, D_MODEL), ATT_WIDTH ** -0.5),
        'w_pb': nrm(ks[19], (DEPTH, D_INNER, D_MODEL), D_INNER ** -0.5),
        'w_out': nrm(ks[20], (DEPTH, D_MODEL, D_MODEL), D_MODEL ** -0.5),
        'norm2_w': 1.0 + nrm(ks[21], (DEPTH, D_MODEL), 0.02),
        'w_up': nrm(ks[22], (DEPTH, D_MODEL, D_FF), D_MODEL ** -0.5),
        'w_down': nrm(ks[23], (DEPTH, D_FF, D_MODEL), D_FF ** -0.5),
    }


def reference(x_prompt, x_sample, cache_k, cache_v, cache_logf, state_conv, state_ssm,
              norm1_w, w_in, b_f, q_norm_w, k_norm_w, conv_w, conv_b, dt_bias, A_log, D_skip,
              ssm_norm_w, w_pa, w_pb, w_out, norm2_w, w_up, w_down):
    yp = x_prompt
    ys = x_sample
    states_p = []
    states_s = []
    for l in range(DEPTH):
        params = (norm1_w[l], w_in[l], b_f[l], q_norm_w[l], k_norm_w[l], conv_w[l], conv_b[l],
                  dt_bias[l], A_log[l], D_skip[l], ssm_norm_w[l], w_pa[l], w_pb[l], w_out[l],
                  norm2_w[l], w_up[l], w_down[l])
        yp, st_p = _layer(yp, None, params)
        ys, st_s = _layer(ys, (cache_k[l], cache_v[l], cache_logf[l], state_conv[l], state_ssm[l]), params)
        states_p.append(st_p)
        states_s.append(st_s)
    k_prompt = _stack(states_p, 0)
    v_prompt = _stack(states_p, 1)
    logf_prompt = _stack(states_p, 2)
    conv_prompt = _stack(states_p, 3)
    ssm_prompt = _stack(states_p, 4)
    k_sample = _stack(states_s, 0)
    v_sample = _stack(states_s, 1)
    logf_sample = _stack(states_s, 2)
    conv_sample = _stack(states_s, 3)
    ssm_sample = _stack(states_s, 4)
    return (yp, ys, k_prompt, v_prompt, logf_prompt, conv_prompt, ssm_prompt,
            k_sample, v_sample, logf_sample, conv_sample, ssm_sample)
```

```cpp
#include <hip/hip_runtime.h>
#include <hip/hip_cooperative_groups.h>
#include <cstdio>
#include <cstdint>
#include <cmath>
namespace cg = cooperative_groups;
namespace pg8 {
#define PG8_LAS __attribute__((address_space(3)))
typedef unsigned short bf16_t;
typedef short bf16x8 __attribute__((ext_vector_type(8)));
typedef float f32x4 __attribute__((ext_vector_type(4)));
typedef unsigned u32x4 __attribute__((ext_vector_type(4)));
constexpr int BM = 256, BK = 64, HALF = 128, HTB = HALF * BK * 2  , STAGE_BYTES = 8 * HTB, NXCD = 8, WGM = 8;

__host__ __device__ __forceinline__ int lds_byte(int r, int c) { const int st = (r >> 4) * 2 + (c >> 5), rr = r & 15, cc = c & 31, ob = rr * 64 + cc * 2; return st * 1024 + (ob ^ (((ob >> 9) & 1) << 5)); }
__host__ __device__ __forceinline__ void stage_rc(int b, int& R, int& C) { const int st = b / 1024, sb = b % 1024, swz = sb ^ (((sb >> 9) & 1) << 5); R = (st >> 1) * 16 + swz / 64; C = (st & 1) * 32 + (swz % 64) / 2; }
__host__ __device__ __forceinline__ int perm32(int rho) { const int n = rho >> 4, i = rho & 15; return 8 * (i >> 2) + 4 * n + (i & 3); }

struct Unit { int pm, pn; };
struct Gemm { const bf16_t* A; const bf16_t* Bt; int M, N, K; };

struct StaticOrder {
    int nM, nN, nwg, G, c;
    __host__ __device__ void init(int M, int N, int G_, int c_) { nM = M / BM; nN = N / BM; nwg = nM * nN; G = G_; c = c_; }
    __host__ __device__ bool next(int i, Unit& u) const {
        const long L = (long)i * G + c; if (L >= nwg) return false;
        int wgid = (int)L; { const int q = nwg / NXCD, r = nwg % NXCD, xcd = wgid % NXCD, off = wgid / NXCD; wgid = (xcd < r ? xcd * (q + 1) : r * (q + 1) + (xcd - r) * q) + off; }
        const int nig = WGM * nN, gid = wgid / nig, fm = gid * WGM, gsz = (nM - fm) < WGM ? (nM - fm) : WGM;
        u.pm = fm + ((wgid % nig) % gsz); u.pn = (wgid % nig) / gsz; return true;
    }
    __device__ __forceinline__ void a_ready(const Unit&) const {}
    __device__ __forceinline__ void done(const Unit&) const {}
};

__device__ __forceinline__ unsigned cvt_pk_bf16(float lo, float hi) { unsigned r; asm volatile("v_cvt_pk_bf16_f32 %0, %1, %2" : "=v"(r) : "v"(lo), "v"(hi)); return r; }
typedef float f32x2 __attribute__((ext_vector_type(2)));
template <class Epi, class Sched, bool ALIGN_EPI = false, bool SP2 = false>
__device__ __forceinline__ void gemm_phase(PG8_LAS unsigned char* lds, const Gemm g, const Sched& S, const Epi& E) {
    const int tid = threadIdx.x, wid = __builtin_amdgcn_readfirstlane(tid >> 6), lane = tid & 63, wr = wid >> 2, wc = wid & 3, fr = lane & 15, fq = lane >> 4;
    const int K = g.K, nt = K / BK;
    unsigned voffA[2], voffB[2];
#pragma unroll
    for (int i = 0; i < 2; ++i) { int R, C; stage_rc(tid * 16 + i * 8192, R, C); const int Rb = Epi::PERM ? ((R & ~31) + perm32(R & 31)) : R;
        voffA[i] = (unsigned)(R * K + C) * 2u; voffB[i] = (unsigned)(Rb * K + C) * 2u; }
    const size_t kstep = (size_t)(BK * 2);
    const size_t hstep = (size_t)HALF * K * 2;
    const size_t tstep = 2 * hstep;
    const unsigned ldsw = (unsigned)wid * 1024u;
    const int aoff = lds_byte(wr * 64 + fr, fq * 8), boff = lds_byte(wc * 32 + fr, fq * 8);
#define PG8_SA(b, h) (((b) * 2 + (h)) * HTB)
#define PG8_SB(b, h) ((4 + (b) * 2 + (h)) * HTB)
#define PG8_STAGE(bufoff, gbase, voff) do { _Pragma("unroll") for (int _i = 0; _i < 2; ++_i) \
        __builtin_amdgcn_global_load_lds((const unsigned*)((const char*)(gbase) + (voff)[_i]), (PG8_LAS unsigned*)(lds + (bufoff) + ldsw + _i * 8192), 16, 0, 0); } while (0)
#define PG8_LDA(dst, b, h) do { _Pragma("unroll") for (int m = 0; m < 4; ++m) _Pragma("unroll") for (int k = 0; k < 2; ++k) dst[m][k] = *(const PG8_LAS bf16x8*)(lds + PG8_SA(b, h) + aoff + m * 2048 + k * 1024); } while (0)
#define PG8_LDB(dst, b, h) do { _Pragma("unroll") for (int n = 0; n < 2; ++n) _Pragma("unroll") for (int k = 0; k < 2; ++k) dst[n][k] = *(const PG8_LAS bf16x8*)(lds + PG8_SB(b, h) + boff + n * 2048 + k * 1024); } while (0)
#define PG8_MMA(ai, bj, At, Bt) do { __builtin_amdgcn_s_setprio(1); _Pragma("unroll") for (int m = 0; m < 4; ++m) _Pragma("unroll") for (int n = 0; n < 2; ++n) _Pragma("unroll") for (int k = 0; k < 2; ++k) \
        acc[ai][bj][m][n] = __builtin_amdgcn_mfma_f32_16x16x32_bf16(Bt[n][k], At[m][k], acc[ai][bj][m][n], 0, 0, 0); __builtin_amdgcn_s_setprio(0); } while (0)
#define PG8_WAIT_V(n) asm volatile("s_waitcnt vmcnt(" #n ")" ::: "memory")
#define PG8_WAIT_L(n) asm volatile("s_waitcnt lgkmcnt(" #n ")" ::: "memory")
#define PG8_BAR __builtin_amdgcn_s_barrier()
#define PG8_SCHED __builtin_amdgcn_sched_barrier(0)
    Unit cur, nxt; int ui = 0;
    if (!S.next(0, cur)) return;
    f32x4 acc[2][2][4][2];
#pragma unroll
    for (int a = 0; a < 2; ++a)
#pragma unroll
        for (int b = 0; b < 2; ++b)
#pragma unroll
            for (int m = 0; m < 4; ++m)
#pragma unroll
                for (int n = 0; n < 2; ++n) acc[a][b][m][n] = (f32x4){0.f, 0.f, 0.f, 0.f};
    bf16x8 At[4][2], B0[2][2], B1[2][2];
    const char* cA = (const char*)g.A + (size_t)cur.pm * tstep; const char* cB = (const char*)g.Bt + (size_t)cur.pn * tstep;
    S.a_ready(cur);
    if constexpr (SP2) {
        PG8_STAGE(PG8_SB(0, 0), cB, voffB); PG8_STAGE(PG8_SB(0, 1), cB + hstep, voffB); PG8_STAGE(PG8_SA(0, 0), cA, voffA); PG8_STAGE(PG8_SA(0, 1), cA + hstep, voffA);
        if (wr == 1) PG8_BAR;
        PG8_WAIT_V(2); PG8_BAR;
        PG8_STAGE(PG8_SB(1, 0), cB + kstep, voffB); PG8_STAGE(PG8_SA(1, 0), cA + kstep, voffA); PG8_STAGE(PG8_SB(1, 1), cB + hstep + kstep, voffB);
        PG8_WAIT_V(6); PG8_BAR;
    } else {
        PG8_STAGE(PG8_SB(0, 0), cB, voffB); PG8_STAGE(PG8_SA(0, 0), cA, voffA); PG8_STAGE(PG8_SB(0, 1), cB + hstep, voffB); PG8_STAGE(PG8_SA(0, 1), cA + hstep, voffA);
        if (wr == 1) PG8_BAR;
        PG8_WAIT_V(4); PG8_BAR;
        PG8_STAGE(PG8_SB(1, 0), cB + kstep, voffB); PG8_STAGE(PG8_SA(1, 0), cA + kstep, voffA); PG8_STAGE(PG8_SB(1, 1), cB + hstep + kstep, voffB);
        PG8_WAIT_V(6); PG8_BAR;
    }
    for (;;) {
        const bool has_next = S.next(ui + 1, nxt);
        const char* nA = has_next ? (const char*)g.A + (size_t)nxt.pm * tstep : cA; const char* nB = has_next ? (const char*)g.Bt + (size_t)nxt.pn * tstep : cB;
        for (int t = 0; t < nt; t += 2) {
            const bool last = (t == nt - 2);
            const char* a1 = cA + (size_t)(t + 1) * kstep;
            const char* a2 = last ? nA : cA + (size_t)(t + 2) * kstep; const char* b2 = last ? nB : cB + (size_t)(t + 2) * kstep;
            const char* a3 = a2 + kstep; const char* b3 = b2 + kstep;
            if (last && has_next) S.a_ready(nxt);
            if constexpr (SP2) {
            PG8_LDB(B0, 0, 0); PG8_LDB(B1, 0, 1); PG8_SCHED; PG8_LDA(At, 0, 0); PG8_STAGE(PG8_SA(1, 1), a1 + hstep, voffA);
            PG8_WAIT_V(8); PG8_WAIT_L(0); PG8_BAR; PG8_MMA(0, 0, At, B0); PG8_MMA(0, 1, At, B1); PG8_BAR; PG8_SCHED;
            PG8_LDA(At, 0, 1); PG8_STAGE(PG8_SB(0, 0), b2, voffB); PG8_STAGE(PG8_SB(0, 1), b2 + hstep, voffB); PG8_STAGE(PG8_SA(0, 0), a2, voffA);
            PG8_WAIT_V(8); PG8_WAIT_L(0); PG8_BAR; PG8_MMA(1, 0, At, B0); PG8_MMA(1, 1, At, B1); PG8_BAR; PG8_SCHED;
            PG8_LDB(B0, 1, 0); PG8_LDB(B1, 1, 1); PG8_SCHED; PG8_LDA(At, 1, 0); PG8_STAGE(PG8_SA(0, 1), a2 + hstep, voffA);
            PG8_WAIT_V(8); PG8_WAIT_L(0); PG8_BAR; PG8_MMA(0, 0, At, B0); PG8_MMA(0, 1, At, B1); PG8_BAR; PG8_SCHED;
            PG8_LDA(At, 1, 1); PG8_STAGE(PG8_SB(1, 0), b3, voffB); PG8_STAGE(PG8_SB(1, 1), b3 + hstep, voffB); PG8_STAGE(PG8_SA(1, 0), a3, voffA);
            PG8_WAIT_V(8); PG8_WAIT_L(0); PG8_BAR; PG8_MMA(1, 0, At, B0); PG8_MMA(1, 1, At, B1); PG8_BAR; PG8_SCHED;
            } else {
            PG8_LDB(B0, 0, 0); PG8_SCHED; PG8_LDA(At, 0, 0); PG8_STAGE(PG8_SA(1, 1), a1 + hstep, voffA);
            PG8_WAIT_L(8); PG8_BAR; PG8_WAIT_L(0); PG8_MMA(0, 0, At, B0); PG8_BAR; PG8_SCHED;
            PG8_LDB(B1, 0, 1); PG8_STAGE(PG8_SB(0, 0), b2, voffB);
            PG8_BAR; PG8_WAIT_L(0); PG8_MMA(0, 1, At, B1); PG8_BAR;
            PG8_LDA(At, 0, 1); PG8_STAGE(PG8_SA(0, 0), a2, voffA);
            PG8_BAR; PG8_WAIT_L(0); PG8_MMA(1, 0, At, B0); PG8_BAR; PG8_SCHED;
            PG8_STAGE(PG8_SB(0, 1), b2 + hstep, voffB);
            PG8_WAIT_V(6); PG8_BAR; PG8_MMA(1, 1, At, B1); PG8_BAR;
            PG8_LDB(B0, 1, 0); PG8_SCHED; PG8_LDA(At, 1, 0); PG8_STAGE(PG8_SA(0, 1), a2 + hstep, voffA);
            PG8_WAIT_L(8); PG8_BAR; PG8_WAIT_L(0); PG8_MMA(0, 0, At, B0); PG8_BAR; PG8_SCHED;
            PG8_LDB(B1, 1, 1); PG8_STAGE(PG8_SB(1, 0), b3, voffB);
            PG8_BAR; PG8_WAIT_L(0); PG8_MMA(0, 1, At, B1); PG8_BAR;
            PG8_LDA(At, 1, 1); PG8_STAGE(PG8_SA(1, 0), a3, voffA);
            PG8_BAR; PG8_WAIT_L(0); PG8_MMA(1, 0, At, B0); PG8_BAR; PG8_SCHED;
            PG8_STAGE(PG8_SB(1, 1), b3 + hstep, voffB);
            PG8_WAIT_V(6); PG8_BAR; PG8_MMA(1, 1, At, B1); PG8_BAR;
            }
        }
        if constexpr (ALIGN_EPI) { if (wr == 0) PG8_BAR; }
        if constexpr (!Epi::AFTER_DRAIN) { E(acc, cur, wr, wc, fr, fq); S.done(cur); }
        if (!has_next) break;
#pragma unroll
        for (int a = 0; a < 2; ++a)
#pragma unroll
            for (int b = 0; b < 2; ++b)
#pragma unroll
                for (int m = 0; m < 4; ++m)
#pragma unroll
                    for (int n = 0; n < 2; ++n) acc[a][b][m][n] = (f32x4){0.f, 0.f, 0.f, 0.f};
        cur = nxt; cA = nA; cB = nB; ++ui;
        if constexpr (ALIGN_EPI) { if (wr == 1) PG8_BAR; }
    }
    PG8_WAIT_V(0);
    if constexpr (!ALIGN_EPI) { if (wr == 0) PG8_BAR; }
    PG8_BAR;
    if constexpr (Epi::AFTER_DRAIN) { E.fused(acc, cur, wr, wc, fr, fq, lds, wid, lane); S.done(cur); }
#undef PG8_SA
#undef PG8_SB
#undef PG8_STAGE
#undef PG8_LDA
#undef PG8_LDB
#undef PG8_MMA
#undef PG8_WAIT_V
#undef PG8_WAIT_L
#undef PG8_BAR
#undef PG8_SCHED
}
}

#ifndef MK_MULTI
#define MK_MULTI 0
#endif
#define LAS __attribute__((address_space(3)))
typedef unsigned short bf16;
typedef short bf16x8 __attribute__((ext_vector_type(8)));
typedef short s16x4 __attribute__((ext_vector_type(4)));
typedef float f32x4 __attribute__((ext_vector_type(4)));
typedef float f32x16 __attribute__((ext_vector_type(16)));
typedef unsigned u32x4 __attribute__((ext_vector_type(4)));
typedef unsigned u32x2 __attribute__((ext_vector_type(2)));

constexpr int DM = 1024, TP = 8192, NBP = 4, NBS = 8, TS = 32, PAST = 2048, MP = NBP * TP, MS = NBS * TS, MT = MP + MS;
constexpr int NH = 16, DI = 2048, NHS = 32, DST = 128, CONVD = 4096, DPROJ = 11312, FF = 4096, NWIN = 11520, SKV = PAST + TS;
constexpr float EPS = 1e-6f, LOG2E = 1.4426950408889634f, QSCALE = 0.125f * LOG2E;
constexpr size_t O_Y = 0, O_KP = (size_t)MT * DM, O_VP = O_KP + (size_t)MP * DM, O_LP = O_VP + (size_t)MP * DM, O_CP = O_LP + (size_t)MP * NH,
                 O_SP = O_CP + (size_t)NBP * 3 * CONVD, O_KS = O_SP + (size_t)NBP * NHS * 64 * DST, O_VS = O_KS + (size_t)MS * DM, O_LS = O_VS + (size_t)MS * DM,
                 O_CS = O_LS + (size_t)MS * NH, O_SS = O_CS + (size_t)NBS * 3 * CONVD, O_END = O_SS + (size_t)NBS * NHS * 64 * DST;
static_assert(O_END == 105271296, "d_out map");
constexpr size_t MiB = 1u << 20, U1 = (size_t)MT * DM * 2;
constexpr size_t WS_WIN = 1 * MiB, WS_WPA = 24 * MiB, WS_WPB = 26 * MiB, WS_WOUT = 30 * MiB, WS_WUP = 32 * MiB, WS_WDN = 40 * MiB;
constexpr size_t WS_LOGF = 48 * MiB, WS_CUMP = 51 * MiB, WS_CUMS = 53 * MiB, WS_DT = 55 * MiB, WS_SEGDEC = 59 * MiB + MiB / 2;
constexpr size_t WS_QS = 64 * 1024, WS_KS = 23 * MiB + MiB / 2, WS_VS = 50 * MiB + MiB / 4, WS_SGAS = 54 * MiB + MiB / 4, WS_SGSS = 511 * MiB + MiB / 2;
constexpr size_t WS_XN = 60 * MiB, WS_BIG = WS_XN + U1, WS_SG = WS_BIG + 4 * U1, WS_END = WS_SG + 2 * U1 + MiB / 2;
static_assert(WS_END <= 512 * MiB, "d_ws map");
constexpr int LDS_BYTES = 147456;

struct Args {
    const float *x_prompt, *x_sample, *cache_k, *cache_v, *cache_logf, *state_conv, *state_ssm, *norm1_w, *w_in, *b_f, *q_norm_w, *k_norm_w, *conv_w, *conv_b,
        *dt_bias, *A_log, *D_skip, *ssm_norm_w, *w_pa, *w_pb, *w_out, *norm2_w, *w_up, *w_down;
    float* out; unsigned char* ws; int ph_lo, ph_hi, coop, pad;
};

__device__ __forceinline__ unsigned f2bf(float f) { unsigned u = __builtin_bit_cast(unsigned, f); return (u + 0x7fffu + ((u >> 16) & 1u)) >> 16; }
typedef float f32x2_t __attribute__((ext_vector_type(2))); typedef __bf16 bf16x2_t __attribute__((ext_vector_type(2)));
__device__ __forceinline__ unsigned pk2(float lo, float hi) { f32x2_t v = {lo, hi}; bf16x2_t b = __builtin_convertvector(v, bf16x2_t); return __builtin_bit_cast(unsigned, b); }
__device__ __forceinline__ float bflo(unsigned w) { return __uint_as_float(w << 16); }
__device__ __forceinline__ float bfhi(unsigned w) { return __uint_as_float(w & 0xffff0000u); }
__device__ __forceinline__ float bf2f(bf16 v) { return __uint_as_float(((unsigned)v) << 16); }
__device__ __forceinline__ float wave_sum(float v) {
#pragma unroll
    for (int o = 1; o < 64; o <<= 1) v += __shfl_xor(v, o);
    return v;
}
__device__ __forceinline__ float sigmoidf_(float x) { return __builtin_amdgcn_rcpf(1.f + __expf(-x)); }
__device__ __forceinline__ float softplusf_(float x) { return fmaxf(x, 0.f) + __logf(1.f + __expf(-fabsf(x))); }
__device__ __forceinline__ const float* xrow_ptr(const Args& a, int m) { return m < MP ? a.x_prompt + (size_t)m * DM : a.x_sample + (size_t)(m - MP) * DM; }

__device__ __forceinline__ int win_src_col(int n) {
    if (n < 2048) return 3088 + n;
    if (n < 6144) return 5136 + (n - 2048);
    if (n < 6400) { const int j = n - 6144; if (j < 16) return 3072 + j; if (j < 48) return 9232 + (j - 16); return -1; }
    if (n < 8448) { int p = n - 6400; const int isk = p >= 1024; p &= 1023; const int tq = p >> 8, pp = p & 255, bj = pp >> 7, wc = (pp & 127) >> 5, e = pp & 31;
                    return (isk ? 1024 : 0) + (4 * tq + wc) * 64 + 32 * bj + e; }
    if (n < 9472) return 2048 + (n - 8448);
    if (n < 10496) return 9264 + (n - 9472);
    return 10288 + (n - 10496);
}
__device__ __forceinline__ void wt_item(const float* __restrict__ W, int K, int N, bf16* WT, int nblk, int item, bool is_win, int tid) {
    const int nb = item % nblk, kb = item / nblk, n = nb * 64 + (tid & 63), k0 = kb * 64 + (tid >> 6) * 8;
    const int sc = is_win ? win_src_col(n) : n;
    float v[8];
#pragma unroll
    for (int i = 0; i < 8; ++i) v[i] = sc >= 0 ? W[(size_t)(k0 + i) * N + sc] : 0.f;
    u32x4 o; o.x = pk2(v[0], v[1]); o.y = pk2(v[2], v[3]); o.z = pk2(v[4], v[5]); o.w = pk2(v[6], v[7]);
    *(u32x4*)(WT + (size_t)n * K + k0) = o;
}
__device__ __forceinline__ void rms_row_to_bf16(const float* xrow, const float* w, bf16* orow, int lane) {
    const f32x4* xr = (const f32x4*)xrow + lane; f32x4 v[4]; float s = 0.f;
#pragma unroll
    for (int j = 0; j < 4; ++j) { v[j] = xr[64 * j]; s += (v[j].x * v[j].x + v[j].y * v[j].y) + (v[j].z * v[j].z + v[j].w * v[j].w); }
    const float rstd = rsqrtf(wave_sum(s) * (1.f / DM) + EPS);
#pragma unroll
    for (int j = 0; j < 4; ++j) { const f32x4 wv = ((const f32x4*)w)[lane + 64 * j]; u32x2 o; o.x = pk2(v[j].x * rstd * wv.x, v[j].y * rstd * wv.y); o.y = pk2(v[j].z * rstd * wv.z, v[j].w * rstd * wv.w);
        *((u32x2*)orow + lane + 64 * j) = o; }
}
__device__ __forceinline__ void phase_prologue(const Args& a) {
    const int tid = threadIdx.x, lane = tid & 63, wid = tid >> 6, G = gridDim.x, bx = blockIdx.x;
    constexpr int I_WIN = (NWIN / 64) * (DM / 64), I_PA = 16 * 16, I_PB = 16 * 32, I_OUT = 16 * 16, I_UP = 64 * 16, I_DN = 16 * 64, NIT = I_WIN + I_PA + I_PB + I_OUT + I_UP + I_DN;
    for (int it = bx; it < NIT; it += G) {
        int r = it;
        if (r < I_WIN) { wt_item(a.w_in, DM, DPROJ, (bf16*)(a.ws + WS_WIN), NWIN / 64, r, true, tid); continue; } r -= I_WIN;
        if (r < I_PA) { wt_item(a.w_pa, DM, DM, (bf16*)(a.ws + WS_WPA), 16, r, false, tid); continue; } r -= I_PA;
        if (r < I_PB) { wt_item(a.w_pb, DI, DM, (bf16*)(a.ws + WS_WPB), 16, r, false, tid); continue; } r -= I_PB;
        if (r < I_OUT) { wt_item(a.w_out, DM, DM, (bf16*)(a.ws + WS_WOUT), 16, r, false, tid); continue; } r -= I_OUT;
        if (r < I_UP) { wt_item(a.w_up, DM, FF, (bf16*)(a.ws + WS_WUP), 64, r, false, tid); continue; } r -= I_UP;
        wt_item(a.w_down, FF, DM, (bf16*)(a.ws + WS_WDN), 16, r, false, tid);
    }
    bf16* XN = (bf16*)(a.ws + WS_XN);
    for (int m = bx * 8 + wid; m < MT; m += G * 8) rms_row_to_bf16(xrow_ptr(a, m), a.norm1_w, XN + (size_t)m * DM, lane);
}

#define EPI_ROW(u, ai, m) ((u).pm * 256 + (ai) * 128 + wr * 64 + (m) * 16 + fr)
#define EPI_CB(bj) ((bj) * 128 + wc * 32 + 8 * fq)
__device__ __forceinline__ u32x4 pack8(const f32x4 v0, const f32x4 v1) { u32x4 w; w.x = pk2(v0[0], v0[1]); w.y = pk2(v0[2], v0[3]); w.z = pk2(v1[0], v1[1]); w.w = pk2(v1[2], v1[3]); return w; }

struct EpiP1 {
    static constexpr bool PERM = true, AFTER_DRAIN = false;
    bf16* Z; bf16* XBC; float* logf_ws; float* dt_ws; float* out; const float* b_f; const float* dt_bias;
    __device__ __forceinline__ void operator()(const pg8::f32x4 (&acc)[2][2][4][2], const pg8::Unit& u, int wr, int wc, int fr, int fq) const {
        const int pn = u.pn;
        if (pn < 24) {
            bf16* base; int ldc, colt;
            if (pn < 8) { base = Z; ldc = DI; colt = pn * 256; } else { base = XBC; ldc = CONVD; colt = (pn - 8) * 256; }
#pragma unroll
            for (int ai = 0; ai < 2; ++ai)
#pragma unroll
                for (int m = 0; m < 4; ++m) { const int row = EPI_ROW(u, ai, m);
#pragma unroll
                    for (int bj = 0; bj < 2; ++bj) *(u32x4*)(base + (size_t)row * ldc + colt + EPI_CB(bj)) = pack8(acc[ai][bj][m][0], acc[ai][bj][m][1]);
                }
        } else if (wc < 2) {
#pragma unroll
            for (int ai = 0; ai < 2; ++ai)
#pragma unroll
                for (int m = 0; m < 4; ++m) { const int row = EPI_ROW(u, ai, m);
#pragma unroll
                    for (int n = 0; n < 2; ++n)
#pragma unroll
                        for (int i = 0; i < 4; ++i) { const int c = 32 * wc + 8 * fq + 4 * n + i; const float v = acc[ai][0][m][n][i];
                            if (c < 16) logf_ws[(size_t)row * 16 + c] = v; else if (c < 48) dt_ws[(size_t)row * 32 + (c - 16)] = v; }
                }
        }
    }
};

struct EpiP3 {
    static constexpr bool PERM = true, AFTER_DRAIN = false;
    bf16* QB; bf16* KB; bf16* VB; bf16* SGA; bf16* SGS; float* out; const float* qw; const float* kw;
    __device__ __forceinline__ void operator()(const pg8::f32x4 (&acc)[2][2][4][2], const pg8::Unit& u, int wr, int wc, int fr, int fq) const {
        const int pn = u.pn;
        if (pn < 8) {
            const bool isk = pn >= 4; const int head = 4 * (pn & 3) + wc; const float* nw = isk ? kw : qw;
            f32x4 wv[2][2];
#pragma unroll
            for (int bj = 0; bj < 2; ++bj)
#pragma unroll
                for (int n = 0; n < 2; ++n) wv[bj][n] = *(const f32x4*)(nw + 32 * bj + 8 * fq + 4 * n);
#pragma unroll
            for (int ai = 0; ai < 2; ++ai)
#pragma unroll
                for (int m = 0; m < 4; ++m) { const int row = EPI_ROW(u, ai, m); float ss = 0.f;
#pragma unroll
                    for (int bj = 0; bj < 2; ++bj)
#pragma unroll
                        for (int n = 0; n < 2; ++n) { const f32x4 x = acc[ai][bj][m][n]; ss += (x[0] * x[0] + x[1] * x[1]) + (x[2] * x[2] + x[3] * x[3]); }
                    ss += __shfl_xor(ss, 16); ss += __shfl_xor(ss, 32);
                    const float rstd = rsqrtf(ss * (1.f / 64.f) + EPS), sc = isk ? rstd : rstd * QSCALE;
                    float* ko = (row < MP) ? out + O_KP + (size_t)row * DM : out + O_KS + (size_t)(row - MP) * DM;
#pragma unroll
                    for (int bj = 0; bj < 2; ++bj) { const f32x4 v0 = acc[ai][bj][m][0] * wv[bj][0] * sc, v1 = acc[ai][bj][m][1] * wv[bj][1] * sc; const int col = head * 64 + 32 * bj + 8 * fq;
                        *(u32x4*)((isk ? KB : QB) + (size_t)row * DM + col) = pack8(v0, v1);
                        if (isk) { *(f32x4*)(ko + col) = v0; *(f32x4*)(ko + col + 4) = v1; } }
                }
        } else if (pn < 12) {
#pragma unroll
            for (int ai = 0; ai < 2; ++ai)
#pragma unroll
                for (int m = 0; m < 4; ++m) { const int row = EPI_ROW(u, ai, m); float* vo = (row < MP) ? out + O_VP + (size_t)row * DM : out + O_VS + (size_t)(row - MP) * DM;
#pragma unroll
                    for (int bj = 0; bj < 2; ++bj) { const int col = (pn - 8) * 256 + EPI_CB(bj); *(u32x4*)(VB + (size_t)row * DM + col) = pack8(acc[ai][bj][m][0], acc[ai][bj][m][1]);
                        *(f32x4*)(vo + col) = acc[ai][bj][m][0]; *(f32x4*)(vo + col + 4) = acc[ai][bj][m][1]; } }
        } else {
            bf16* G = pn < 16 ? SGA : SGS; const int colt = ((pn - 12) & 3) * 256;
#pragma unroll
            for (int ai = 0; ai < 2; ++ai)
#pragma unroll
                for (int m = 0; m < 4; ++m) { const int row = EPI_ROW(u, ai, m);
#pragma unroll
                    for (int bj = 0; bj < 2; ++bj) { f32x4 v0 = acc[ai][bj][m][0], v1 = acc[ai][bj][m][1];
#pragma unroll
                        for (int i = 0; i < 4; ++i) { v0[i] = sigmoidf_(v0[i]); v1[i] = sigmoidf_(v1[i]); }
                        *(u32x4*)(G + (size_t)row * DM + colt + EPI_CB(bj)) = pack8(v0, v1); } }
        }
    }
};

template <int MODE> struct EpiGate {
    static constexpr bool PERM = true, AFTER_DRAIN = false;
    const bf16* G; const bf16* T; bf16* O;
    __device__ __forceinline__ void operator()(const pg8::f32x4 (&acc)[2][2][4][2], const pg8::Unit& u, int wr, int wc, int fr, int fq) const {
#pragma unroll
        for (int ai = 0; ai < 2; ++ai)
#pragma unroll
            for (int m = 0; m < 4; ++m) { const int row = EPI_ROW(u, ai, m);
#pragma unroll
                for (int bj = 0; bj < 2; ++bj) { const size_t off = (size_t)row * DM + u.pn * 256 + EPI_CB(bj); const u32x4 g = *(const u32x4*)(G + off);
                    f32x4 v0 = acc[ai][bj][m][0], v1 = acc[ai][bj][m][1];
                    v0[0] *= bflo(g.x); v0[1] *= bfhi(g.x); v0[2] *= bflo(g.y); v0[3] *= bfhi(g.y); v1[0] *= bflo(g.z); v1[1] *= bfhi(g.z); v1[2] *= bflo(g.w); v1[3] *= bfhi(g.w);
                    if (MODE == 1) { const u32x4 t = *(const u32x4*)(T + off);
                        v0[0] += bflo(t.x); v0[1] += bfhi(t.x); v0[2] += bflo(t.y); v0[3] += bfhi(t.y); v1[0] += bflo(t.z); v1[1] += bfhi(t.z); v1[2] += bflo(t.w); v1[3] += bfhi(t.w); }
                    *(u32x4*)(O + off) = pack8(v0, v1); } }
    }
};

struct EpiRes {
    static constexpr bool PERM = true, AFTER_DRAIN = false;
    const float* xp; const float* xs; float* out; int xin; bf16* xw; const float* nw; float* part;
    __device__ __forceinline__ void operator()(const pg8::f32x4 (&acc)[2][2][4][2], const pg8::Unit& u, int wr, int wc, int fr, int fq) const {
#pragma unroll
        for (int ai = 0; ai < 2; ++ai)
#pragma unroll
            for (int m = 0; m < 4; ++m) { const int row = EPI_ROW(u, ai, m);
                const float* b = xin ? ((row < MP) ? xp + (size_t)row * DM : xs + (size_t)(row - MP) * DM) : out + (size_t)row * DM; float* o = out + (size_t)row * DM; float ss = 0.f;
#pragma unroll
                for (int bj = 0; bj < 2; ++bj) { const int col = u.pn * 256 + EPI_CB(bj); const f32x4 b0 = *(const f32x4*)(b + col), b1 = *(const f32x4*)(b + col + 4);
                    const f32x4 v0 = b0 + acc[ai][bj][m][0], v1 = b1 + acc[ai][bj][m][1];
                    *(f32x4*)(o + col) = v0; *(f32x4*)(o + col + 4) = v1;
                    if (xw) { const f32x4 w0 = *(const f32x4*)(nw + col), w1 = *(const f32x4*)(nw + col + 4); *(u32x4*)(xw + (size_t)row * DM + col) = pack8(v0 * w0, v1 * w1);
                        ss += (v0[0] * v0[0] + v0[1] * v0[1]) + (v0[2] * v0[2] + v0[3] * v0[3]) + (v1[0] * v1[0] + v1[1] * v1[1]) + (v1[2] * v1[2] + v1[3] * v1[3]); } }
                if (xw) { ss += __shfl_xor(ss, 16); ss += __shfl_xor(ss, 32); if (fq == 0) part[(size_t)row * 16 + u.pn * 4 + wc] = ss; } }
    }
};

struct EpiRelu2 {
    static constexpr bool PERM = true, AFTER_DRAIN = false;
    bf16* O; int ldc; const float* part;
    __device__ __forceinline__ void operator()(const pg8::f32x4 (&acc)[2][2][4][2], const pg8::Unit& u, int wr, int wc, int fr, int fq) const {
#pragma unroll
        for (int ai = 0; ai < 2; ++ai)
#pragma unroll
            for (int m = 0; m < 4; ++m) { const int row = EPI_ROW(u, ai, m); const f32x4* pp = (const f32x4*)(part + (size_t)row * 16);
                const f32x4 s4 = (pp[0] + pp[1]) + (pp[2] + pp[3]); const float rstd = rsqrtf(((s4[0] + s4[1]) + (s4[2] + s4[3])) * (1.f / DM) + EPS);
#pragma unroll
                for (int bj = 0; bj < 2; ++bj) { f32x4 v0 = acc[ai][bj][m][0], v1 = acc[ai][bj][m][1];
#pragma unroll
                    for (int i = 0; i < 4; ++i) { const float a0 = fmaxf(v0[i], 0.f) * rstd, a1 = fmaxf(v1[i], 0.f) * rstd; v0[i] = a0 * a0; v1[i] = a1 * a1; }
                    *(u32x4*)(O + (size_t)row * ldc + u.pn * 256 + EPI_CB(bj)) = pack8(v0, v1); } }
    }
};

template <class Epi> __device__ __forceinline__ void run_gemm(LAS unsigned char* lds, const bf16* A, const bf16* Bt, int N, int K, const Epi& E, int M = MT) {
    pg8::Gemm g{A, Bt, M, N, K}; pg8::StaticOrder S; S.init(M, N, (int)gridDim.x, (int)blockIdx.x);
    pg8::gemm_phase<Epi, pg8::StaticOrder, true, true>(lds, g, S, E);
}
template <int MODE, int NCB = 16> __device__ __forceinline__ void mini_gemm(const Args& a, LAS unsigned char* lds, const bf16* A, const bf16* Bt, const int K, const bf16* Gt, const bf16* T, bf16* O, bf16* XW, float* part) {
    const int tid = threadIdx.x, lane = tid & 63, wid = __builtin_amdgcn_readfirstlane(tid >> 6), fr = lane & 15, fq = lane >> 4;
    LAS float* RED = (LAS float*)lds;
    typedef float f32x2v __attribute__((ext_vector_type(2)));
    for (int pc = blockIdx.x; pc < 16 * NCB; pc += gridDim.x) {
        const int row0 = MP + 16 * (pc / NCB), col0 = 64 * (pc % NCB), KS = K >> 8;
        f32x4 acc[4];
#pragma unroll
        for (int ct = 0; ct < 4; ++ct) acc[ct] = (f32x4){0.f, 0.f, 0.f, 0.f};
        const bf16* ap = A + (size_t)(row0 + fr) * K + (size_t)wid * (K >> 3) + 8 * fq;
        const bf16* bp = Bt + (size_t)(col0 + fr) * K + (size_t)wid * (K >> 3) + 8 * fq;
        for (int s0 = 0; s0 < KS; s0 += 4) {
            bf16x8 av[4], bv[4][4];
#pragma unroll
            for (int s = 0; s < 4; ++s) { av[s] = *(const bf16x8*)(ap + (s0 + s) * 32);
#pragma unroll
                for (int ct = 0; ct < 4; ++ct) bv[s][ct] = *(const bf16x8*)(bp + (size_t)(16 * ct) * K + (s0 + s) * 32); }
#pragma unroll
            for (int s = 0; s < 4; ++s)
#pragma unroll
                for (int ct = 0; ct < 4; ++ct) acc[ct] = __builtin_amdgcn_mfma_f32_16x16x32_bf16(bv[s][ct], av[s], acc[ct], 0, 0, 0);
        }
#pragma unroll
        for (int ct = 0; ct < 4; ++ct) *(LAS f32x4*)(RED + (wid * 16 + fr) * 64 + 16 * ct + 4 * fq) = acc[ct];
        __syncthreads();
        const int r = tid >> 5, c2 = (tid & 31) * 2; float v0 = 0.f, v1 = 0.f;
#pragma unroll
        for (int w = 0; w < 8; ++w) { const f32x2v t = *(const LAS f32x2v*)(RED + (w * 16 + r) * 64 + c2); v0 += t.x; v1 += t.y; }
        const int row = row0 + r, col = col0 + c2; const size_t off = (size_t)row * DM + col;
        if (MODE == 0 || MODE == 1) { const unsigned g = *(const unsigned*)(Gt + off); v0 *= bflo(g); v1 *= bfhi(g);
            if (MODE == 1) { const unsigned t = *(const unsigned*)(T + off); v0 += bflo(t); v1 += bfhi(t); }
            *(unsigned*)(O + off) = pk2(v0, v1); }
        if (MODE == 2) { const f32x2v x = *(const f32x2v*)(a.x_sample + (size_t)(row - MP) * DM + col), w = *(const f32x2v*)(a.norm2_w + col); v0 += x.x; v1 += x.y;
            *(f32x2v*)(a.out + off) = (f32x2v){v0, v1}; *(unsigned*)(XW + off) = pk2(v0 * w.x, v1 * w.y);
            float ss = v0 * v0 + v1 * v1;
#pragma unroll
            for (int o = 1; o < 32; o <<= 1) ss += __shfl_xor(ss, o);
            if ((tid & 31) == 0) part[(size_t)row * 16 + (pc & 15)] = ss; }
        if (MODE == 3) { f32x2v y = *(const f32x2v*)(a.out + off); y.x += v0; y.y += v1; *(f32x2v*)(a.out + off) = y; }
        if (MODE == 4) { const f32x4* pp = (const f32x4*)(part + (size_t)row * 16); const f32x4 s4 = (pp[0] + pp[1]) + (pp[2] + pp[3]); const float rstd = rsqrtf(((s4[0] + s4[1]) + (s4[2] + s4[3])) * (1.f / DM) + EPS);
            const float a0 = fmaxf(v0, 0.f) * rstd, a1 = fmaxf(v1, 0.f) * rstd; *(unsigned*)(O + (size_t)row * (64 * NCB) + col) = pk2(a0 * a0, a1 * a1); }
        __syncthreads();
    }
}

__device__ __forceinline__ float logf_at(const Args& a, const float* LOGF, int smp, int b, int t, int h, float bf) {
    if (smp) return t < PAST ? a.cache_logf[((size_t)b * PAST + t) * 16 + h] : -softplusf_(-(LOGF[((size_t)MP + b * TS + (t - PAST)) * 16 + h] + bf));
    return -softplusf_(-(LOGF[((size_t)b * TP + t) * 16 + h] + bf));
}
__device__ __forceinline__ void cumsum_item(const Args& a, LAS unsigned char* lds, int item) {
    const int tid = threadIdx.x, h = tid & 15, j = tid >> 4;
    LAS float* S = (LAS float*)lds;
    const float* LOGF = (const float*)(a.ws + WS_LOGF);
    const int smp = item >= NBP * 16; const int b = smp ? (item - NBP * 16) / 5 : item >> 4, blk = smp ? (item - NBP * 16) % 5 : item & 15;
    const int sl = smp ? 13 : 16, t0 = blk * 32 * sl;
    float* dst = smp ? (float*)(a.ws + WS_CUMS) + (size_t)b * SKV * 16 : (float*)(a.ws + WS_CUMP) + (size_t)b * TP * 16;
    const float bf = a.b_f[h];
    float off = 0.f;
    const int nit = t0 >> 5;
    for (int i0 = 0; i0 < nit; i0 += 8) { float pv[8];
#pragma unroll
        for (int u = 0; u < 8; ++u) pv[u] = (i0 + u < nit) ? logf_at(a, LOGF, smp, b, j + 32 * (i0 + u), h, bf) : 0.f;
#pragma unroll
        for (int u = 0; u < 8; ++u) off += pv[u]; }
    float v[16]; float s = 0.f;
#pragma unroll
    for (int i = 0; i < 16; ++i) { v[i] = (i < sl) ? logf_at(a, LOGF, smp, b, t0 + j * sl + i, h, bf) : 0.f; s += v[i]; }
    S[j * 16 + h] = off; S[512 + j * 16 + h] = s; __syncthreads();
    float run = 0.f;
    for (int k = 0; k < 32; ++k) run += S[k * 16 + h];
    for (int k = 0; k < j; ++k) run += S[512 + k * 16 + h];
#pragma unroll
    for (int i = 0; i < 16; ++i) if (i < sl) { const int t = t0 + j * sl + i; run += v[i]; if (smp) dst[(size_t)t * 16 + h] = run; else dst[((size_t)h * TP) + t] = -run * LOG2E;
        if (!smp) a.out[O_LP + ((size_t)b * TP + t) * 16 + h] = v[i]; else if (t >= PAST) a.out[O_LS + ((size_t)b * TS + (t - PAST)) * 16 + h] = v[i]; }
    __syncthreads();
}
__device__ __forceinline__ void phase_gate_norm(const Args& a) {
    const int tid = threadIdx.x, lane = tid & 63, wid = tid >> 6, G = gridDim.x;
    bf16* Z = (bf16*)(a.out + O_Y); const bf16* YR = (const bf16*)(a.ws + WS_BIG);
    for (int m = blockIdx.x * 8 + wid; m < MT; m += G * 8) {
#pragma unroll 2
        for (int gi = 0; gi < 8; ++gi) { const size_t off = (size_t)m * DI + gi * 256 + 4 * lane;
            const u32x2 yr = *(const u32x2*)(YR + off), zz = *(const u32x2*)(Z + off); const f32x4 wv = *(const f32x4*)(a.ssm_norm_w + gi * 256 + 4 * lane);
            float y[4] = {bflo(yr.x), bfhi(yr.x), bflo(yr.y), bfhi(yr.y)}; const float z[4] = {bflo(zz.x), bfhi(zz.x), bflo(zz.y), bfhi(zz.y)};
            float ss = 0.f;
#pragma unroll
            for (int i = 0; i < 4; ++i) { y[i] = y[i] * z[i] * sigmoidf_(z[i]); ss += y[i] * y[i]; }
            const float rstd = rsqrtf(wave_sum(ss) * (1.f / 256.f) + EPS);
            u32x2 o; o.x = pk2(y[0] * rstd * wv.x, y[1] * rstd * wv.y); o.y = pk2(y[2] * rstd * wv.z, y[3] * rstd * wv.w); *(u32x2*)(Z + off) = o; }
    }
}
#ifndef ATT_THRL
#define ATT_THRL 90
#endif
#include <hip/hip_bf16.h>
namespace attn_body {
using bf16=__hip_bfloat16;
using bf16x8=__attribute__((ext_vector_type(8)))short;
using s16x4=__attribute__((ext_vector_type(4)))short;
using f32x16=__attribute__((ext_vector_type(16)))float;
using u32x4=__attribute__((ext_vector_type(4)))unsigned;
constexpr int BATCH=4,NHEAD=16,SEQ=8192,D=64,DM=NHEAD*D;
constexpr int NW=8,QBLK=32,QB=QBLK*NW,KVBLK=64,NQB=SEQ/QB;
constexpr int ATTN_PITCH=DM, ATTN_UNIT_ROWS=QB;
__device__ __forceinline__ int crow(int r,int hi){return (r&3)+8*(r>>2)+4*hi;}
#define SBAR() __builtin_amdgcn_sched_barrier(0)
__device__ __forceinline__ void cmask(f32x16&p0,f32x16&p1,int jb,int qrel,int hi){
  const float NEG=-INFINITY; int kb=64*jb+4*hi;
  #pragma unroll
  for(int r=0;r<16;++r){int kv=kb+(r&3)+8*(r>>2); if(kv>qrel)p0[r]=NEG; if(kv+32>qrel)p1[r]=NEG;}
}

constexpr int NSLOT=3, SLOTB=8192;
constexpr int LDS_K=0, LDS_V=NSLOT*SLOTB, LDS_WS=2*NSLOT*SLOTB, LDS_OST=LDS_WS+NW*64*4, LDS_BYTES=LDS_OST+NW*4096, LDS_BIAS=86016;
constexpr float C2=0.125f*1.4426950408889634f;
__device__ __forceinline__ void glds16(const void*gsrc,unsigned lds_dst){unsigned keep;
  asm volatile("s_mov_b32 %0, m0\n\ts_mov_b32 m0, %2\n\ts_nop 0\n\tglobal_load_lds_dwordx4 %1, off\n\ts_mov_b32 m0, %0":"=&s"(keep):"v"(gsrc),"s"(lds_dst):"memory");}
__device__ __forceinline__ float max3f(float a,float b,float c){float r;asm("v_max3_f32 %0, %1, %2, %3":"=v"(r):"v"(a),"v"(b),"v"(c));return r;}
__device__ __forceinline__ float max2f(float a,float b){float r;asm("v_max_f32_e32 %0, %1, %2":"=v"(r):"v"(a),"v"(b));return r;}
__device__ __forceinline__ float fadd_s(float a,float b){float r;asm("v_add_f32_e32 %0, %1, %2":"=v"(r):"v"(a),"v"(b));return r;}
__device__ __forceinline__ float fsub_s(float a,float b){float r;asm("v_sub_f32_e32 %0, %1, %2":"=v"(r):"v"(a),"v"(b));return r;}
typedef float f32x2_t __attribute__((ext_vector_type(2))); typedef __bf16 bf16x2_t __attribute__((ext_vector_type(2)));
__device__ __forceinline__ unsigned cvtpk_s(float lo,float hi){f32x2_t v={lo,hi};bf16x2_t b=__builtin_convertvector(v,bf16x2_t);return __builtin_bit_cast(unsigned,b);}
#define WAIT_BAR(N) asm volatile("s_waitcnt vmcnt(" #N ") lgkmcnt(0)\n\ts_barrier":::"memory")

__device__ __forceinline__ void qkt(f32x16&p0,f32x16&p1,const char*Kslot,const bf16x8*qr,const f32x16&i0,const f32x16&i1,int r32,int hi){
  const char*kb=Kslot+hi*1024+r32*16;
  #pragma unroll
  for(int d0=0;d0<4;++d0){
    const bf16x8 b0=*reinterpret_cast<const bf16x8*>(kb+d0*2048);
    const bf16x8 b1=*reinterpret_cast<const bf16x8*>(kb+d0*2048+512);
    if(d0==0){p0=__builtin_amdgcn_mfma_f32_32x32x16_bf16(b0,qr[0],i0,0,0,0);p1=__builtin_amdgcn_mfma_f32_32x32x16_bf16(b1,qr[0],i1,0,0,0);}
    else{p0=__builtin_amdgcn_mfma_f32_32x32x16_bf16(b0,qr[d0],p0,0,0,0);p1=__builtin_amdgcn_mfma_f32_32x32x16_bf16(b1,qr[d0],p1,0,0,0);}}
}
typedef __attribute__((address_space(3))) const char* lds_cptr;
typedef short v4i16_t __attribute__((ext_vector_type(4)));
__device__ __forceinline__ void kload8(bf16x8*kf,lds_cptr kp){
  kf[0]=*(const __attribute__((address_space(3))) bf16x8*)(kp);      kf[1]=*(const __attribute__((address_space(3))) bf16x8*)(kp+512);
  kf[2]=*(const __attribute__((address_space(3))) bf16x8*)(kp+2048); kf[3]=*(const __attribute__((address_space(3))) bf16x8*)(kp+2560);
  kf[4]=*(const __attribute__((address_space(3))) bf16x8*)(kp+4096); kf[5]=*(const __attribute__((address_space(3))) bf16x8*)(kp+4608);
  kf[6]=*(const __attribute__((address_space(3))) bf16x8*)(kp+6144); kf[7]=*(const __attribute__((address_space(3))) bf16x8*)(kp+6656);
}
__device__ __forceinline__ void kload2(bf16x8*kf,lds_cptr kp,int j){ kf[2*j]=*(const __attribute__((address_space(3))) bf16x8*)(kp+j*2048); kf[2*j+1]=*(const __attribute__((address_space(3))) bf16x8*)(kp+j*2048+512); }
__device__ __forceinline__ s16x4 vtr(lds_cptr p){ return __builtin_bit_cast(s16x4,__builtin_amdgcn_ds_read_tr16_b64_v4i16((__attribute__((address_space(3))) v4i16_t*)p)); }
__device__ __forceinline__ float rowmax(const f32x16&p0,const f32x16&p1){
  float a=max3f(p0[0],p0[1],p1[0]),b=max3f(p0[2],p0[3],p1[1]);a=max3f(a,p1[2],p1[3]);
  #pragma unroll
  for(int r=4;r<16;r+=4){a=max3f(a,p0[r],p0[r+1]);b=max3f(b,p0[r+2],p0[r+3]);a=max3f(a,p1[r],p1[r+1]);b=max3f(b,p1[r+2],p1[r+3]);}
  const float m=max2f(a,b);
  auto rr=__builtin_amdgcn_permlane32_swap(__float_as_uint(m),__float_as_uint(m),false,false);
  return max2f(__uint_as_float(rr[0]),__uint_as_float(rr[1]));
}
__device__ __forceinline__ void pv(f32x16*o,int vb,bf16x8 pa0,bf16x8 pa1,bf16x8 pa2,bf16x8 pa3){
  #pragma unroll
  for(int d0=0;d0<2;++d0){s16x4 lo[4],hi[4];
    #pragma unroll
    for(int ks=0;ks<4;++ks){
      asm volatile("ds_read_b64_tr_b16 %0,%1 offset:%c2":"=&v"(lo[ks]):"v"(vb),"i"(d0*4096+ks*1024):"memory");
      asm volatile("ds_read_b64_tr_b16 %0,%1 offset:%c2":"=&v"(hi[ks]):"v"(vb),"i"(d0*4096+ks*1024+512):"memory");}
    asm volatile("s_waitcnt lgkmcnt(0)":::"memory");SBAR();
    #define PK(k) (bf16x8){lo[k][0],lo[k][1],lo[k][2],lo[k][3],hi[k][0],hi[k][1],hi[k][2],hi[k][3]}
    o[d0]=__builtin_amdgcn_mfma_f32_32x32x16_bf16(pa0,PK(0),o[d0],0,0,0);
    o[d0]=__builtin_amdgcn_mfma_f32_32x32x16_bf16(pa1,PK(1),o[d0],0,0,0);
    o[d0]=__builtin_amdgcn_mfma_f32_32x32x16_bf16(pa2,PK(2),o[d0],0,0,0);
    o[d0]=__builtin_amdgcn_mfma_f32_32x32x16_bf16(pa3,PK(3),o[d0],0,0,0);
    #undef PK
  }
}

#ifndef ATTN_STORE16
#define ATTN_STORE16(p,v) (*(u32x4*)(p)=(v))
#endif
template<int THRL> __device__ __forceinline__ void attn_unit(int b,int h,int qb,const bf16*Q,const bf16*__restrict__ K,const bf16*__restrict__ V,bf16*O,const float*__restrict__ BL2,char*shm){
  const int tid=threadIdx.x,lane=tid&63,r32=lane&31,hi=lane>>5; const int wid=__builtin_amdgcn_readfirstlane(tid>>6);
  const long rowbase=(long)b*SEQ; const int q0=qb*QB;
  const bf16*Qw=Q+(rowbase+q0+wid*QBLK)*DM+h*D;
  const bf16*Kh=K+rowbase*DM+h*D,*Vh=V+rowbase*DM+h*D;
  const unsigned lds0=(unsigned)(uintptr_t)shm;
  float*wsf=(float*)(shm+LDS_WS)+wid*64;
  const bf16*ksrc=Kh+(long)lane*DM+wid*8;
  const bf16*vsrc=Vh+(long)(16*(wid&3)+(lane>>2))*DM+(wid>>2)*32+(lane&3)*8;
  const unsigned kdst=lds0+LDS_K+wid*1024, vdst=lds0+LDS_V+wid*1024;
  #define DMA_K(t,slot) glds16(ksrc+(long)(t)*KVBLK*DM,(unsigned)__builtin_amdgcn_readfirstlane(kdst+(slot)))
  #define DMA_V(t,slot) glds16(vsrc+(long)(t)*KVBLK*DM,(unsigned)__builtin_amdgcn_readfirstlane(vdst+(slot)))
  const int vb0=(int)(lds0+LDS_V)+((lane>>4)&1)*32+(lane&3)*8+(4*hi+((lane&15)>>2))*64;
  const char*Kbase=shm+LDS_K; bf16x8 kf[8];
  const lds_cptr shm3=(lds_cptr)shm; const lds_cptr kp0=shm3+LDS_K+hi*1024+r32*16; const lds_cptr vp0=shm3+LDS_V+((lane>>4)&1)*32+(lane&3)*8+(4*hi+((lane&15)>>2))*64;
  const int NT=(q0+QB)/KVBLK;
  const float*blh=(const float*)(shm+LDS_BIAS)+4*hi;
  #define BINIT1(C,t,o) do{ const float*bp_=blh+64*(t)+(o); \
    _Pragma("unroll") for(int g_=0;g_<4;++g_){ typedef float f32x4_t __attribute__((ext_vector_type(4))); const f32x4_t b0_=*(const f32x4_t*)(bp_+8*g_); \
      _Pragma("unroll") for(int i_=0;i_<4;++i_){ C[4*g_+i_]=b0_[i_]-mhat; } } }while(0)
  #define BINIT(C0,C1,t) do{ BINIT1(C0,t,0); BINIT1(C1,t,32); }while(0)
  #define BG(G,C,t,o,g_) do{ if(G){ typedef float f32x4_t __attribute__((ext_vector_type(4))); const f32x4_t b0_=*(const f32x4_t*)(blh+64*(t)+(o)+8*(g_)); \
      const f32x2_t m2_={mhat,mhat}; const f32x2_t lo_=(f32x2_t){b0_[0],b0_[1]}-m2_, hi_=(f32x2_t){b0_[2],b0_[3]}-m2_; \
      C[4*(g_)]=lo_[0]; C[4*(g_)+1]=lo_[1]; C[4*(g_)+2]=hi_[0]; C[4*(g_)+3]=hi_[1]; SBAR(); } }while(0)
  DMA_K(0,0);DMA_V(0,0);DMA_K(1,SLOTB);
  { typedef float f32x4_t __attribute__((ext_vector_type(4))); float*bl=(float*)(shm+LDS_BIAS); const int nch=(q0+QB)/4;
    for(int c=tid;c<nch;c+=NW*64){ const f32x4_t v=*(const f32x4_t*)(BL2+4*c); *(f32x4_t*)(bl+4*c)=v; }
    asm volatile("s_waitcnt vmcnt(0)":::"memory"); }
  bf16x8 qr[4];
  #pragma unroll
  for(int d0=0;d0<4;++d0)qr[d0]=*reinterpret_cast<const bf16x8*>(&Qw[(long)r32*DM+d0*16+hi*8]);
  float mhat=0.f,l_reg=0.f;f32x16 o[2];o[0]=f32x16{};o[1]=f32x16{};
  const int qrel=wid*QBLK+r32;
  #define CMASK(P0,P1,t) do{int jb_=(t)-(NT-4); if(jb_>=0)cmask(P0,P1,jb_,qrel,hi);}while(0)
  bool resc=false;
  #define START(P0,P1) do{ const float rm=rowmax(P0,P1); resc=false; \
    { const float dl=rm; mhat=fadd_s(mhat,dl); \
      _Pragma("unroll") for(int r=0;r<16;++r){P0[r]=fsub_s(P0[r],dl);P1[r]=fsub_s(P1[r],dl);} } \
    _Pragma("unroll") for(int r=0;r<16;++r)P0[r]=__builtin_amdgcn_exp2f(P0[r]); }while(0)
  #define RESC() do{ if(resc){ asm volatile("s_waitcnt lgkmcnt(0)":::"memory"); \
      _Pragma("unroll") for(int d_=0;d_<2;++d_) _Pragma("unroll") for(int r=0;r<16;++r)o[d_][r]*=wsf[crow(r,hi)]; } }while(0)
  f32x16 pA0,pA1,pB0,pB1;
  int sl_prev=0,sl_cur=0,sl_next=SLOTB;
  #define ROT() do{sl_prev=sl_cur;sl_cur=sl_next;sl_next=(sl_next==(NSLOT-1)*SLOTB)?0:sl_next+SLOTB;}while(0)
  DMA_K(2,2*SLOTB);
  WAIT_BAR(3);
  { f32x16 i0_,i1_; BINIT(i0_,i1_,0); qkt(pA0,pA1,Kbase,qr,i0_,i1_,r32,hi); } asm volatile("s_nop 15\n\ts_nop 7":"+v"(pA0),"+v"(pA1));CMASK(pA0,pA1,0);
  START(pA0,pA1);
  _Pragma("unroll") for(int r=0;r<16;++r)pA1[r]=__builtin_amdgcn_exp2f(pA1[r]);
  WAIT_BAR(0);
  DMA_K(3,0);DMA_V(1,SLOTB);
  ROT();
  kload8(kf,kp0+sl_cur);
  WAIT_BAR(2);
  s16x4 vlo[8],vhi[8]; u32x4 pw0,pw1,pw2,pw3;
  #define PKW(P,B) cvtpk_s(P[B],P[B+1])
  #define PAF(k) __builtin_bit_cast(bf16x8,pw##k)
  #define VFR(i) (bf16x8){vlo[i][0],vlo[i][1],vlo[i][2],vlo[i][3],vhi[i][0],vhi[i][1],vhi[i][2],vhi[i][3]}
  #define PIN(x) asm volatile("":"+v"(x))
  #define MX3(a,b,c) __builtin_fmaxf(__builtin_fmaxf((a),(b)),(c))
  #define GAPA(MF,A0,A1,A2,A3,W0,W1,PW) do{ MF; sacc+=A0; sacc+=A1; sacc+=A2; sacc+=A3; PIN(sacc); W0; W1; PIN(PW); SBAR(); }while(0)
  #define EX(v) __builtin_amdgcn_exp2f(v)
  #define GAPB(MF,X,B) do{ MF; X[B]=EX(X[B]); X[B+1]=EX(X[B+1]); X[B+2]=EX(X[B+2]); X[B+3]=EX(X[B+3]); PIN(X); SBAR(); }while(0)
  #define VRD(i) do{ vlo[i]=vtr(vp_+(((i)>>2)*4096+((i)&3)*1024)); vhi[i]=vtr(vp_+(((i)>>2)*4096+((i)&3)*1024+512)); }while(0)
  #define KRD(G,j) do{ if(G){ kload2(kf,kp0+sl_next,j); SBAR(); } }while(0)
  #define STEP(C0,C1,P0,P1,t,GK,GV,GL) do{ SBAR(); \
    const lds_cptr vp_=vp0+sl_prev; \
    VRD(0); SBAR(); float sacc=(P0[0]+P0[1]); \
    GAPA(C0=__builtin_amdgcn_mfma_f32_32x32x16_bf16(kf[0],qr[0],C0,0,0,0), P0[2],P0[3],P0[4],P0[5],     pw0[0]=PKW(P0,0), pw0[1]=PKW(P0,2), pw0); \
    VRD(4); SBAR(); GAPA(C1=__builtin_amdgcn_mfma_f32_32x32x16_bf16(kf[1],qr[0],C1,0,0,0), P0[6],P0[7],P0[8],P0[9],     pw0[2]=PKW(P0,4), pw0[3]=PKW(P0,6), pw0); \
    VRD(1); SBAR(); GAPA(C0=__builtin_amdgcn_mfma_f32_32x32x16_bf16(kf[2],qr[1],C0,0,0,0),   P0[10],P0[11],P0[12],P0[13], pw1[0]=PKW(P0,8), pw1[1]=PKW(P0,10), pw1); \
    VRD(5); SBAR(); GAPA(C1=__builtin_amdgcn_mfma_f32_32x32x16_bf16(kf[3],qr[1],C1,0,0,0),   P0[14],P0[15],P1[0],P1[1],   pw1[2]=PKW(P0,12),pw1[3]=PKW(P0,14), pw1); \
    VRD(2); SBAR(); GAPA(C0=__builtin_amdgcn_mfma_f32_32x32x16_bf16(kf[4],qr[2],C0,0,0,0),   P1[2],P1[3],P1[4],P1[5],     pw2[0]=PKW(P1,0), pw2[1]=PKW(P1,2), pw2); \
    VRD(6); SBAR(); GAPA(C1=__builtin_amdgcn_mfma_f32_32x32x16_bf16(kf[5],qr[2],C1,0,0,0),   P1[6],P1[7],P1[8],P1[9],     pw2[2]=PKW(P1,4), pw2[3]=PKW(P1,6), pw2); \
    VRD(3); SBAR(); GAPA(C0=__builtin_amdgcn_mfma_f32_32x32x16_bf16(kf[6],qr[3],C0,0,0,0),   P1[10],P1[11],P1[12],P1[13], pw3[0]=PKW(P1,8), pw3[1]=PKW(P1,10), pw3); \
    VRD(7); SBAR(); GAPA(C1=__builtin_amdgcn_mfma_f32_32x32x16_bf16(kf[7],qr[3],C1,0,0,0),   P1[14],P1[15],0.f,0.f,       pw3[2]=PKW(P1,12),pw3[3]=PKW(P1,14), pw3); \
    l_reg+=sacc; \
    if(GK){DMA_K((t)+3,sl_cur);} if(GV){DMA_V((t)+1,sl_next);} \
    CMASK(C0,C1,t); \
    { float a=MX3(C0[0],C0[1],C1[0]),b=MX3(C0[2],C0[3],C1[1]); a=MX3(a,C1[2],C1[3]); \
      _Pragma("unroll") for(int r=4;r<16;r+=4){a=MX3(a,C0[r],C0[r+1]);b=MX3(b,C0[r+2],C0[r+3]);a=MX3(a,C1[r],C1[r+1]);b=MX3(b,C1[r+2],C1[r+3]);} \
      float rm=__builtin_fmaxf(a,b); { auto rr=__builtin_amdgcn_permlane32_swap(__float_as_uint(rm),__float_as_uint(rm),false,false); rm=__builtin_fmaxf(__uint_as_float(rr[0]),__uint_as_float(rr[1])); } \
      resc=false; \
      if(__builtin_expect(__any(rm>(float)THRL),0)){ const float dl=__builtin_fmaxf(rm,0.f); mhat+=dl; \
        _Pragma("unroll") for(int r=0;r<16;++r){C0[r]-=dl;C1[r]-=dl;} \
        const float f=__builtin_amdgcn_exp2f(-dl); l_reg*=f; if(hi==0)wsf[r32]=f; resc=true; } } \
    SBAR(); \
    GAPB(o[0]=__builtin_amdgcn_mfma_f32_32x32x16_bf16(PAF(0),VFR(0),o[0],0,0,0), C0,0); BG(GL,P0,(t)+1,0,0); \
    GAPB(o[1]=__builtin_amdgcn_mfma_f32_32x32x16_bf16(PAF(0),VFR(4),o[1],0,0,0), C0,4); BG(GL,P0,(t)+1,0,1); \
    KRD(GL,0); GAPB(o[0]=__builtin_amdgcn_mfma_f32_32x32x16_bf16(PAF(1),VFR(1),o[0],0,0,0), C0,8); BG(GL,P0,(t)+1,0,2); \
    KRD(GL,1); GAPB(o[1]=__builtin_amdgcn_mfma_f32_32x32x16_bf16(PAF(1),VFR(5),o[1],0,0,0), C0,12); BG(GL,P0,(t)+1,0,3); \
    KRD(GL,2); GAPB(o[0]=__builtin_amdgcn_mfma_f32_32x32x16_bf16(PAF(2),VFR(2),o[0],0,0,0), C1,0); BG(GL,P1,(t)+1,32,0); \
    KRD(GL,3); GAPB(o[1]=__builtin_amdgcn_mfma_f32_32x32x16_bf16(PAF(2),VFR(6),o[1],0,0,0), C1,4); BG(GL,P1,(t)+1,32,1); \
    GAPB(o[0]=__builtin_amdgcn_mfma_f32_32x32x16_bf16(PAF(3),VFR(3),o[0],0,0,0), C1,8); BG(GL,P1,(t)+1,32,2); \
    GAPB(o[1]=__builtin_amdgcn_mfma_f32_32x32x16_bf16(PAF(3),VFR(7),o[1],0,0,0), C1,12); BG(GL,P1,(t)+1,32,3); \
    }while(0)
  int t=1;
  BINIT(pB0,pB1,1);
  #undef CMASK
  #define CMASK(P0,P1,t) do{}while(0)
  for(;t+5<NT;t+=2){
    STEP(pB0,pB1,pA0,pA1,t,true,true,true);     WAIT_BAR(2); RESC(); ROT();
    STEP(pA0,pA1,pB0,pB1,t+1,true,true,true);   WAIT_BAR(2); RESC(); ROT();
  }
  #undef CMASK
  #define CMASK(P0,P1,t) do{int jb_=(t)-(NT-4); if(jb_>=0)cmask(P0,P1,jb_,qrel,hi);}while(0)
  #define ENDW(tt) do{ if((tt)+3<NT){WAIT_BAR(2);} else if((tt)+2<NT){WAIT_BAR(1);} else {WAIT_BAR(0);} }while(0)
  for(;t+1<NT;t+=2){
    STEP(pB0,pB1,pA0,pA1,t,(t+3<NT),(t+1<NT),(t+1<NT));       ENDW(t);   RESC(); ROT();
    STEP(pA0,pA1,pB0,pB1,t+1,(t+4<NT),(t+2<NT),(t+2<NT));     ENDW(t+1); RESC(); ROT();
  }
  STEP(pB0,pB1,pA0,pA1,NT-1,false,false,false); RESC();
  { float sacc=pB0[0]+pB0[1]; _Pragma("unroll") for(int r=2;r<16;++r)sacc+=pB0[r]; _Pragma("unroll") for(int r=0;r<16;++r)sacc+=pB1[r]; l_reg+=sacc;
    pw0=(u32x4){PKW(pB0,0),PKW(pB0,2),PKW(pB0,4),PKW(pB0,6)};pw1=(u32x4){PKW(pB0,8),PKW(pB0,10),PKW(pB0,12),PKW(pB0,14)};pw2=(u32x4){PKW(pB1,0),PKW(pB1,2),PKW(pB1,4),PKW(pB1,6)};pw3=(u32x4){PKW(pB1,8),PKW(pB1,10),PKW(pB1,12),PKW(pB1,14)};
    SBAR(); pv(o,vb0+sl_cur,PAF(0),PAF(1),PAF(2),PAF(3)); }
  #undef PKW
  #undef PAF
  #undef VFR
  #undef PIN
  #undef MX3
  #undef GAPA
  #undef GAPB
  #undef EX
  #undef VRD
  #undef KRD
  #undef STEP
  #undef ENDW
  {auto rr=__builtin_amdgcn_permlane32_swap(__float_as_uint(l_reg),__float_as_uint(l_reg),false,false);l_reg=__uint_as_float(rr[0])+__uint_as_float(rr[1]);}
  if(hi==0)wsf[32+r32]=l_reg;asm volatile("s_waitcnt lgkmcnt(0)":::"memory");
  float rli[16];
  #pragma unroll
  for(int r=0;r<16;++r)rli[r]=__builtin_amdgcn_rcpf(wsf[32+crow(r,hi)]);
  bf16*Ow=O+(rowbase+q0+wid*QBLK)*DM+h*D;
  { bf16*stg=(bf16*)(shm+LDS_OST)+wid*2048;
    #pragma unroll
    for(int r=0;r<16;++r){const int orow=crow(r,hi);
      #pragma unroll
      for(int d0=0;d0<2;++d0)stg[orow*64+d0*32+r32]=__float2bfloat16(o[d0][r]*rli[r]);}
    asm volatile("s_waitcnt lgkmcnt(0)":::"memory");
    #pragma unroll
    for(int i=0;i<4;++i){const int row=i*8+(lane>>3),ch=lane&7; const u32x4 v=*(const u32x4*)(stg+row*64+ch*8); ATTN_STORE16(Ow+(long)row*DM+ch*8,v);} }
  asm volatile("s_waitcnt lgkmcnt(0)\n\ts_barrier":::"memory");
  #undef BINIT
  #undef BINIT1
  #undef BG
  #undef DMA_K
  #undef DMA_V
  #undef CMASK
  #undef START
  #undef RESC
  #undef ROT
}
constexpr int ATTN_LDS_BYTES=LDS_BYTES;
struct AttnTensors { const bf16* Q; const bf16* K; const bf16* V; bf16* O; const float* BL2; };
struct AttnUnit { int bh; int qb; };
struct StaticOrder {
  int vcu;
  __device__ __forceinline__ explicit StaticOrder(int grid,int block):vcu((block%8)*(grid/8)+block/8){}
  __device__ __forceinline__ bool next(int i,AttnUnit&u)const{ if(i>=8)return false; const int s=vcu&7,j=i&3; u.bh=(vcu>>3)+32*(i>>2); u.qb=(j==0)?31-s:(j==1)?16+s:(j==2)?15-s:s; return true; }
  __device__ __forceinline__ void a_ready(const AttnUnit&)const{}
  __device__ __forceinline__ void done(const AttnUnit&)const{}
};
template<class Sched,int THRL=ATT_THRL> __device__ __forceinline__ void attn_phase(char*lds,const AttnTensors&T,const Sched&S){
  AttnUnit u;
  for(int i=0;S.next(i,u);++i){ S.a_ready(u); attn_unit<THRL>(u.bh/NHEAD,u.bh%NHEAD,u.qb,T.Q,T.K,T.V,T.O,T.BL2+(long)u.bh*SEQ,lds); S.done(u); }
}
#undef SBAR
#undef WAIT_BAR
}

#define XB_TMO      128
#define XB_XCNT(j)  (256  + 64 * (j))
#define XB_XSUB(j)  (1280 + 64 * (j))
#define XB_XGEN(j)  (2304 + 64 * (j))
#define XB_TOP      3328
#define XB_TOPGEN   3392
#define XCD_BAR_WORDS 3456
#define XB_SPIN_CAP (1u << 18)

__device__ __forceinline__ unsigned xb_ld(unsigned* p)              { return __hip_atomic_load(p, __ATOMIC_RELAXED, __HIP_MEMORY_SCOPE_AGENT); }
__device__ __forceinline__ unsigned xb_add(unsigned* p, unsigned v) { return __hip_atomic_fetch_add(p, v, __ATOMIC_RELAXED, __HIP_MEMORY_SCOPE_AGENT); }
__device__ __forceinline__ unsigned xb_xcc_id() { return (unsigned)__builtin_amdgcn_s_getreg((3 << 11) | 20) & 0xFu; }
#define XB_SPIN(cond, bar) do { unsigned _sp = 0; while (cond) { __builtin_amdgcn_s_sleep(1); \
    if ((++_sp & 255u) == 0u) { if (xb_ld(&(bar)[XB_TMO])) break; if (_sp > XB_SPIN_CAP) { atomicAdd(&(bar)[XB_TMO], 1u); break; } } } } while (0)

struct XcdBarrier {
    unsigned* bar; unsigned x;
    volatile LAS unsigned* st;
};

__device__ __forceinline__ XcdBarrier xcd_barrier_post(unsigned* bar, volatile LAS unsigned* st) {
    XcdBarrier b; b.bar = bar; b.x = xb_xcc_id(); b.st = st;
    if (threadIdx.x == 0) (void)xb_add(&bar[XB_XCNT(b.x)], 1u);
    return b;
}
__device__ __forceinline__ void xcd_barrier_complete(unsigned* bar, unsigned x, unsigned& nloc, unsigned& nx) {
    const unsigned G = gridDim.x * gridDim.y * gridDim.z;
    unsigned sum, cnt, mine, sp = 0u;
    for (;;) {
        sum = 0u; cnt = 0u; mine = 0u;
#pragma unroll
        for (unsigned j = 0; j < 16; ++j) { const unsigned c = xb_ld(&bar[XB_XCNT(j)]); sum += c; cnt += (c > 0u) ? 1u : 0u; mine = (j == x) ? c : mine; }
        if (sum == G) break;
        __builtin_amdgcn_s_sleep(1);
        if ((++sp & 255u) == 0u) { if (xb_ld(&bar[XB_TMO])) break; if (sp > XB_SPIN_CAP) { atomicAdd(&bar[XB_TMO], 1u); break; } }
    }
    nloc = mine > 0u ? mine : 1u; nx = cnt > 0u ? cnt : 1u;
}

__device__ __forceinline__ void xcd_barrier(const XcdBarrier& b) {
    asm volatile("s_waitcnt vmcnt(0)" ::: "memory");
    __syncthreads();
    if (threadIdx.x == 0) {
        unsigned* bar = b.bar;
        __builtin_amdgcn_s_waitcnt(0);
        unsigned nloc = b.st[0], nx = b.st[1];
        if (nloc == 0u) { xcd_barrier_complete(bar, b.x, nloc, nx); b.st[0] = nloc; b.st[1] = nx; }
        const unsigned old = xb_add(&bar[XB_XSUB(b.x)], 1u);
        const unsigned gen = old / nloc;
        if (old + 1u == (gen + 1u) * nloc) {
            __builtin_amdgcn_fence(__ATOMIC_RELEASE, "agent");
            asm volatile("s_waitcnt vmcnt(0)" ::: "memory");
            const unsigned og = xb_add(&bar[XB_TOP], 1u);
            const unsigned tg = og / nx;
            if (og + 1u == (tg + 1u) * nx) xb_add(&bar[XB_TOPGEN], 1u);
            else XB_SPIN(xb_ld(&bar[XB_TOPGEN]) == tg, bar);
            __builtin_amdgcn_fence(__ATOMIC_ACQUIRE, "agent");
            xb_add(&bar[XB_XGEN(b.x)], 1u);
            asm volatile("s_waitcnt vmcnt(0)" ::: "memory");
        } else {
            XB_SPIN(xb_ld(&bar[XB_XGEN(b.x)]) == gen, bar);
            __builtin_amdgcn_fence(__ATOMIC_ACQUIRE, "agent");
            asm volatile("s_waitcnt vmcnt(0)" ::: "memory");
        }
    }
    __syncthreads();
}


#ifndef MK_UNROLL
#define MK_UNROLL 1
#endif
#ifndef DIS
#define DIS 0
#endif
#ifndef SSD_LT_UNROLL
#define SSD_LT_UNROLL 4
#endif
#define MFMA16(A, B, C) __builtin_amdgcn_mfma_f32_16x16x32_bf16((A), (B), (C), 0, 0, 0)
#define MFMA32(A, B, C) __builtin_amdgcn_mfma_f32_32x32x16_bf16((A), (B), (C), 0, 0, 0)
__device__ __forceinline__ bf16* bcc_row(const Args& a, size_t m) { return m < (size_t)MP ? (bf16*)(a.out + O_KP) + m * 2048 : (bf16*)(a.out + O_VP) + (m - MP) * 2048; }
__device__ __forceinline__ float* segst_ptr(const Args& a) { return a.out + O_VP + (1u << 20); }

__device__ __forceinline__ void conv8x8(const u32x4 (&xr)[11], const float (&cw)[4][8], const float (&cbias)[8], int nvalid, u32x4 (&orow)[8], u32x4 (&otr)[8]) {
#pragma unroll
    for (int j2 = 0; j2 < 4; ++j2) { float xl[11], xh[11];
#pragma unroll
        for (int i = 0; i < 11; ++i) { xl[i] = bflo(xr[i][j2]); xh[i] = bfhi(xr[i][j2]); }
        float ol[8], oh[8];
#pragma unroll
        for (int tt = 0; tt < 8; ++tt) { float v0 = cbias[2 * j2] + cw[0][2 * j2] * xl[tt] + cw[1][2 * j2] * xl[tt + 1] + cw[2][2 * j2] * xl[tt + 2] + cw[3][2 * j2] * xl[tt + 3];
            float v1 = cbias[2 * j2 + 1] + cw[0][2 * j2 + 1] * xh[tt] + cw[1][2 * j2 + 1] * xh[tt + 1] + cw[2][2 * j2 + 1] * xh[tt + 2] + cw[3][2 * j2 + 1] * xh[tt + 3];
            v0 = v0 * sigmoidf_(v0); v1 = v1 * sigmoidf_(v1); if (tt >= nvalid) { v0 = 0.f; v1 = 0.f; } ol[tt] = v0; oh[tt] = v1; orow[tt][j2] = pk2(v0, v1); }
#pragma unroll
        for (int t2 = 0; t2 < 4; ++t2) { otr[2 * j2][t2] = pk2(ol[2 * t2], ol[2 * t2 + 1]); otr[2 * j2 + 1][t2] = pk2(oh[2 * t2], oh[2 * t2 + 1]); } }
}
__device__ __forceinline__ u32x4 xbc_row8(const Args& a, const bf16* XBC, size_t seqbase, int smp, int b, int ts, int cc) {
    if (ts >= 0 && (!smp || ts < TS)) return *(const u32x4*)(XBC + (seqbase + ts) * CONVD + cc);
    if (smp && ts < 0) { const float* sp = a.state_conv + ((size_t)b * 3 + (ts + 3)) * CONVD + cc; return pack8(*(const f32x4*)sp, *(const f32x4*)(sp + 4)); }
    return (u32x4){0u, 0u, 0u, 0u};
}
__device__ __forceinline__ void phase_bc_conv(const Args& a) {
    const int tid = threadIdx.x, G = gridDim.x, cc = 8 * tid;
    const bf16* XBC = (const bf16*)(a.ws + WS_BIG); bf16* XC = (bf16*)(a.ws + WS_SG);
    float cw[4][8], cbias[8];
#pragma unroll
    for (int i = 0; i < 4; ++i)
#pragma unroll
        for (int j = 0; j < 8; ++j) cw[i][j] = a.conv_w[(size_t)i * CONVD + cc + j];
#pragma unroll
    for (int j = 0; j < 8; ++j) cbias[j] = a.conv_b[cc + j];
    const int nP = MP / 8, nS = MS / 8;
    const bool contig = (nP % G) == 0; const int per = contig ? nP / G : (nP - (int)blockIdx.x + G - 1) / G, nsm = ((int)blockIdx.x < nS) ? 1 : 0, nst = per + nsm;
#define BCC_IT(j) ((j) < per ? (contig ? (int)blockIdx.x * per + (j) : (int)blockIdx.x + (j) * G) : nP + (int)blockIdx.x)
    u32x4 xn[11];
#define BCC_LD(itv, lo) do { const int smp_ = (itv) >= nP, to_ = smp_ ? (itv) - nP : (itv); const int b_ = smp_ ? to_ / (TS / 8) : to_ / (TP / 8), t0_ = smp_ ? (to_ % (TS / 8)) * 8 : (to_ % (TP / 8)) * 8; \
        const size_t sb_ = smp_ ? (size_t)MP + (size_t)b_ * TS : (size_t)b_ * TP; _Pragma("unroll") for (int i_ = 0; i_ < 11; ++i_) if (i_ >= (lo)) xn[i_] = xbc_row8(a, XBC, sb_, smp_, b_, t0_ - 3 + i_, cc); } while (0)
    if (nst > 0) BCC_LD(BCC_IT(0), 0);
    for (int j = 0; j < nst; ++j) {
        const int it = BCC_IT(j);
        const int smp = it >= nP; const int to = smp ? it - nP : it;
        const int b = smp ? to / (TS / 8) : to / (TP / 8), t0 = smp ? (to % (TS / 8)) * 8 : (to % (TP / 8)) * 8;
        const size_t seqbase = smp ? (size_t)MP + (size_t)b * TS : (size_t)b * TP;
        u32x4 xr[11];
#pragma unroll
        for (int i = 0; i < 11; ++i) xr[i] = xn[i];
        if (j + 1 < nst) { const int itn = BCC_IT(j + 1);
            if (contig && itn == it + 1 && (itn % (TP / 8)) != 0) { xn[0] = xr[8]; xn[1] = xr[9]; xn[2] = xr[10]; BCC_LD(itn, 3); } else BCC_LD(itn, 0); }
        u32x4 orow[8], otr[8]; conv8x8(xr, cw, cbias, 8, orow, otr);
        if (tid < 256) {
#pragma unroll
            for (int tt = 0; tt < 8; ++tt) *(u32x4*)(XC + (seqbase + t0 + tt) * 2048 + cc) = orow[tt];
        } else {
#pragma unroll
            for (int tt = 0; tt < 8; ++tt) *(u32x4*)(bcc_row(a, seqbase + t0 + tt) + (cc - 2048)) = orow[tt];
        }
        const int tl = smp ? TS : TP;
        if (t0 + 8 == tl) { float* cs = smp ? a.out + O_CS + (size_t)b * 3 * CONVD : a.out + O_CP + (size_t)b * 3 * CONVD;
#pragma unroll
            for (int i = 0; i < 3; ++i) { const u32x4 w = xr[8 + i]; float* o = cs + (size_t)i * CONVD + cc;
                *(f32x4*)o = (f32x4){bflo(w.x), bfhi(w.x), bflo(w.y), bfhi(w.y)}; *(f32x4*)(o + 4) = (f32x4){bflo(w.z), bfhi(w.z), bflo(w.w), bfhi(w.w)}; } }
    }
#undef BCC_LD
#undef BCC_IT
}

constexpr int SSD_CS = 0, SSD_BS = 17408, SSD_BT = 34816, SSD_XT = 53248, SSD_MM = 90112, SSD_FA = 126976;
__device__ __forceinline__ void ssd_item(const Args& a, LAS unsigned char* lds, const int mode, const int smp, const int b, const int seg, const int g) {
    const int tid = threadIdx.x, lane = tid & 63, wid = __builtin_amdgcn_readfirstlane(tid >> 6), fr = lane & 15, fq = lane >> 4, hh = wid >> 1, ph = wid & 1, head = 4 * g + hh;
    LAS bf16* Cs = (LAS bf16*)(lds + SSD_CS); LAS bf16* Bs = (LAS bf16*)(lds + SSD_BS); LAS bf16* BT = (LAS bf16*)(lds + SSD_BT);
    LAS bf16* XTh = (LAS bf16*)(lds + SSD_XT) + hh * 4608; LAS bf16* MMh = (LAS bf16*)(lds + SSD_MM) + hh * 4608;
    LAS float* FAh = (LAS float*)(lds + SSD_FA) + hh * 256;
    const size_t seqbase = smp ? (size_t)MP + (size_t)b * TS : (size_t)b * TP;
    const int tseg = smp ? 0 : seg * 1024, nch = smp ? 1 : 16;
    const float Dh = a.D_skip[head];
    const bf16* XBC = (const bf16*)(a.ws + WS_BIG);
    const float* DTW = (const float*)(a.ws + WS_DT);
    float* SEGST = segst_ptr(a); float* SEGDEC = (float*)(a.ws + WS_SEGDEC);
    f32x4 st[8][2];
    if (mode == 1 && smp) { const float* h0 = a.state_ssm + ((size_t)b * NHS + head) * 8192;
#pragma unroll
        for (int nt = 0; nt < 8; ++nt)
#pragma unroll
            for (int pt2 = 0; pt2 < 2; ++pt2) st[nt][pt2] = *(const f32x4*)(h0 + (32 * ph + 16 * pt2 + fr) * 128 + 16 * nt + 4 * fq);
    } else if (mode == 1) {
#pragma unroll
        for (int nt = 0; nt < 8; ++nt)
#pragma unroll
            for (int pt2 = 0; pt2 < 2; ++pt2) st[nt][pt2] = (f32x4){0.f, 0.f, 0.f, 0.f};
#pragma unroll 1
        for (int s = 0; s < seg; ++s) { const float* h0 = SEGST + (((size_t)b * 8 + s) * NHS + head) * 8192; const float dec = SEGDEC[(b * 8 + s) * NHS + head];
#pragma unroll
            for (int nt = 0; nt < 8; ++nt)
#pragma unroll
                for (int pt2 = 0; pt2 < 2; ++pt2) st[nt][pt2] = st[nt][pt2] * dec + *(const f32x4*)(h0 + (32 * ph + 16 * pt2 + fr) * 128 + 16 * nt + 4 * fq); }
    } else {
#pragma unroll
        for (int nt = 0; nt < 8; ++nt)
#pragma unroll
            for (int pt2 = 0; pt2 < 2; ++pt2) st[nt][pt2] = (f32x4){0.f, 0.f, 0.f, 0.f};
    }
    const int xco = tid & 31, xtq = (tid >> 5) & 7, bno = tid & 15, btq = (tid >> 4) & 7;
    const bool isX = tid < 256, isB = !isX && tid < 384, ldact = isX || isB || mode == 1;
    const int tq = isX ? xtq : btq;
    const bf16* rbase = isX ? (const bf16*)(a.ws + WS_SG) + (seqbase + tseg + 8 * tq) * 2048 + g * 256 + 8 * xco
                            : bcc_row(a, seqbase + tseg + 8 * tq) + (isB ? 0 : 1024) + g * 128 + 8 * bno;
    u32x4 pf[8];
#define SSD_PF(cn) do { _Pragma("unroll") for (int tt_ = 0; tt_ < 8; ++tt_) pf[tt_] = (ldact && (!smp || 8 * tq + tt_ < TS)) ? *(const u32x4*)(rbase + ((size_t)(cn) * 64 + tt_) * 2048) : (u32x4){0u, 0u, 0u, 0u}; \
        } while (0)
    SSD_PF(0);
    if (mode == 1) { for (int e = lane + 64 * ph; e < 64 * 72 / 2; e += 128) ((LAS unsigned*)MMh)[e] = 0u; }
    const float Ah = -expf(a.A_log[4 * g + (wid & 3)]), dtb = a.dt_bias[4 * g + (wid & 3)];
    float decsum = 0.f;
    bf16* ZB = (bf16*)(a.out + O_Y); LAS float* NS = (LAS float*)(lds + 131072);
    int ypend = -1;
#define SSD_YFIN() do { if (mode == 1 && ypend >= 0) { const float* nwp_ = a.ssm_norm_w + head * 64 + 32 * ph + 4 * fq; const f32x4 nw0_ = *(const f32x4*)nwp_, nw1_ = *(const f32x4*)(nwp_ + 16); \
        const float nwv[8] = {nw0_[0], nw0_[1], nw0_[2], nw0_[3], nw1_[0], nw1_[1], nw1_[2], nw1_[3]}; _Pragma("unroll") for (int lt = 0; lt < 4; ++lt) { const int l = 16 * lt + fr; float tot = 0.f; \
        _Pragma("unroll") for (int w = 0; w < 8; ++w) tot += NS[w * 64 + l]; const float rs = rsqrtf(tot * (1.f / 256.f) + EPS); \
        if (!smp || l < TS) { bf16* zo = ZB + (seqbase + ypend + l) * DI + head * 64 + 32 * ph + 4 * fq; const u32x2 g0 = *(const u32x2*)zo, g1 = *(const u32x2*)(zo + 16); \
            *(u32x2*)zo = (u32x2){pk2(bflo(g0.x) * rs * nwv[0], bfhi(g0.x) * rs * nwv[1]), pk2(bflo(g0.y) * rs * nwv[2], bfhi(g0.y) * rs * nwv[3])}; \
            *(u32x2*)(zo + 16) = (u32x2){pk2(bflo(g1.x) * rs * nwv[4], bfhi(g1.x) * rs * nwv[5]), pk2(bflo(g1.y) * rs * nwv[6], bfhi(g1.y) * rs * nwv[7])}; } } } } while (0)
    for (int c = 0; c < nch; ++c) {
        const int t0 = tseg + c * 64;
        const float dtraw = (tid >= 256 && (!smp || lane < TS)) ? DTW[(seqbase + t0 + lane) * 32 + 4 * g + (wid & 3)] : -1e30f;
        SSD_YFIN();
        if (isX || isB) {
            LAS bf16* T = isX ? (LAS bf16*)(lds + SSD_XT) + (xco >> 3) * 4608 + (8 * (xco & 7)) * 72 + 8 * tq : BT + (8 * bno) * 72 + 8 * tq;
#pragma unroll
            for (int j = 0; j < 8; ++j) { u32x4 w;
#pragma unroll
                for (int t2 = 0; t2 < 4; ++t2) { const unsigned lo = pf[2 * t2][j >> 1], hi = pf[2 * t2 + 1][j >> 1]; w[t2] = (j & 1) ? ((lo >> 16) | (hi & 0xffff0000u)) : ((lo & 0xffffu) | (hi << 16)); }
                *(LAS u32x4*)(T + j * 72) = w; }
        }
        if (!isX && mode == 1) { LAS bf16* R = isB ? Bs : Cs;
#pragma unroll
            for (int tt = 0; tt < 8; ++tt) *(LAS u32x4*)(R + (8 * tq + tt) * 136 + 8 * bno) = pf[tt]; }
        if (tid >= 256) {
            LAS float* F = (LAS float*)(lds + SSD_FA) + (wid & 3) * 256;
            const float dtv = dtraw > -1e29f ? softplusf_(dtraw + dtb) : 0.f; float av = dtv * Ah;
#pragma unroll
            for (int o = 1; o < 64; o <<= 1) { const float tv = __shfl_up(av, o); if (lane >= o) av += tv; }
            const float alast = __shfl(av, 63);
            F[lane] = dtv; F[64 + lane] = av; F[128 + lane] = __expf(av); F[192 + lane] = __expf(alast - av) * dtv; }
        if (c + 1 < nch) SSD_PF(c + 1);
        __syncthreads();
        const float acl = FAh[64 + 63]; if (mode == 0) decsum += acl;
        u32x2 zpre[4][2];
        if (mode == 1) {
#pragma unroll
            for (int lt = 0; lt < 4; ++lt) { const int l = 16 * lt + fr; if (!smp || l < TS) { const bf16* zp = ZB + (seqbase + t0 + l) * DI + head * 64 + 32 * ph + 4 * fq; zpre[lt][0] = *(const u32x2*)zp; zpre[lt][1] = *(const u32x2*)(zp + 16); } else { zpre[lt][0] = (u32x2){0u, 0u}; zpre[lt][1] = (u32x2){0u, 0u}; } }
        }
        if (mode == 1 && !(DIS & 4)) {
#pragma unroll MK_UNROLL
            for (int k = 0; k < 2; ++k) { const int lt = ph ? 1 + k : 3 * k;
_Pragma("unroll 1")
                for (int jt = 0; jt <= lt; ++jt) { f32x4 acc = {0.f, 0.f, 0.f, 0.f};
#pragma unroll
                    for (int ks = 0; ks < 4; ++ks) { const bf16x8 A = *(const LAS bf16x8*)(Cs + (16 * lt + fr) * 136 + 32 * ks + 8 * fq), B = *(const LAS bf16x8*)(Bs + (16 * jt + fr) * 136 + 32 * ks + 8 * fq); acc = MFMA16(A, B, acc); }
                    const int s = 16 * jt + fr; const float as_ = FAh[64 + s], ds = FAh[s];
#pragma unroll
                    for (int r = 0; r < 4; ++r) { const int l = 16 * lt + 4 * fq + r; float v = (l >= s) ? acc[r] * __expf(FAh[64 + l] - as_) * ds : 0.f; if (l == s) v += Dh; MMh[l * 72 + s] = (bf16)f2bf(v); } } }
            __syncthreads();
            if (!(DIS & 8)) {
            u32x2 hp[4][2][2];
#pragma unroll
            for (int kk = 0; kk < 4; ++kk)
#pragma unroll
                for (int pt2 = 0; pt2 < 2; ++pt2) { hp[kk][pt2][0] = (u32x2){pk2(st[2 * kk][pt2][0], st[2 * kk][pt2][1]), pk2(st[2 * kk][pt2][2], st[2 * kk][pt2][3])};
                    hp[kk][pt2][1] = (u32x2){pk2(st[2 * kk + 1][pt2][0], st[2 * kk + 1][pt2][1]), pk2(st[2 * kk + 1][pt2][2], st[2 * kk + 1][pt2][3])}; }
#pragma unroll SSD_LT_UNROLL
            for (int lt = 0; lt < 4; ++lt) { f32x4 y0 = {0.f, 0.f, 0.f, 0.f}, y1 = y0;
#pragma unroll
                for (int kk = 0; kk < 4; ++kk) { const LAS bf16* cp = Cs + (16 * lt + fr) * 136 + 32 * kk + 4 * fq; const u32x2 c0 = *(const LAS u32x2*)cp, c1 = *(const LAS u32x2*)(cp + 16);
                    const bf16x8 Bc = __builtin_bit_cast(bf16x8, (u32x4){c0.x, c0.y, c1.x, c1.y});
                    const bf16x8 A0 = __builtin_bit_cast(bf16x8, (u32x4){hp[kk][0][0].x, hp[kk][0][0].y, hp[kk][0][1].x, hp[kk][0][1].y}), A1 = __builtin_bit_cast(bf16x8, (u32x4){hp[kk][1][0].x, hp[kk][1][0].y, hp[kk][1][1].x, hp[kk][1][1].y});
                    y0 = MFMA16(A0, Bc, y0); y1 = MFMA16(A1, Bc, y1); }
                const int l = 16 * lt + fr; const float e = FAh[128 + l]; y0 = y0 * e; y1 = y1 * e;
#pragma unroll
                for (int ks = 0; ks < 2; ++ks) { const bf16x8 Bm = *(const LAS bf16x8*)(MMh + (16 * lt + fr) * 72 + 32 * ks + 8 * fq);
                    const bf16x8 A0 = *(const LAS bf16x8*)(XTh + (32 * ph + fr) * 72 + 32 * ks + 8 * fq), A1 = *(const LAS bf16x8*)(XTh + (32 * ph + 16 + fr) * 72 + 32 * ks + 8 * fq);
                    y0 = MFMA16(A0, Bm, y0); y1 = MFMA16(A1, Bm, y1); }
                float ss = 0.f;
                if (!smp || l < TS) { bf16* zp = ZB + (seqbase + t0 + l) * DI + head * 64 + 32 * ph + 4 * fq; const u32x2 z0 = zpre[lt][0], z1 = zpre[lt][1];
                    const float zf[8] = {bflo(z0.x), bfhi(z0.x), bflo(z0.y), bfhi(z0.y), bflo(z1.x), bfhi(z1.x), bflo(z1.y), bfhi(z1.y)};
#pragma unroll
                    for (int r = 0; r < 4; ++r) { y0[r] = y0[r] * zf[r] * sigmoidf_(zf[r]); y1[r] = y1[r] * zf[4 + r] * sigmoidf_(zf[4 + r]); ss += y0[r] * y0[r] + y1[r] * y1[r]; }
                    *(u32x2*)zp = (u32x2){pk2(y0[0], y0[1]), pk2(y0[2], y0[3])}; *(u32x2*)(zp + 16) = (u32x2){pk2(y1[0], y1[1]), pk2(y1[2], y1[3])}; }
                ss += __shfl_xor(ss, 16); ss += __shfl_xor(ss, 32);
                if (fq == 0) NS[wid * 64 + l] = ss; }
            ypend = t0;
            }
        }
        if (!(DIS & 16)) { const float cd = __expf(acl);
#pragma unroll
            for (int nt = 0; nt < 8; ++nt) { st[nt][0] = st[nt][0] * cd; st[nt][1] = st[nt][1] * cd; }
#pragma unroll
            for (int ks = 0; ks < 2; ++ks) { const f32x4 w0 = *(const LAS f32x4*)(FAh + 192 + 32 * ks + 8 * fq), w1 = *(const LAS f32x4*)(FAh + 192 + 32 * ks + 8 * fq + 4);
                bf16x8 Bx[2];
#pragma unroll
                for (int pt2 = 0; pt2 < 2; ++pt2) { const u32x4 x = *(const LAS u32x4*)(XTh + (32 * ph + 16 * pt2 + fr) * 72 + 32 * ks + 8 * fq);
                    Bx[pt2] = __builtin_bit_cast(bf16x8, (u32x4){pk2(bflo(x.x) * w0[0], bfhi(x.x) * w0[1]), pk2(bflo(x.y) * w0[2], bfhi(x.y) * w0[3]), pk2(bflo(x.z) * w1[0], bfhi(x.z) * w1[1]), pk2(bflo(x.w) * w1[2], bfhi(x.w) * w1[3])}); }
#pragma unroll
                for (int nt = 0; nt < 8; ++nt) { const bf16x8 An = *(const LAS bf16x8*)(BT + (16 * nt + fr) * 72 + 32 * ks + 8 * fq); st[nt][0] = MFMA16(An, Bx[0], st[nt][0]); st[nt][1] = MFMA16(An, Bx[1], st[nt][1]); if (nt & 1) __builtin_amdgcn_sched_barrier(0); } } }
        __syncthreads();
    }
    SSD_YFIN();
#undef SSD_YFIN
    float* dst = nullptr;
    if (mode == 0) { dst = SEGST + (((size_t)b * 8 + seg) * NHS + head) * 8192; if (lane == 0 && ph == 0) SEGDEC[(b * 8 + seg) * NHS + head] = expf(decsum); }
    else if (smp) dst = a.out + O_SS + ((size_t)b * NHS + head) * 8192;
    else if (seg == 7) dst = a.out + O_SP + ((size_t)b * NHS + head) * 8192;
    if (dst) {
#pragma unroll
        for (int nt = 0; nt < 8; ++nt)
#pragma unroll
            for (int pt2 = 0; pt2 < 2; ++pt2) *(f32x4*)(dst + (32 * ph + 16 * pt2 + fr) * 128 + 16 * nt + 4 * fq) = st[nt][pt2];
    }
#undef SSD_PF
    __syncthreads();
}
__device__ __forceinline__ void phase_ssd_b(const Args& a) {
    float* SEGST = segst_ptr(a); const float* SEGDEC = (const float*)(a.ws + WS_SEGDEC);
    const int n = NBP * NHS * 8192;
    for (int e = blockIdx.x * 512 + threadIdx.x; e < n; e += gridDim.x * 512) { const int b = e / (NHS * 8192), rem = e % (NHS * 8192), head = rem / 8192; float H = 0.f;
#pragma unroll
        for (int s = 0; s < 8; ++s) { const size_t idx = ((size_t)b * 8 + s) * NHS * 8192 + rem; const float loc = s < 7 ? SEGST[idx] : 0.f; SEGST[idx] = H; H = H * SEGDEC[(b * 8 + s) * NHS + head] + loc; } }
}

#ifndef ATT_THRL
#define ATT_THRL 60
#endif
template <bool SMP> __device__ __forceinline__ void attn_unit(const Args& a, LAS unsigned char* lds, const int b, const int h, const int qb) {
    const int tid = threadIdx.x, lane = tid & 63, r32 = lane & 31, hi = lane >> 5, wid = __builtin_amdgcn_readfirstlane(tid >> 6);
    bf16* QB = (bf16*)(a.ws + WS_BIG); const bf16* KB = QB + (size_t)MT * DM; const bf16* VB = KB + (size_t)MT * DM;
    bf16* OB = QB + (size_t)3 * MT * DM;
    if (SMP) { QB = (bf16*)(a.ws + WS_QS) - (size_t)MP * DM; KB = (const bf16*)(a.ws + WS_KS) - (size_t)MP * DM; VB = (const bf16*)(a.ws + WS_VS) - (size_t)MP * DM; }
    LAS bf16* Ks = (LAS bf16*)lds; LAS bf16* VT = (LAS bf16*)(lds + 18432); LAS float* CBs = (LAS float*)(lds + 36864);
    const int NT = SMP ? (SKV + 63) / 64 : 4 * qb + 4;
    const bool active = SMP ? (wid == 0) : true;
    const size_t qrow0 = SMP ? (size_t)MP + (size_t)b * TS : (size_t)b * TP + (size_t)qb * 256 + wid * 32;
    const int qpos0 = SMP ? PAST : qb * 256 + wid * 32;
    const float* CUM = SMP ? (const float*)(a.ws + WS_CUMS) + (size_t)b * SKV * 16 + h : (const float*)(a.ws + WS_CUMP) + (size_t)b * TP * 16 + h;
    bf16x8 qr[4];
#pragma unroll
    for (int d0 = 0; d0 < 4; ++d0) qr[d0] = active ? *(const bf16x8*)(QB + (qrow0 + r32) * DM + h * 64 + 16 * d0 + 8 * hi) : (bf16x8){0, 0, 0, 0, 0, 0, 0, 0};
    float mrun = -1e30f, lrun = 0.f; f32x16 o0, o1;
#pragma unroll
    for (int r = 0; r < 16; ++r) { o0[r] = 0.f; o1[r] = 0.f; }
    const int srow = tid >> 3, sch = tid & 7;
    u32x4 kreg, vreg; float breg = 0.f;
#define ATT_LOAD(t) do { const int kv0_ = 64 * (t); \
        if (!SMP) { const size_t ro = ((size_t)b * TP + kv0_ + srow) * DM + h * 64 + sch * 8; kreg = *(const u32x4*)(KB + ro); vreg = *(const u32x4*)(VB + ro); if (tid < 64) breg = -CUM[(size_t)(kv0_ + tid) * 16] * LOG2E; } \
        else if (kv0_ < PAST) { const size_t ro = (((size_t)b * PAST + kv0_ + srow) * NH + h) * 64 + sch * 8; const f32x4 k0 = *(const f32x4*)(a.cache_k + ro), k1 = *(const f32x4*)(a.cache_k + ro + 4), v0 = *(const f32x4*)(a.cache_v + ro), v1 = *(const f32x4*)(a.cache_v + ro + 4); \
            kreg = pack8(k0, k1); vreg = pack8(v0, v1); if (tid < 64) breg = -CUM[(size_t)(kv0_ + tid) * 16] * LOG2E; } \
        else { if (srow < TS) { const size_t ro = ((size_t)MP + (size_t)b * TS + srow) * DM + h * 64 + sch * 8; kreg = *(const u32x4*)(KB + ro); vreg = *(const u32x4*)(VB + ro); } else { kreg = (u32x4){0u, 0u, 0u, 0u}; vreg = kreg; } \
            if (tid < 64) breg = tid < TS ? -CUM[(size_t)(kv0_ + tid) * 16] * LOG2E : 0.f; } } while (0)
#define ATT_STORE(buf) do { *(LAS u32x4*)(Ks + (buf) * 4608 + srow * 72 + sch * 8) = kreg; LAS bf16* vt_ = VT + (buf) * 4608 + (sch * 8) * 72 + srow; \
        vt_[0] = (bf16)(vreg.x & 0xffffu); vt_[72] = (bf16)(vreg.x >> 16); vt_[144] = (bf16)(vreg.y & 0xffffu); vt_[216] = (bf16)(vreg.y >> 16); \
        vt_[288] = (bf16)(vreg.z & 0xffffu); vt_[360] = (bf16)(vreg.z >> 16); vt_[432] = (bf16)(vreg.w & 0xffffu); vt_[504] = (bf16)(vreg.w >> 16); \
        if (tid < 64) CBs[(buf) * 64 + tid] = breg; } while (0)
    ATT_LOAD(0); ATT_STORE(0); __syncthreads();
    for (int t = 0; t < NT; ++t) {
        const int buf = t & 1, kv0 = 64 * t;
        if (t + 1 < NT) ATT_LOAD(t + 1);
        if (active && kv0 <= qpos0 + 31) {
            const LAS bf16* kb = Ks + buf * 4608; const LAS bf16* vb = VT + buf * 4608; const LAS float* cb = CBs + buf * 64;
            f32x16 p0, p1;
#pragma unroll
            for (int r = 0; r < 16; ++r) { p0[r] = 0.f; p1[r] = 0.f; }
#pragma unroll
            for (int d0 = 0; d0 < 4; ++d0) { const bf16x8 a0 = *(const LAS bf16x8*)(kb + r32 * 72 + 16 * d0 + 8 * hi), a1 = *(const LAS bf16x8*)(kb + (32 + r32) * 72 + 16 * d0 + 8 * hi);
                p0 = MFMA32(a0, qr[d0], p0); p1 = MFMA32(a1, qr[d0], p1); }
#pragma unroll
            for (int gq = 0; gq < 4; ++gq) { const f32x4 b0 = *(const LAS f32x4*)(cb + 8 * gq + 4 * hi), b1 = *(const LAS f32x4*)(cb + 32 + 8 * gq + 4 * hi);
#pragma unroll
                for (int i = 0; i < 4; ++i) { p0[4 * gq + i] += b0[i]; p1[4 * gq + i] += b1[i]; } }
            if (kv0 + 63 > qpos0) { const int q = qpos0 + r32;
#pragma unroll
                for (int r = 0; r < 16; ++r) { const int kv = kv0 + (r & 3) + 8 * (r >> 2) + 4 * hi; if (kv > q) p0[r] = -INFINITY; if (kv + 32 > q) p1[r] = -INFINITY; } }
            float mx = fmaxf(p0[0], p1[0]);
#pragma unroll
            for (int r = 1; r < 16; ++r) mx = fmaxf(mx, fmaxf(p0[r], p1[r]));
            mx = fmaxf(mx, __shfl_xor(mx, 32));
            const float mnew = fmaxf(mrun, mx), alpha = __builtin_amdgcn_exp2f(mrun - mnew); mrun = mnew;
            float sum = 0.f;
#pragma unroll
            for (int r = 0; r < 16; ++r) { p0[r] = __builtin_amdgcn_exp2f(p0[r] - mnew); p1[r] = __builtin_amdgcn_exp2f(p1[r] - mnew); sum += p0[r] + p1[r]; }
            lrun = lrun * alpha + sum;
#pragma unroll
            for (int r = 0; r < 16; ++r) { o0[r] *= alpha; o1[r] *= alpha; }
            u32x4 pw[2][2];
#pragma unroll
            for (int hf = 0; hf < 2; ++hf) { pw[0][hf] = (u32x4){pk2(p0[8 * hf], p0[8 * hf + 1]), pk2(p0[8 * hf + 2], p0[8 * hf + 3]), pk2(p0[8 * hf + 4], p0[8 * hf + 5]), pk2(p0[8 * hf + 6], p0[8 * hf + 7])};
                pw[1][hf] = (u32x4){pk2(p1[8 * hf], p1[8 * hf + 1]), pk2(p1[8 * hf + 2], p1[8 * hf + 3]), pk2(p1[8 * hf + 4], p1[8 * hf + 5]), pk2(p1[8 * hf + 6], p1[8 * hf + 7])}; }
#pragma unroll
            for (int kt = 0; kt < 2; ++kt)
#pragma unroll
                for (int hf = 0; hf < 2; ++hf) { const bf16x8 pb = __builtin_bit_cast(bf16x8, pw[kt][hf]);
                    { const LAS bf16* vp = vb + r32 * 72 + 32 * kt + 16 * hf + 4 * hi; const s16x4 lo = *(const LAS s16x4*)vp, h4 = *(const LAS s16x4*)(vp + 8);
                      const bf16x8 av = {lo[0], lo[1], lo[2], lo[3], h4[0], h4[1], h4[2], h4[3]}; o0 = MFMA32(av, pb, o0); }
                    { const LAS bf16* vp = vb + (32 + r32) * 72 + 32 * kt + 16 * hf + 4 * hi; const s16x4 lo = *(const LAS s16x4*)vp, h4 = *(const LAS s16x4*)(vp + 8);
                      const bf16x8 av = {lo[0], lo[1], lo[2], lo[3], h4[0], h4[1], h4[2], h4[3]}; o1 = MFMA32(av, pb, o1); } }
        }
        if (t + 1 < NT) ATT_STORE(buf ^ 1);
        __syncthreads();
    }
    if (active) { const float lt = lrun + __shfl_xor(lrun, 32), inv = 1.f / lt; bf16* orow = OB + (qrow0 + r32) * DM + h * 64;
#pragma unroll
        for (int gq = 0; gq < 4; ++gq) { u32x2 w0, w1; w0.x = pk2(o0[4 * gq] * inv, o0[4 * gq + 1] * inv); w0.y = pk2(o0[4 * gq + 2] * inv, o0[4 * gq + 3] * inv);
            w1.x = pk2(o1[4 * gq] * inv, o1[4 * gq + 1] * inv); w1.y = pk2(o1[4 * gq + 2] * inv, o1[4 * gq + 3] * inv);
            *(u32x2*)(orow + 8 * gq + 4 * hi) = w0; *(u32x2*)(orow + 32 + 8 * gq + 4 * hi) = w1; } }
#undef ATT_LOAD
#undef ATT_STORE
}
__device__ __forceinline__ void phase_attention(const Args& a, LAS unsigned char* lds, char* lds_gen) {
    const attn_body::AttnTensors AT{(const attn_body::bf16*)(a.ws + WS_BIG), (const attn_body::bf16*)(a.ws + WS_BIG) + (size_t)MT * DM, (const attn_body::bf16*)(a.ws + WS_BIG) + (size_t)2 * MT * DM,
                                    (attn_body::bf16*)(a.ws + WS_BIG) + (size_t)3 * MT * DM, (const float*)(a.ws + WS_CUMP)};
    const attn_body::StaticOrder S((int)gridDim.x, (int)blockIdx.x);
    attn_body::attn_phase<attn_body::StaticOrder>(lds_gen, AT, S);
    for (int u = blockIdx.x; u < NBS * NH; u += gridDim.x) attn_unit<true>(a, lds, u >> 4, u & 15, 0);
}

struct SampleOrder {
    int pn;
    __device__ __forceinline__ bool next(int i, pg8::Unit& u) const { if (i > 0 || pn < 0) return false; u.pm = MP / 256; u.pn = pn; return true; }
    __device__ __forceinline__ void a_ready(const pg8::Unit&) const {}
    __device__ __forceinline__ void done(const pg8::Unit&) const {}
};
constexpr int N_PHASES = 14;
__global__ void __launch_bounds__(512, 2) fox_ssd_fwd(Args a) {
    extern __shared__ __attribute__((aligned(16))) unsigned char lds_raw[];
    LAS unsigned char* lds = (LAS unsigned char*)lds_raw;
    const int lo = a.ph_lo, hi = a.ph_hi, G = gridDim.x, bx = blockIdx.x, tid = threadIdx.x;
#ifndef REPMASK
#define REPMASK 0
#endif
#ifndef PHMASK
#define PHMASK 0x3fff
#endif
#define IN(k) (((PHMASK >> (k)) & 1) && lo <= (k) && (k) < hi)
#ifndef FAST_BAR
#define FAST_BAR 1
#endif
#define SEAM(k) do { if (IN(k) && IN((k) + 1)) { if (a.coop) { if (!FAST_BAR || ((k) == 0 && a.pad != 0)) cg::this_grid().sync(); else xcd_barrier(xbar); } } } while (0)
    XcdBarrier xbar; xbar.bar = (unsigned*)a.ws; xbar.x = 0; xbar.st = nullptr;
    if (FAST_BAR && a.coop) { volatile LAS unsigned* stw = (volatile LAS unsigned*)(lds + 139264); if (tid < 2) stw[tid] = 0u; __syncthreads(); xbar = xcd_barrier_post((unsigned*)a.ws, stw); }
    bf16* WIN = (bf16*)(a.ws + WS_WIN); bf16* XN = (bf16*)(a.ws + WS_XN); bf16* BIG = (bf16*)(a.ws + WS_BIG); bf16* SG = (bf16*)(a.ws + WS_SG);
    bf16* QB = BIG; bf16* KB = BIG + (size_t)MT * DM; bf16* VB = KB + (size_t)MT * DM; bf16* TMP = VB + (size_t)MT * DM; bf16* SGA = SG; bf16* SGS = SG + (size_t)MT * DM;
    bf16* Z = (bf16*)(a.out + O_Y);
    if (IN(0)) for (int rep_ = 0; rep_ <= ((REPMASK >> 0) & 1); ++rep_) phase_prologue(a);
    SEAM(0);
    if (IN(1)) for (int rep_ = 0; rep_ <= ((REPMASK >> 1) & 1); ++rep_) { EpiP1 E{Z, BIG, (float*)(a.ws + WS_LOGF), (float*)(a.ws + WS_DT), a.out, a.b_f, a.dt_bias}; run_gemm(lds, XN, WIN, 25 * 256, DM, E);
        { const int spn = (int)bx - (G - 20); SampleOrder SO{(G == 256 && spn >= 0) ? spn : -1};
          EpiP3 ES{(bf16*)(a.ws + WS_QS) - (size_t)MP * DM, (bf16*)(a.ws + WS_KS) - (size_t)MP * DM, (bf16*)(a.ws + WS_VS) - (size_t)MP * DM, (bf16*)(a.ws + WS_SGAS) - (size_t)MP * DM, (bf16*)(a.ws + WS_SGSS) - (size_t)MP * DM, a.out, a.q_norm_w, a.k_norm_w};
          pg8::Gemm gs{XN, WIN + (size_t)25 * 256 * DM, MT, 20 * 256, DM};
          pg8::gemm_phase<EpiP3, SampleOrder, true, true>(lds, gs, SO, ES); } }
    SEAM(1);
    if (IN(2)) for (int rep_ = 0; rep_ <= ((REPMASK >> 2) & 1); ++rep_) {
        phase_bc_conv(a);
        if (G <= NBP * 7 * 8) { const int nC = NBP * 16 + NBS * 5; for (int it = G - 1 - bx; it < nC; it += G) cumsum_item(a, lds, it); }
    }
    SEAM(2);
    if (IN(3)) {
        const int nA = NBP * 7 * 8;
        for (int rep = 0; rep <= ((REPMASK >> 3) & 1); ++rep)
        for (int it = bx; it < nA; it += G) { const int g = it & 7, r = it >> 3; ssd_item(a, lds, 0, 0, r / 7, r % 7, g); }
        if (G > nA && bx >= nA) { const int nC = NBP * 16 + NBS * 5; for (int it = bx - nA; it < nC; it += G - nA) cumsum_item(a, lds, it); }
    }
    SEAM(3);
    if (IN(5)) {
        const int nP = NBP * 8 * 8, nS = NBS * 8;
        for (int rep = 0; rep <= ((REPMASK >> 5) & 1); ++rep)
        for (int it = bx; it < nP + nS; it += G) { if (it < nP) { const int g = it & 7, r = it >> 3; ssd_item(a, lds, 1, 0, r >> 3, r & 7, g); } else { const int r = it - nP; ssd_item(a, lds, 1, 1, r >> 3, 0, r & 7); } }
    }
    SEAM(5);
    if (IN(7)) for (int rep_ = 0; rep_ <= ((REPMASK >> 7) & 1); ++rep_) { EpiP3 E{QB, KB, VB, SGA, SGS, a.out, a.q_norm_w, a.k_norm_w}; run_gemm(lds, XN, WIN + (size_t)25 * 256 * DM, 20 * 256, DM, E, MP); }
    SEAM(7);
    if (IN(8)) { for (int rep = 0; rep <= ((REPMASK >> 8) & 1); ++rep) phase_attention(a, lds, (char*)lds_raw); }
    SEAM(8);
    if (IN(9)) for (int rep_ = 0; rep_ <= ((REPMASK >> 9) & 1); ++rep_) { EpiGate<0> E{SGA, nullptr, VB}; run_gemm(lds, TMP, (const bf16*)(a.ws + WS_WPA), DM, DM, E, MP); mini_gemm<0>(a, lds, TMP, (const bf16*)(a.ws + WS_WPA), DM, (const bf16*)(a.ws + WS_SGAS) - (size_t)MP * DM, nullptr, VB, nullptr, nullptr); }
    if (IN(10)) for (int rep_ = 0; rep_ <= ((REPMASK >> 10) & 1); ++rep_) { EpiGate<1> E{SGS, VB, KB}; run_gemm(lds, Z, (const bf16*)(a.ws + WS_WPB), DM, DI, E, MP); mini_gemm<1>(a, lds, Z, (const bf16*)(a.ws + WS_WPB), DI, (const bf16*)(a.ws + WS_SGSS) - (size_t)MP * DM, VB, KB, nullptr, nullptr); }
    SEAM(10);
    if (IN(11)) for (int rep_ = 0; rep_ <= ((REPMASK >> 11) & 1); ++rep_) { EpiRes E{a.x_prompt, a.x_sample, a.out, 1, XN, a.norm2_w, (float*)(a.ws + WS_LOGF)}; run_gemm(lds, KB, (const bf16*)(a.ws + WS_WOUT), DM, DM, E, MP); mini_gemm<2>(a, lds, KB, (const bf16*)(a.ws + WS_WOUT), DM, nullptr, nullptr, nullptr, XN, (float*)(a.ws + WS_LOGF)); }
    SEAM(11);
    if (IN(12)) for (int rep_ = 0; rep_ <= ((REPMASK >> 12) & 1); ++rep_) { EpiRelu2 E{BIG, FF, (const float*)(a.ws + WS_LOGF)}; run_gemm(lds, XN, (const bf16*)(a.ws + WS_WUP), FF, DM, E); }
    SEAM(12);
    if (IN(13)) { EpiRes E{nullptr, nullptr, a.out, 0, nullptr, nullptr, nullptr}; run_gemm(lds, BIG, (const bf16*)(a.ws + WS_WDN), DM, FF, E, MP); mini_gemm<3>(a, lds, BIG, (const bf16*)(a.ws + WS_WDN), FF, nullptr, nullptr, nullptr, nullptr, nullptr); }
#undef IN
#undef SEAM
}

extern "C" void kernel_launch(void* const* d_in, const int* in_sizes, int n_in, void* d_out, int out_size, void* d_ws, size_t ws_size, hipStream_t stream) {
    static int grid = 0;
    if (grid == 0) {
        if (n_in != 24 || (size_t)out_size != O_END || ws_size < WS_END) { fprintf(stderr, "kernel_launch: unexpected shapes: n_in %d out %d ws %zu\n", n_in, out_size, ws_size); grid = -1; return; }
        int dev = 0, cus = 0, per_cu = 0;
        if (hipGetDevice(&dev) != hipSuccess || hipDeviceGetAttribute(&cus, hipDeviceAttributeMultiprocessorCount, dev) != hipSuccess) { grid = -1; return; }
        if (hipFuncSetAttribute((const void*)fox_ssd_fwd, hipFuncAttributeMaxDynamicSharedMemorySize, LDS_BYTES) != hipSuccess) { fprintf(stderr, "kernel_launch: hipFuncSetAttribute failed\n"); grid = -1; return; }
        if (hipOccupancyMaxActiveBlocksPerMultiprocessor(&per_cu, (const void*)fox_ssd_fwd, 512, LDS_BYTES) != hipSuccess || per_cu < 1) per_cu = 1;
        (void)hipGetLastError();
        grid = cus * per_cu;
    }
    if (grid < 0) return;
    Args a{};
    const float** pp = (const float**)&a;
    for (int i = 0; i < 24; ++i) pp[i] = (const float*)d_in[i];
    a.out = (float*)d_out; a.ws = (unsigned char*)d_ws;
#if MK_MULTI
    for (int p = 0; p < N_PHASES; ++p) { a.ph_lo = p; a.ph_hi = p + 1; a.coop = 0; hipLaunchKernelGGL(fox_ssd_fwd, dim3(grid), dim3(512), LDS_BYTES, stream, a); }
#else
    a.ph_lo = 0; a.ph_hi = N_PHASES; a.coop = 1;
    (void)hipMemsetAsync(d_ws, 0, 16384, stream);
    void* args[] = {&a};
    hipError_t e = hipLaunchCooperativeKernel((const void*)fox_ssd_fwd, dim3(grid), dim3(512), args, LDS_BYTES, stream);
    if (e != hipSuccess) fprintf(stderr, "cooperative launch failed: %s (grid %d)\n", hipGetErrorString(e), grid);
#endif
}
```

```cpp
#include <hip/hip_runtime.h>
#include <hip/hip_cooperative_groups.h>
#include <cstdio>
#include <cstdint>
#include <cmath>
namespace cg = cooperative_groups;
namespace pg8 {
#define PG8_LAS __attribute__((address_space(3)))
typedef unsigned short bf16_t;
typedef short bf16x8 __attribute__((ext_vector_type(8)));
typedef float f32x4 __attribute__((ext_vector_type(4)));
typedef unsigned u32x4 __attribute__((ext_vector_type(4)));
constexpr int BM = 256, BK = 64, HALF = 128, HTB = HALF * BK * 2  , STAGE_BYTES = 8 * HTB, NXCD = 8, WGM = 8;

__host__ __device__ __forceinline__ int lds_byte(int r, int c) { const int st = (r >> 4) * 2 + (c >> 5), rr = r & 15, cc = c & 31, ob = rr * 64 + cc * 2; return st * 1024 + (ob ^ (((ob >> 9) & 1) << 5)); }
__host__ __device__ __forceinline__ void stage_rc(int b, int& R, int& C) { const int st = b / 1024, sb = b % 1024, swz = sb ^ (((sb >> 9) & 1) << 5); R = (st >> 1) * 16 + swz / 64; C = (st & 1) * 32 + (swz % 64) / 2; }
__host__ __device__ __forceinline__ int perm32(int rho) { const int n = rho >> 4, i = rho & 15; return 8 * (i >> 2) + 4 * n + (i & 3); }

struct Unit { int pm, pn; };
struct Gemm { const bf16_t* A; const bf16_t* Bt; int M, N, K; };

struct StaticOrder {
    int nM, nN, nwg, G, c;
    __host__ __device__ void init(int M, int N, int G_, int c_) { nM = M / BM; nN = N / BM; nwg = nM * nN; G = G_; c = c_; }
    __host__ __device__ bool next(int i, Unit& u) const {
        const long L = (long)i * G + c; if (L >= nwg) return false;
        int wgid = (int)L; { const int q = nwg / NXCD, r = nwg % NXCD, xcd = wgid % NXCD, off = wgid / NXCD; wgid = (xcd < r ? xcd * (q + 1) : r * (q + 1) + (xcd - r) * q) + off; }
        const int nig = WGM * nN, gid = wgid / nig, fm = gid * WGM, gsz = (nM - fm) < WGM ? (nM - fm) : WGM;
        u.pm = fm + ((wgid % nig) % gsz); u.pn = (wgid % nig) / gsz; return true;
    }
    __device__ __forceinline__ void a_ready(const Unit&) const {}
    __device__ __forceinline__ void done(const Unit&) const {}
};

__device__ __forceinline__ unsigned cvt_pk_bf16(float lo, float hi) { unsigned r; asm volatile("v_cvt_pk_bf16_f32 %0, %1, %2" : "=v"(r) : "v"(lo), "v"(hi)); return r; }
typedef float f32x2 __attribute__((ext_vector_type(2)));
template <class Epi, class Sched, bool ALIGN_EPI = false, bool SP2 = false>
__device__ __forceinline__ void gemm_phase(PG8_LAS unsigned char* lds, const Gemm g, const Sched& S, const Epi& E) {
    const int tid = threadIdx.x, wid = __builtin_amdgcn_readfirstlane(tid >> 6), lane = tid & 63, wr = wid >> 2, wc = wid & 3, fr = lane & 15, fq = lane >> 4;
    const int K = g.K, nt = K / BK;
    unsigned voffA[2], voffB[2];
#pragma unroll
    for (int i = 0; i < 2; ++i) { int R, C; stage_rc(tid * 16 + i * 8192, R, C); const int Rb = Epi::PERM ? ((R & ~31) + perm32(R & 31)) : R;
        voffA[i] = (unsigned)(R * K + C) * 2u; voffB[i] = (unsigned)(Rb * K + C) * 2u; }
    const size_t kstep = (size_t)(BK * 2);
    const size_t hstep = (size_t)HALF * K * 2;
    const size_t tstep = 2 * hstep;
    const unsigned ldsw = (unsigned)wid * 1024u;
    const int aoff = lds_byte(wr * 64 + fr, fq * 8), boff = lds_byte(wc * 32 + fr, fq * 8);
#define PG8_SA(b, h) (((b) * 2 + (h)) * HTB)
#define PG8_SB(b, h) ((4 + (b) * 2 + (h)) * HTB)
#define PG8_STAGE(bufoff, gbase, voff) do { _Pragma("unroll") for (int _i = 0; _i < 2; ++_i) \
        __builtin_amdgcn_global_load_lds((const unsigned*)((const char*)(gbase) + (voff)[_i]), (PG8_LAS unsigned*)(lds + (bufoff) + ldsw + _i * 8192), 16, 0, 0); } while (0)
#define PG8_LDA(dst, b, h) do { _Pragma("unroll") for (int m = 0; m < 4; ++m) _Pragma("unroll") for (int k = 0; k < 2; ++k) dst[m][k] = *(const PG8_LAS bf16x8*)(lds + PG8_SA(b, h) + aoff + m * 2048 + k * 1024); } while (0)
#define PG8_LDB(dst, b, h) do { _Pragma("unroll") for (int n = 0; n < 2; ++n) _Pragma("unroll") for (int k = 0; k < 2; ++k) dst[n][k] = *(const PG8_LAS bf16x8*)(lds + PG8_SB(b, h) + boff + n * 2048 + k * 1024); } while (0)
#define PG8_MMA(ai, bj, At, Bt) do { __builtin_amdgcn_s_setprio(1); _Pragma("unroll") for (int m = 0; m < 4; ++m) _Pragma("unroll") for (int n = 0; n < 2; ++n) _Pragma("unroll") for (int k = 0; k < 2; ++k) \
        acc[ai][bj][m][n] = __builtin_amdgcn_mfma_f32_16x16x32_bf16(Bt[n][k], At[m][k], acc[ai][bj][m][n], 0, 0, 0); __builtin_amdgcn_s_setprio(0); } while (0)
#define PG8_WAIT_V(n) asm volatile("s_waitcnt vmcnt(" #n ")" ::: "memory")
#define PG8_WAIT_L(n) asm volatile("s_waitcnt lgkmcnt(" #n ")" ::: "memory")
#define PG8_BAR __builtin_amdgcn_s_barrier()
#define PG8_SCHED __builtin_amdgcn_sched_barrier(0)
    Unit cur, nxt; int ui = 0;
    if (!S.next(0, cur)) return;
    f32x4 acc[2][2][4][2];
#pragma unroll
    for (int a = 0; a < 2; ++a)
#pragma unroll
        for (int b = 0; b < 2; ++b)
#pragma unroll
            for (int m = 0; m < 4; ++m)
#pragma unroll
                for (int n = 0; n < 2; ++n) acc[a][b][m][n] = (f32x4){0.f, 0.f, 0.f, 0.f};
    bf16x8 At[4][2], B0[2][2], B1[2][2];
    const char* cA = (const char*)g.A + (size_t)cur.pm * tstep; const char* cB = (const char*)g.Bt + (size_t)cur.pn * tstep;
    S.a_ready(cur);
    if constexpr (SP2) {
        PG8_STAGE(PG8_SB(0, 0), cB, voffB); PG8_STAGE(PG8_SB(0, 1), cB + hstep, voffB); PG8_STAGE(PG8_SA(0, 0), cA, voffA); PG8_STAGE(PG8_SA(0, 1), cA + hstep, voffA);
        if (wr == 1) PG8_BAR;
        PG8_WAIT_V(2); PG8_BAR;
        PG8_STAGE(PG8_SB(1, 0), cB + kstep, voffB); PG8_STAGE(PG8_SA(1, 0), cA + kstep, voffA); PG8_STAGE(PG8_SB(1, 1), cB + hstep + kstep, voffB);
        PG8_WAIT_V(6); PG8_BAR;
    } else {
        PG8_STAGE(PG8_SB(0, 0), cB, voffB); PG8_STAGE(PG8_SA(0, 0), cA, voffA); PG8_STAGE(PG8_SB(0, 1), cB + hstep, voffB); PG8_STAGE(PG8_SA(0, 1), cA + hstep, voffA);
        if (wr == 1) PG8_BAR;
        PG8_WAIT_V(4); PG8_BAR;
        PG8_STAGE(PG8_SB(1, 0), cB + kstep, voffB); PG8_STAGE(PG8_SA(1, 0), cA + kstep, voffA); PG8_STAGE(PG8_SB(1, 1), cB + hstep + kstep, voffB);
        PG8_WAIT_V(6); PG8_BAR;
    }
    for (;;) {
        const bool has_next = S.next(ui + 1, nxt);
        const char* nA = has_next ? (const char*)g.A + (size_t)nxt.pm * tstep : cA; const char* nB = has_next ? (const char*)g.Bt + (size_t)nxt.pn * tstep : cB;
        for (int t = 0; t < nt; t += 2) {
            const bool last = (t == nt - 2);
            const char* a1 = cA + (size_t)(t + 1) * kstep;
            const char* a2 = last ? nA : cA + (size_t)(t + 2) * kstep; const char* b2 = last ? nB : cB + (size_t)(t + 2) * kstep;
            const char* a3 = a2 + kstep; const char* b3 = b2 + kstep;
            if (last && has_next) S.a_ready(nxt);
            if constexpr (SP2) {
            PG8_LDB(B0, 0, 0); PG8_LDB(B1, 0, 1); PG8_SCHED; PG8_LDA(At, 0, 0); PG8_STAGE(PG8_SA(1, 1), a1 + hstep, voffA);
            PG8_WAIT_V(8); PG8_WAIT_L(0); PG8_BAR; PG8_MMA(0, 0, At, B0); PG8_MMA(0, 1, At, B1); PG8_BAR; PG8_SCHED;
            PG8_LDA(At, 0, 1); PG8_STAGE(PG8_SB(0, 0), b2, voffB); PG8_STAGE(PG8_SB(0, 1), b2 + hstep, voffB); PG8_STAGE(PG8_SA(0, 0), a2, voffA);
            PG8_WAIT_V(8); PG8_WAIT_L(0); PG8_BAR; PG8_MMA(1, 0, At, B0); PG8_MMA(1, 1, At, B1); PG8_BAR; PG8_SCHED;
            PG8_LDB(B0, 1, 0); PG8_LDB(B1, 1, 1); PG8_SCHED; PG8_LDA(At, 1, 0); PG8_STAGE(PG8_SA(0, 1), a2 + hstep, voffA);
            PG8_WAIT_V(8); PG8_WAIT_L(0); PG8_BAR; PG8_MMA(0, 0, At, B0); PG8_MMA(0, 1, At, B1); PG8_BAR; PG8_SCHED;
            PG8_LDA(At, 1, 1); PG8_STAGE(PG8_SB(1, 0), b3, voffB); PG8_STAGE(PG8_SB(1, 1), b3 + hstep, voffB); PG8_STAGE(PG8_SA(1, 0), a3, voffA);
            PG8_WAIT_V(8); PG8_WAIT_L(0); PG8_BAR; PG8_MMA(1, 0, At, B0); PG8_MMA(1, 1, At, B1); PG8_BAR; PG8_SCHED;
            } else {
            PG8_LDB(B0, 0, 0); PG8_SCHED; PG8_LDA(At, 0, 0); PG8_STAGE(PG8_SA(1, 1), a1 + hstep, voffA);
            PG8_WAIT_L(8); PG8_BAR; PG8_WAIT_L(0); PG8_MMA(0, 0, At, B0); PG8_BAR; PG8_SCHED;
            PG8_LDB(B1, 0, 1); PG8_STAGE(PG8_SB(0, 0), b2, voffB);
            PG8_BAR; PG8_WAIT_L(0); PG8_MMA(0, 1, At, B1); PG8_BAR;
            PG8_LDA(At, 0, 1); PG8_STAGE(PG8_SA(0, 0), a2, voffA);
            PG8_BAR; PG8_WAIT_L(0); PG8_MMA(1, 0, At, B0); PG8_BAR; PG8_SCHED;
            PG8_STAGE(PG8_SB(0, 1), b2 + hstep, voffB);
            PG8_WAIT_V(6); PG8_BAR; PG8_MMA(1, 1, At, B1); PG8_BAR;
            PG8_LDB(B0, 1, 0); PG8_SCHED; PG8_LDA(At, 1, 0); PG8_STAGE(PG8_SA(0, 1), a2 + hstep, voffA);
            PG8_WAIT_L(8); PG8_BAR; PG8_WAIT_L(0); PG8_MMA(0, 0, At, B0); PG8_BAR; PG8_SCHED;
            PG8_LDB(B1, 1, 1); PG8_STAGE(PG8_SB(1, 0), b3, voffB);
            PG8_BAR; PG8_WAIT_L(0); PG8_MMA(0, 1, At, B1); PG8_BAR;
            PG8_LDA(At, 1, 1); PG8_STAGE(PG8_SA(1, 0), a3, voffA);
            PG8_BAR; PG8_WAIT_L(0); PG8_MMA(1, 0, At, B0); PG8_BAR; PG8_SCHED;
            PG8_STAGE(PG8_SB(1, 1), b3 + hstep, voffB);
            PG8_WAIT_V(6); PG8_BAR; PG8_MMA(1, 1, At, B1); PG8_BAR;
            }
        }
        if constexpr (ALIGN_EPI) { if (wr == 0) PG8_BAR; }
        if constexpr (!Epi::AFTER_DRAIN) { E(acc, cur, wr, wc, fr, fq); S.done(cur); }
        if (!has_next) break;
#pragma unroll
        for (int a = 0; a < 2; ++a)
#pragma unroll
            for (int b = 0; b < 2; ++b)
#pragma unroll
                for (int m = 0; m < 4; ++m)
#pragma unroll
                    for (int n = 0; n < 2; ++n) acc[a][b][m][n] = (f32x4){0.f, 0.f, 0.f, 0.f};
        cur = nxt; cA = nA; cB = nB; ++ui;
        if constexpr (ALIGN_EPI) { if (wr == 1) PG8_BAR; }
    }
    PG8_WAIT_V(0);
    if constexpr (!ALIGN_EPI) { if (wr == 0) PG8_BAR; }
    PG8_BAR;
    if constexpr (Epi::AFTER_DRAIN) { E.fused(acc, cur, wr, wc, fr, fq, lds, wid, lane); S.done(cur); }
#undef PG8_SA
#undef PG8_SB
#undef PG8_STAGE
#undef PG8_LDA
#undef PG8_LDB
#undef PG8_MMA
#undef PG8_WAIT_V
#undef PG8_WAIT_L
#undef PG8_BAR
#undef PG8_SCHED
}
}

#ifndef MK_MULTI
#define MK_MULTI 0
#endif
#define LAS __attribute__((address_space(3)))
typedef unsigned short bf16;
typedef short bf16x8 __attribute__((ext_vector_type(8)));
typedef short s16x4 __attribute__((ext_vector_type(4)));
typedef float f32x4 __attribute__((ext_vector_type(4)));
typedef float f32x16 __attribute__((ext_vector_type(16)));
typedef unsigned u32x4 __attribute__((ext_vector_type(4)));
typedef unsigned u32x2 __attribute__((ext_vector_type(2)));

constexpr int DM = 1024, TP = 8192, NBP = 4, NBS = 8, TS = 32, PAST = 2048, MP = NBP * TP, MS = NBS * TS, MT = MP + MS;
constexpr int NH = 16, DI = 2048, NHS = 32, DST = 128, CONVD = 4096, DPROJ = 11312, FF = 4096, NWIN = 11520, SKV = PAST + TS;
constexpr float EPS = 1e-6f, LOG2E = 1.4426950408889634f, QSCALE = 0.125f * LOG2E;
constexpr size_t O_Y = 0, O_KP = (size_t)MT * DM, O_VP = O_KP + (size_t)MP * DM, O_LP = O_VP + (size_t)MP * DM, O_CP = O_LP + (size_t)MP * NH,
                 O_SP = O_CP + (size_t)NBP * 3 * CONVD, O_KS = O_SP + (size_t)NBP * NHS * 64 * DST, O_VS = O_KS + (size_t)MS * DM, O_LS = O_VS + (size_t)MS * DM,
                 O_CS = O_LS + (size_t)MS * NH, O_SS = O_CS + (size_t)NBS * 3 * CONVD, O_END = O_SS + (size_t)NBS * NHS * 64 * DST;
static_assert(O_END == 105271296, "d_out map");
constexpr size_t MiB = 1u << 20, U1 = (size_t)MT * DM * 2;
constexpr size_t WS_WIN = 1 * MiB, WS_WPA = 24 * MiB, WS_WPB = 26 * MiB, WS_WOUT = 30 * MiB, WS_WUP = 32 * MiB, WS_WDN = 40 * MiB;
constexpr size_t WS_LOGF = 48 * MiB, WS_CUMP = 51 * MiB, WS_CUMS = 53 * MiB, WS_DT = 55 * MiB, WS_SEGDEC = 59 * MiB + MiB / 2;
constexpr size_t WS_QS = 64 * 1024, WS_KS = 23 * MiB + MiB / 2, WS_VS = 50 * MiB + MiB / 4, WS_SGAS = 54 * MiB + MiB / 4, WS_SGSS = 511 * MiB + MiB / 2;
constexpr size_t WS_XN = 60 * MiB, WS_BIG = WS_XN + U1, WS_SG = WS_BIG + 4 * U1, WS_END = WS_SG + 2 * U1 + MiB / 2;
static_assert(WS_END <= 512 * MiB, "d_ws map");
constexpr int LDS_BYTES = 147456;

struct Args {
    const float *x_prompt, *x_sample, *cache_k, *cache_v, *cache_logf, *state_conv, *state_ssm, *norm1_w, *w_in, *b_f, *q_norm_w, *k_norm_w, *conv_w, *conv_b,
        *dt_bias, *A_log, *D_skip, *ssm_norm_w, *w_pa, *w_pb, *w_out, *norm2_w, *w_up, *w_down;
    float* out; unsigned char* ws; int ph_lo, ph_hi, coop, pad;
};

__device__ __forceinline__ unsigned f2bf(float f) { unsigned u = __builtin_bit_cast(unsigned, f); return (u + 0x7fffu + ((u >> 16) & 1u)) >> 16; }
typedef float f32x2_t __attribute__((ext_vector_type(2))); typedef __bf16 bf16x2_t __attribute__((ext_vector_type(2)));
__device__ __forceinline__ unsigned pk2(float lo, float hi) { f32x2_t v = {lo, hi}; bf16x2_t b = __builtin_convertvector(v, bf16x2_t); return __builtin_bit_cast(unsigned, b); }
__device__ __forceinline__ float bflo(unsigned w) { return __uint_as_float(w << 16); }
__device__ __forceinline__ float bfhi(unsigned w) { return __uint_as_float(w & 0xffff0000u); }
__device__ __forceinline__ float bf2f(bf16 v) { return __uint_as_float(((unsigned)v) << 16); }
__device__ __forceinline__ float wave_sum(float v) {
#pragma unroll
    for (int o = 1; o < 64; o <<= 1) v += __shfl_xor(v, o);
    return v;
}
__device__ __forceinline__ float sigmoidf_(float x) { return __builtin_amdgcn_rcpf(1.f + __expf(-x)); }
__device__ __forceinline__ float softplusf_(float x) { return fmaxf(x, 0.f) + __logf(1.f + __expf(-fabsf(x))); }
__device__ __forceinline__ const float* xrow_ptr(const Args& a, int m) { return m < MP ? a.x_prompt + (size_t)m * DM : a.x_sample + (size_t)(m - MP) * DM; }

__device__ __forceinline__ int win_src_col(int n) {
    if (n < 2048) return 3088 + n;
    if (n < 6144) return 5136 + (n - 2048);
    if (n < 6400) { const int j = n - 6144; if (j < 16) return 3072 + j; if (j < 48) return 9232 + (j - 16); return -1; }
    if (n < 8448) { int p = n - 6400; const int isk = p >= 1024; p &= 1023; const int tq = p >> 8, pp = p & 255, bj = pp >> 7, wc = (pp & 127) >> 5, e = pp & 31;
                    return (isk ? 1024 : 0) + (4 * tq + wc) * 64 + 32 * bj + e; }
    if (n < 9472) return 2048 + (n - 8448);
    if (n < 10496) return 9264 + (n - 9472);
    return 10288 + (n - 10496);
}
__device__ __forceinline__ void wt_item(const float* __restrict__ W, int K, int N, bf16* WT, int nblk, int item, bool is_win, int tid) {
    const int nb = item % nblk, kb = item / nblk, n = nb * 64 + (tid & 63), k0 = kb * 64 + (tid >> 6) * 8;
    const int sc = is_win ? win_src_col(n) : n;
    float v[8];
#pragma unroll
    for (int i = 0; i < 8; ++i) v[i] = sc >= 0 ? W[(size_t)(k0 + i) * N + sc] : 0.f;
    u32x4 o; o.x = pk2(v[0], v[1]); o.y = pk2(v[2], v[3]); o.z = pk2(v[4], v[5]); o.w = pk2(v[6], v[7]);
    *(u32x4*)(WT + (size_t)n * K + k0) = o;
}
__device__ __forceinline__ void rms_row_to_bf16(const float* xrow, const float* w, bf16* orow, int lane) {
    const f32x4* xr = (const f32x4*)xrow + lane; f32x4 v[4]; float s = 0.f;
#pragma unroll
    for (int j = 0; j < 4; ++j) { v[j] = xr[64 * j]; s += (v[j].x * v[j].x + v[j].y * v[j].y) + (v[j].z * v[j].z + v[j].w * v[j].w); }
    const float rstd = rsqrtf(wave_sum(s) * (1.f / DM) + EPS);
#pragma unroll
    for (int j = 0; j < 4; ++j) { const f32x4 wv = ((const f32x4*)w)[lane + 64 * j]; u32x2 o; o.x = pk2(v[j].x * rstd * wv.x, v[j].y * rstd * wv.y); o.y = pk2(v[j].z * rstd * wv.z, v[j].w * rstd * wv.w);
        *((u32x2*)orow + lane + 64 * j) = o; }
}
__device__ __forceinline__ void phase_prologue(const Args& a) {
    const int tid = threadIdx.x, lane = tid & 63, wid = tid >> 6, G = gridDim.x, bx = blockIdx.x;
    constexpr int I_WIN = (NWIN / 64) * (DM / 64), I_PA = 16 * 16, I_PB = 16 * 32, I_OUT = 16 * 16, I_UP = 64 * 16, I_DN = 16 * 64, NIT = I_WIN + I_PA + I_PB + I_OUT + I_UP + I_DN;
    for (int it = bx; it < NIT; it += G) {
        int r = it;
        if (r < I_WIN) { wt_item(a.w_in, DM, DPROJ, (bf16*)(a.ws + WS_WIN), NWIN / 64, r, true, tid); continue; } r -= I_WIN;
        if (r < I_PA) { wt_item(a.w_pa, DM, DM, (bf16*)(a.ws + WS_WPA), 16, r, false, tid); continue; } r -= I_PA;
        if (r < I_PB) { wt_item(a.w_pb, DI, DM, (bf16*)(a.ws + WS_WPB), 16, r, false, tid); continue; } r -= I_PB;
        if (r < I_OUT) { wt_item(a.w_out, DM, DM, (bf16*)(a.ws + WS_WOUT), 16, r, false, tid); continue; } r -= I_OUT;
        if (r < I_UP) { wt_item(a.w_up, DM, FF, (bf16*)(a.ws + WS_WUP), 64, r, false, tid); continue; } r -= I_UP;
        wt_item(a.w_down, FF, DM, (bf16*)(a.ws + WS_WDN), 16, r, false, tid);
    }
    bf16* XN = (bf16*)(a.ws + WS_XN);
    for (int m = bx * 8 + wid; m < MT; m += G * 8) rms_row_to_bf16(xrow_ptr(a, m), a.norm1_w, XN + (size_t)m * DM, lane);
}

#define EPI_ROW(u, ai, m) ((u).pm * 256 + (ai) * 128 + wr * 64 + (m) * 16 + fr)
#define EPI_CB(bj) ((bj) * 128 + wc * 32 + 8 * fq)
__device__ __forceinline__ u32x4 pack8(const f32x4 v0, const f32x4 v1) { u32x4 w; w.x = pk2(v0[0], v0[1]); w.y = pk2(v0[2], v0[3]); w.z = pk2(v1[0], v1[1]); w.w = pk2(v1[2], v1[3]); return w; }

struct EpiP1 {
    static constexpr bool PERM = true, AFTER_DRAIN = false;
    bf16* Z; bf16* XBC; float* logf_ws; float* dt_ws; float* out; const float* b_f; const float* dt_bias;
    __device__ __forceinline__ void operator()(const pg8::f32x4 (&acc)[2][2][4][2], const pg8::Unit& u, int wr, int wc, int fr, int fq) const {
        const int pn = u.pn;
        if (pn < 24) {
            bf16* base; int ldc, colt;
            if (pn < 8) { base = Z; ldc = DI; colt = pn * 256; } else { base = XBC; ldc = CONVD; colt = (pn - 8) * 256; }
#pragma unroll
            for (int ai = 0; ai < 2; ++ai)
#pragma unroll
                for (int m = 0; m < 4; ++m) { const int row = EPI_ROW(u, ai, m);
#pragma unroll
                    for (int bj = 0; bj < 2; ++bj) *(u32x4*)(base + (size_t)row * ldc + colt + EPI_CB(bj)) = pack8(acc[ai][bj][m][0], acc[ai][bj][m][1]);
                }
        } else if (wc < 2) {
#pragma unroll
            for (int ai = 0; ai < 2; ++ai)
#pragma unroll
                for (int m = 0; m < 4; ++m) { const int row = EPI_ROW(u, ai, m);
#pragma unroll
                    for (int n = 0; n < 2; ++n)
#pragma unroll
                        for (int i = 0; i < 4; ++i) { const int c = 32 * wc + 8 * fq + 4 * n + i; const float v = acc[ai][0][m][n][i];
                            if (c < 16) logf_ws[(size_t)row * 16 + c] = v; else if (c < 48) dt_ws[(size_t)row * 32 + (c - 16)] = v; }
                }
        }
    }
};

struct EpiP3 {
    static constexpr bool PERM = true, AFTER_DRAIN = false;
    bf16* QB; bf16* KB; bf16* VB; bf16* SGA; bf16* SGS; float* out; const float* qw; const float* kw;
    __device__ __forceinline__ void operator()(const pg8::f32x4 (&acc)[2][2][4][2], const pg8::Unit& u, int wr, int wc, int fr, int fq) const {
        const int pn = u.pn;
        if (pn < 8) {
            const bool isk = pn >= 4; const int head = 4 * (pn & 3) + wc; const float* nw = isk ? kw : qw;
            f32x4 wv[2][2];
#pragma unroll
            for (int bj = 0; bj < 2; ++bj)
#pragma unroll
                for (int n = 0; n < 2; ++n) wv[bj][n] = *(const f32x4*)(nw + 32 * bj + 8 * fq + 4 * n);
#pragma unroll
            for (int ai = 0; ai < 2; ++ai)
#pragma unroll
                for (int m = 0; m < 4; ++m) { const int row = EPI_ROW(u, ai, m); float ss = 0.f;
#pragma unroll
                    for (int bj = 0; bj < 2; ++bj)
#pragma unroll
                        for (int n = 0; n < 2; ++n) { const f32x4 x = acc[ai][bj][m][n]; ss += (x[0] * x[0] + x[1] * x[1]) + (x[2] * x[2] + x[3] * x[3]); }
                    ss += __shfl_xor(ss, 16); ss += __shfl_xor(ss, 32);
                    const float rstd = rsqrtf(ss * (1.f / 64.f) + EPS), sc = isk ? rstd : rstd * QSCALE;
                    float* ko = (row < MP) ? out + O_KP + (size_t)row * DM : out + O_KS + (size_t)(row - MP) * DM;
#pragma unroll
                    for (int bj = 0; bj < 2; ++bj) { const f32x4 v0 = acc[ai][bj][m][0] * wv[bj][0] * sc, v1 = acc[ai][bj][m][1] * wv[bj][1] * sc; const int col = head * 64 + 32 * bj + 8 * fq;
                        *(u32x4*)((isk ? KB : QB) + (size_t)row * DM + col) = pack8(v0, v1);
                        if (isk) { *(f32x4*)(ko + col) = v0; *(f32x4*)(ko + col + 4) = v1; } }
                }
        } else if (pn < 12) {
#pragma unroll
            for (int ai = 0; ai < 2; ++ai)
#pragma unroll
                for (int m = 0; m < 4; ++m) { const int row = EPI_ROW(u, ai, m); float* vo = (row < MP) ? out + O_VP + (size_t)row * DM : out + O_VS + (size_t)(row - MP) * DM;
#pragma unroll
                    for (int bj = 0; bj < 2; ++bj) { const int col = (pn - 8) * 256 + EPI_CB(bj); *(u32x4*)(VB + (size_t)row * DM + col) = pack8(acc[ai][bj][m][0], acc[ai][bj][m][1]);
                        *(f32x4*)(vo + col) = acc[ai][bj][m][0]; *(f32x4*)(vo + col + 4) = acc[ai][bj][m][1]; } }
        } else {
            bf16* G = pn < 16 ? SGA : SGS; const int colt = ((pn - 12) & 3) * 256;
#pragma unroll
            for (int ai = 0; ai < 2; ++ai)
#pragma unroll
                for (int m = 0; m < 4; ++m) { const int row = EPI_ROW(u, ai, m);
#pragma unroll
                    for (int bj = 0; bj < 2; ++bj) { f32x4 v0 = acc[ai][bj][m][0], v1 = acc[ai][bj][m][1];
#pragma unroll
                        for (int i = 0; i < 4; ++i) { v0[i] = sigmoidf_(v0[i]); v1[i] = sigmoidf_(v1[i]); }
                        *(u32x4*)(G + (size_t)row * DM + colt + EPI_CB(bj)) = pack8(v0, v1); } }
        }
    }
};

template <int MODE> struct EpiGate {
    static constexpr bool PERM = true, AFTER_DRAIN = false;
    const bf16* G; const bf16* T; bf16* O;
    __device__ __forceinline__ void operator()(const pg8::f32x4 (&acc)[2][2][4][2], const pg8::Unit& u, int wr, int wc, int fr, int fq) const {
#pragma unroll
        for (int ai = 0; ai < 2; ++ai)
#pragma unroll
            for (int m = 0; m < 4; ++m) { const int row = EPI_ROW(u, ai, m);
#pragma unroll
                for (int bj = 0; bj < 2; ++bj) { const size_t off = (size_t)row * DM + u.pn * 256 + EPI_CB(bj); const u32x4 g = *(const u32x4*)(G + off);
                    f32x4 v0 = acc[ai][bj][m][0], v1 = acc[ai][bj][m][1];
                    v0[0] *= bflo(g.x); v0[1] *= bfhi(g.x); v0[2] *= bflo(g.y); v0[3] *= bfhi(g.y); v1[0] *= bflo(g.z); v1[1] *= bfhi(g.z); v1[2] *= bflo(g.w); v1[3] *= bfhi(g.w);
                    if (MODE == 1) { const u32x4 t = *(const u32x4*)(T + off);
                        v0[0] += bflo(t.x); v0[1] += bfhi(t.x); v0[2] += bflo(t.y); v0[3] += bfhi(t.y); v1[0] += bflo(t.z); v1[1] += bfhi(t.z); v1[2] += bflo(t.w); v1[3] += bfhi(t.w); }
                    *(u32x4*)(O + off) = pack8(v0, v1); } }
    }
};

struct EpiRes {
    static constexpr bool PERM = true, AFTER_DRAIN = false;
    const float* xp; const float* xs; float* out; int xin; bf16* xw; const float* nw; float* part;
    __device__ __forceinline__ void operator()(const pg8::f32x4 (&acc)[2][2][4][2], const pg8::Unit& u, int wr, int wc, int fr, int fq) const {
#pragma unroll
        for (int ai = 0; ai < 2; ++ai)
#pragma unroll
            for (int m = 0; m < 4; ++m) { const int row = EPI_ROW(u, ai, m);
                const float* b = xin ? ((row < MP) ? xp + (size_t)row * DM : xs + (size_t)(row - MP) * DM) : out + (size_t)row * DM; float* o = out + (size_t)row * DM; float ss = 0.f;
#pragma unroll
                for (int bj = 0; bj < 2; ++bj) { const int col = u.pn * 256 + EPI_CB(bj); const f32x4 b0 = *(const f32x4*)(b + col), b1 = *(const f32x4*)(b + col + 4);
                    const f32x4 v0 = b0 + acc[ai][bj][m][0], v1 = b1 + acc[ai][bj][m][1];
                    *(f32x4*)(o + col) = v0; *(f32x4*)(o + col + 4) = v1;
                    if (xw) { const f32x4 w0 = *(const f32x4*)(nw + col), w1 = *(const f32x4*)(nw + col + 4); *(u32x4*)(xw + (size_t)row * DM + col) = pack8(v0 * w0, v1 * w1);
                        ss += (v0[0] * v0[0] + v0[1] * v0[1]) + (v0[2] * v0[2] + v0[3] * v0[3]) + (v1[0] * v1[0] + v1[1] * v1[1]) + (v1[2] * v1[2] + v1[3] * v1[3]); } }
                if (xw) { ss += __shfl_xor(ss, 16); ss += __shfl_xor(ss, 32); if (fq == 0) part[(size_t)row * 16 + u.pn * 4 + wc] = ss; } }
    }
};

struct EpiRelu2 {
    static constexpr bool PERM = true, AFTER_DRAIN = false;
    bf16* O; int ldc; const float* part;
    __device__ __forceinline__ void operator()(const pg8::f32x4 (&acc)[2][2][4][2], const pg8::Unit& u, int wr, int wc, int fr, int fq) const {
#pragma unroll
        for (int ai = 0; ai < 2; ++ai)
#pragma unroll
            for (int m = 0; m < 4; ++m) { const int row = EPI_ROW(u, ai, m); const f32x4* pp = (const f32x4*)(part + (size_t)row * 16);
                const f32x4 s4 = (pp[0] + pp[1]) + (pp[2] + pp[3]); const float rstd = rsqrtf(((s4[0] + s4[1]) + (s4[2] + s4[3])) * (1.f / DM) + EPS);
#pragma unroll
                for (int bj = 0; bj < 2; ++bj) { f32x4 v0 = acc[ai][bj][m][0], v1 = acc[ai][bj][m][1];
#pragma unroll
                    for (int i = 0; i < 4; ++i) { const float a0 = fmaxf(v0[i], 0.f) * rstd, a1 = fmaxf(v1[i], 0.f) * rstd; v0[i] = a0 * a0; v1[i] = a1 * a1; }
                    *(u32x4*)(O + (size_t)row * ldc + u.pn * 256 + EPI_CB(bj)) = pack8(v0, v1); } }
    }
};

template <class Epi> __device__ __forceinline__ void run_gemm(LAS unsigned char* lds, const bf16* A, const bf16* Bt, int N, int K, const Epi& E, int M = MT) {
    pg8::Gemm g{A, Bt, M, N, K}; pg8::StaticOrder S; S.init(M, N, (int)gridDim.x, (int)blockIdx.x);
    pg8::gemm_phase<Epi, pg8::StaticOrder, true, true>(lds, g, S, E);
}
template <int MODE, int NCB = 16> __device__ __forceinline__ void mini_gemm(const Args& a, LAS unsigned char* lds, const bf16* A, const bf16* Bt, const int K, const bf16* Gt, const bf16* T, bf16* O, bf16* XW, float* part) {
    const int tid = threadIdx.x, lane = tid & 63, wid = __builtin_amdgcn_readfirstlane(tid >> 6), fr = lane & 15, fq = lane >> 4;
    LAS float* RED = (LAS float*)lds;
    typedef float f32x2v __attribute__((ext_vector_type(2)));
    for (int pc = blockIdx.x; pc < 16 * NCB; pc += gridDim.x) {
        const int row0 = MP + 16 * (pc / NCB), col0 = 64 * (pc % NCB), KS = K >> 8;
        f32x4 acc[4];
#pragma unroll
        for (int ct = 0; ct < 4; ++ct) acc[ct] = (f32x4){0.f, 0.f, 0.f, 0.f};
        const bf16* ap = A + (size_t)(row0 + fr) * K + (size_t)wid * (K >> 3) + 8 * fq;
        const bf16* bp = Bt + (size_t)(col0 + fr) * K + (size_t)wid * (K >> 3) + 8 * fq;
        for (int s0 = 0; s0 < KS; s0 += 4) {
            bf16x8 av[4], bv[4][4];
#pragma unroll
            for (int s = 0; s < 4; ++s) { av[s] = *(const bf16x8*)(ap + (s0 + s) * 32);
#pragma unroll
                for (int ct = 0; ct < 4; ++ct) bv[s][ct] = *(const bf16x8*)(bp + (size_t)(16 * ct) * K + (s0 + s) * 32); }
#pragma unroll
            for (int s = 0; s < 4; ++s)
#pragma unroll
                for (int ct = 0; ct < 4; ++ct) acc[ct] = __builtin_amdgcn_mfma_f32_16x16x32_bf16(bv[s][ct], av[s], acc[ct], 0, 0, 0);
        }
#pragma unroll
        for (int ct = 0; ct < 4; ++ct) *(LAS f32x4*)(RED + (wid * 16 + fr) * 64 + 16 * ct + 4 * fq) = acc[ct];
        __syncthreads();
        const int r = tid >> 5, c2 = (tid & 31) * 2; float v0 = 0.f, v1 = 0.f;
#pragma unroll
        for (int w = 0; w < 8; ++w) { const f32x2v t = *(const LAS f32x2v*)(RED + (w * 16 + r) * 64 + c2); v0 += t.x; v1 += t.y; }
        const int row = row0 + r, col = col0 + c2; const size_t off = (size_t)row * DM + col;
        if (MODE == 0 || MODE == 1) { const unsigned g = *(const unsigned*)(Gt + off); v0 *= bflo(g); v1 *= bfhi(g);
            if (MODE == 1) { const unsigned t = *(const unsigned*)(T + off); v0 += bflo(t); v1 += bfhi(t); }
            *(unsigned*)(O + off) = pk2(v0, v1); }
        if (MODE == 2) { const f32x2v x = *(const f32x2v*)(a.x_sample + (size_t)(row - MP) * DM + col), w = *(const f32x2v*)(a.norm2_w + col); v0 += x.x; v1 += x.y;
            *(f32x2v*)(a.out + off) = (f32x2v){v0, v1}; *(unsigned*)(XW + off) = pk2(v0 * w.x, v1 * w.y);
            float ss = v0 * v0 + v1 * v1;
#pragma unroll
            for (int o = 1; o < 32; o <<= 1) ss += __shfl_xor(ss, o);
            if ((tid & 31) == 0) part[(size_t)row * 16 + (pc & 15)] = ss; }
        if (MODE == 3) { f32x2v y = *(const f32x2v*)(a.out + off); y.x += v0; y.y += v1; *(f32x2v*)(a.out + off) = y; }
        if (MODE == 4) { const f32x4* pp = (const f32x4*)(part + (size_t)row * 16); const f32x4 s4 = (pp[0] + pp[1]) + (pp[2] + pp[3]); const float rstd = rsqrtf(((s4[0] + s4[1]) + (s4[2] + s4[3])) * (1.f / DM) + EPS);
            const float a0 = fmaxf(v0, 0.f) * rstd, a1 = fmaxf(v1, 0.f) * rstd; *(unsigned*)(O + (size_t)row * (64 * NCB) + col) = pk2(a0 * a0, a1 * a1); }
        __syncthreads();
    }
}

__device__ __forceinline__ float logf_at(const Args& a, const float* LOGF, int smp, int b, int t, int h, float bf) {
    if (smp) return t < PAST ? a.cache_logf[((size_t)b * PAST + t) * 16 + h] : -softplusf_(-(LOGF[((size_t)MP + b * TS + (t - PAST)) * 16 + h] + bf));
    return -softplusf_(-(LOGF[((size_t)b * TP + t) * 16 + h] + bf));
}
constexpr size_t WS_BTOT = WS_SEGDEC + 8192;
__device__ __forceinline__ void cumsum_item(const Args& a, LAS unsigned char* lds, int item) {
    const int tid = threadIdx.x, h = tid & 15, j = tid >> 4;
    LAS float* S = (LAS float*)lds;
    const float* LOGF = (const float*)(a.ws + WS_LOGF);
    const int smp = item >= NBP * 16; const int b = smp ? (item - NBP * 16) / 5 : item >> 4, blk = smp ? (item - NBP * 16) % 5 : item & 15;
    const int sl = smp ? 13 : 16, t0 = blk * 32 * sl;
    float* dst = smp ? (float*)(a.ws + WS_CUMS) + (size_t)b * SKV * 16 : (float*)(a.ws + WS_CUMP) + (size_t)b * TP * 16;
    const float bf = a.b_f[h];
    float off = 0.f;
    const int nit = smp ? (t0 >> 5) : 0;
    for (int i0 = 0; i0 < nit; i0 += 8) { float pv[8];
#pragma unroll
        for (int u = 0; u < 8; ++u) pv[u] = (i0 + u < nit) ? logf_at(a, LOGF, smp, b, j + 32 * (i0 + u), h, bf) : 0.f;
#pragma unroll
        for (int u = 0; u < 8; ++u) off += pv[u]; }
    float v[16]; float s = 0.f;
#pragma unroll
    for (int i = 0; i < 16; ++i) { v[i] = (i < sl) ? logf_at(a, LOGF, smp, b, t0 + j * sl + i, h, bf) : 0.f; s += v[i]; }
    S[j * 16 + h] = off; S[512 + j * 16 + h] = s; __syncthreads();
    float run = 0.f;
    for (int k = 0; k < 32; ++k) run += S[k * 16 + h];
    for (int k = 0; k < j; ++k) run += S[512 + k * 16 + h];
#pragma unroll
    for (int i = 0; i < 16; ++i) if (i < sl) { const int t = t0 + j * sl + i; run += v[i]; if (smp) dst[(size_t)t * 16 + h] = run; else dst[((size_t)h * TP) + t] = run;
        if (!smp) a.out[O_LP + ((size_t)b * TP + t) * 16 + h] = v[i]; else if (t >= PAST) a.out[O_LS + ((size_t)b * TS + (t - PAST)) * 16 + h] = v[i]; }
    if (j == 31) ((float*)(a.ws + WS_BTOT))[item * 16 + h] = run;
    __syncthreads();
}
__device__ __forceinline__ void cumsum_fixup(const Args& a, LAS unsigned char* lds) {
    const int tid = threadIdx.x;
    LAS float* OFF = (LAS float*)lds;
    const float* BT = (const float*)(a.ws + WS_BTOT);
    for (int e = tid; e < NBP * 16 * 16; e += 512) { const int blk = (e >> 4) & 15; float o = 0.f;
        for (int k = 0; k < blk; ++k) o += BT[e - 16 * (blk - k)];
        OFF[e] = o; }
    __syncthreads();
    float* CP = (float*)(a.ws + WS_CUMP);
    for (int e = blockIdx.x * 512 + tid; e < NBP * 16 * TP; e += gridDim.x * 512) CP[e] = -(CP[e] + OFF[((((e >> 17) << 4) + ((e >> 9) & 15)) << 4) + ((e >> 13) & 15)]) * LOG2E;
    __syncthreads();
}
__device__ __forceinline__ void phase_gate_norm(const Args& a) {
    const int tid = threadIdx.x, lane = tid & 63, wid = tid >> 6, G = gridDim.x;
    bf16* Z = (bf16*)(a.out + O_Y); const bf16* YR = (const bf16*)(a.ws + WS_BIG);
    for (int m = blockIdx.x * 8 + wid; m < MT; m += G * 8) {
#pragma unroll 2
        for (int gi = 0; gi < 8; ++gi) { const size_t off = (size_t)m * DI + gi * 256 + 4 * lane;
            const u32x2 yr = *(const u32x2*)(YR + off), zz = *(const u32x2*)(Z + off); const f32x4 wv = *(const f32x4*)(a.ssm_norm_w + gi * 256 + 4 * lane);
            float y[4] = {bflo(yr.x), bfhi(yr.x), bflo(yr.y), bfhi(yr.y)}; const float z[4] = {bflo(zz.x), bfhi(zz.x), bflo(zz.y), bfhi(zz.y)};
            float ss = 0.f;
#pragma unroll
            for (int i = 0; i < 4; ++i) { y[i] = y[i] * z[i] * sigmoidf_(z[i]); ss += y[i] * y[i]; }
            const float rstd = rsqrtf(wave_sum(ss) * (1.f / 256.f) + EPS);
            u32x2 o; o.x = pk2(y[0] * rstd * wv.x, y[1] * rstd * wv.y); o.y = pk2(y[2] * rstd * wv.z, y[3] * rstd * wv.w); *(u32x2*)(Z + off) = o; }
    }
}
#ifndef ATT_THRL
#define ATT_THRL 90
#endif
#include <hip/hip_bf16.h>
namespace attn_body {
using bf16=__hip_bfloat16;
using bf16x8=__attribute__((ext_vector_type(8)))short;
using s16x4=__attribute__((ext_vector_type(4)))short;
using f32x16=__attribute__((ext_vector_type(16)))float;
using u32x4=__attribute__((ext_vector_type(4)))unsigned;
constexpr int BATCH=4,NHEAD=16,SEQ=8192,D=64,DM=NHEAD*D;
constexpr int NW=8,QBLK=32,QB=QBLK*NW,KVBLK=64,NQB=SEQ/QB;
constexpr int ATTN_PITCH=DM, ATTN_UNIT_ROWS=QB;
__device__ __forceinline__ int crow(int r,int hi){return (r&3)+8*(r>>2)+4*hi;}
#define SBAR() __builtin_amdgcn_sched_barrier(0)
__device__ __forceinline__ void cmask(f32x16&p0,f32x16&p1,int jb,int qrel,int hi){
  const float NEG=-INFINITY; int kb=64*jb+4*hi;
  #pragma unroll
  for(int r=0;r<16;++r){int kv=kb+(r&3)+8*(r>>2); if(kv>qrel)p0[r]=NEG; if(kv+32>qrel)p1[r]=NEG;}
}

constexpr int NSLOT=3, SLOTB=8192;
constexpr int LDS_K=0, LDS_V=NSLOT*SLOTB, LDS_WS=2*NSLOT*SLOTB, LDS_OST=LDS_WS+NW*64*4, LDS_BYTES=LDS_OST+NW*4096, LDS_BIAS=86016;
constexpr float C2=0.125f*1.4426950408889634f;
__device__ __forceinline__ void glds16(const void*gsrc,unsigned lds_dst){unsigned keep;
  asm volatile("s_mov_b32 %0, m0\n\ts_mov_b32 m0, %2\n\ts_nop 0\n\tglobal_load_lds_dwordx4 %1, off\n\ts_mov_b32 m0, %0":"=&s"(keep):"v"(gsrc),"s"(lds_dst):"memory");}
__device__ __forceinline__ float max3f(float a,float b,float c){float r;asm("v_max3_f32 %0, %1, %2, %3":"=v"(r):"v"(a),"v"(b),"v"(c));return r;}
__device__ __forceinline__ float max2f(float a,float b){float r;asm("v_max_f32_e32 %0, %1, %2":"=v"(r):"v"(a),"v"(b));return r;}
__device__ __forceinline__ float fadd_s(float a,float b){float r;asm("v_add_f32_e32 %0, %1, %2":"=v"(r):"v"(a),"v"(b));return r;}
__device__ __forceinline__ float fsub_s(float a,float b){float r;asm("v_sub_f32_e32 %0, %1, %2":"=v"(r):"v"(a),"v"(b));return r;}
typedef float f32x2_t __attribute__((ext_vector_type(2))); typedef __bf16 bf16x2_t __attribute__((ext_vector_type(2)));
__device__ __forceinline__ unsigned cvtpk_s(float lo,float hi){f32x2_t v={lo,hi};bf16x2_t b=__builtin_convertvector(v,bf16x2_t);return __builtin_bit_cast(unsigned,b);}
#define WAIT_BAR(N) asm volatile("s_waitcnt vmcnt(" #N ") lgkmcnt(0)\n\ts_barrier":::"memory")

__device__ __forceinline__ void qkt(f32x16&p0,f32x16&p1,const char*Kslot,const bf16x8*qr,const f32x16&i0,const f32x16&i1,int r32,int hi){
  const char*kb=Kslot+hi*1024+r32*16;
  #pragma unroll
  for(int d0=0;d0<4;++d0){
    const bf16x8 b0=*reinterpret_cast<const bf16x8*>(kb+d0*2048);
    const bf16x8 b1=*reinterpret_cast<const bf16x8*>(kb+d0*2048+512);
    if(d0==0){p0=__builtin_amdgcn_mfma_f32_32x32x16_bf16(b0,qr[0],i0,0,0,0);p1=__builtin_amdgcn_mfma_f32_32x32x16_bf16(b1,qr[0],i1,0,0,0);}
    else{p0=__builtin_amdgcn_mfma_f32_32x32x16_bf16(b0,qr[d0],p0,0,0,0);p1=__builtin_amdgcn_mfma_f32_32x32x16_bf16(b1,qr[d0],p1,0,0,0);}}
}
typedef __attribute__((address_space(3))) const char* lds_cptr;
typedef short v4i16_t __attribute__((ext_vector_type(4)));
__device__ __forceinline__ void kload8(bf16x8*kf,lds_cptr kp){
  kf[0]=*(const __attribute__((address_space(3))) bf16x8*)(kp);      kf[1]=*(const __attribute__((address_space(3))) bf16x8*)(kp+512);
  kf[2]=*(const __attribute__((address_space(3))) bf16x8*)(kp+2048); kf[3]=*(const __attribute__((address_space(3))) bf16x8*)(kp+2560);
  kf[4]=*(const __attribute__((address_space(3))) bf16x8*)(kp+4096); kf[5]=*(const __attribute__((address_space(3))) bf16x8*)(kp+4608);
  kf[6]=*(const __attribute__((address_space(3))) bf16x8*)(kp+6144); kf[7]=*(const __attribute__((address_space(3))) bf16x8*)(kp+6656);
}
__device__ __forceinline__ void kload2(bf16x8*kf,lds_cptr kp,int j){ kf[2*j]=*(const __attribute__((address_space(3))) bf16x8*)(kp+j*2048); kf[2*j+1]=*(const __attribute__((address_space(3))) bf16x8*)(kp+j*2048+512); }
__device__ __forceinline__ s16x4 vtr(lds_cptr p){ return __builtin_bit_cast(s16x4,__builtin_amdgcn_ds_read_tr16_b64_v4i16((__attribute__((address_space(3))) v4i16_t*)p)); }
__device__ __forceinline__ float rowmax(const f32x16&p0,const f32x16&p1){
  float a=max3f(p0[0],p0[1],p1[0]),b=max3f(p0[2],p0[3],p1[1]);a=max3f(a,p1[2],p1[3]);
  #pragma unroll
  for(int r=4;r<16;r+=4){a=max3f(a,p0[r],p0[r+1]);b=max3f(b,p0[r+2],p0[r+3]);a=max3f(a,p1[r],p1[r+1]);b=max3f(b,p1[r+2],p1[r+3]);}
  const float m=max2f(a,b);
  auto rr=__builtin_amdgcn_permlane32_swap(__float_as_uint(m),__float_as_uint(m),false,false);
  return max2f(__uint_as_float(rr[0]),__uint_as_float(rr[1]));
}
__device__ __forceinline__ void pv(f32x16*o,int vb,bf16x8 pa0,bf16x8 pa1,bf16x8 pa2,bf16x8 pa3){
  #pragma unroll
  for(int d0=0;d0<2;++d0){s16x4 lo[4],hi[4];
    #pragma unroll
    for(int ks=0;ks<4;++ks){
      asm volatile("ds_read_b64_tr_b16 %0,%1 offset:%c2":"=&v"(lo[ks]):"v"(vb),"i"(d0*4096+ks*1024):"memory");
      asm volatile("ds_read_b64_tr_b16 %0,%1 offset:%c2":"=&v"(hi[ks]):"v"(vb),"i"(d0*4096+ks*1024+512):"memory");}
    asm volatile("s_waitcnt lgkmcnt(0)":::"memory");SBAR();
    #define PK(k) (bf16x8){lo[k][0],lo[k][1],lo[k][2],lo[k][3],hi[k][0],hi[k][1],hi[k][2],hi[k][3]}
    o[d0]=__builtin_amdgcn_mfma_f32_32x32x16_bf16(pa0,PK(0),o[d0],0,0,0);
    o[d0]=__builtin_amdgcn_mfma_f32_32x32x16_bf16(pa1,PK(1),o[d0],0,0,0);
    o[d0]=__builtin_amdgcn_mfma_f32_32x32x16_bf16(pa2,PK(2),o[d0],0,0,0);
    o[d0]=__builtin_amdgcn_mfma_f32_32x32x16_bf16(pa3,PK(3),o[d0],0,0,0);
    #undef PK
  }
}

#ifndef ATTN_STORE16
#define ATTN_STORE16(p,v) (*(u32x4*)(p)=(v))
#endif
template<int THRL> __device__ __forceinline__ void attn_unit(int b,int h,int qb,const bf16*Q,const bf16*__restrict__ K,const bf16*__restrict__ V,bf16*O,const float*__restrict__ BL2,char*shm){
  const int tid=threadIdx.x,lane=tid&63,r32=lane&31,hi=lane>>5; const int wid=__builtin_amdgcn_readfirstlane(tid>>6);
  const long rowbase=(long)b*SEQ; const int q0=qb*QB;
  const bf16*Qw=Q+(rowbase+q0+wid*QBLK)*DM+h*D;
  const bf16*Kh=K+rowbase*DM+h*D,*Vh=V+rowbase*DM+h*D;
  const unsigned lds0=(unsigned)(uintptr_t)shm;
  float*wsf=(float*)(shm+LDS_WS)+wid*64;
  const bf16*ksrc=Kh+(long)lane*DM+wid*8;
  const bf16*vsrc=Vh+(long)(16*(wid&3)+(lane>>2))*DM+(wid>>2)*32+(lane&3)*8;
  const unsigned kdst=lds0+LDS_K+wid*1024, vdst=lds0+LDS_V+wid*1024;
  #define DMA_K(t,slot) glds16(ksrc+(long)(t)*KVBLK*DM,(unsigned)__builtin_amdgcn_readfirstlane(kdst+(slot)))
  #define DMA_V(t,slot) glds16(vsrc+(long)(t)*KVBLK*DM,(unsigned)__builtin_amdgcn_readfirstlane(vdst+(slot)))
  const int vb0=(int)(lds0+LDS_V)+((lane>>4)&1)*32+(lane&3)*8+(4*hi+((lane&15)>>2))*64;
  const char*Kbase=shm+LDS_K; bf16x8 kf[8];
  const lds_cptr shm3=(lds_cptr)shm; const lds_cptr kp0=shm3+LDS_K+hi*1024+r32*16; const lds_cptr vp0=shm3+LDS_V+((lane>>4)&1)*32+(lane&3)*8+(4*hi+((lane&15)>>2))*64;
  const int NT=(q0+QB)/KVBLK;
  const float*blh=(const float*)(shm+LDS_BIAS)+4*hi;
  #define BINIT1(C,t,o) do{ const float*bp_=blh+64*(t)+(o); \
    _Pragma("unroll") for(int g_=0;g_<4;++g_){ typedef float f32x4_t __attribute__((ext_vector_type(4))); const f32x4_t b0_=*(const f32x4_t*)(bp_+8*g_); \
      _Pragma("unroll") for(int i_=0;i_<4;++i_){ C[4*g_+i_]=b0_[i_]-mhat; } } }while(0)
  #define BINIT(C0,C1,t) do{ BINIT1(C0,t,0); BINIT1(C1,t,32); }while(0)
  #define BG(G,C,t,o,g_) do{ if(G){ typedef float f32x4_t __attribute__((ext_vector_type(4))); const f32x4_t b0_=*(const f32x4_t*)(blh+64*(t)+(o)+8*(g_)); \
      const f32x2_t m2_={mhat,mhat}; const f32x2_t lo_=(f32x2_t){b0_[0],b0_[1]}-m2_, hi_=(f32x2_t){b0_[2],b0_[3]}-m2_; \
      C[4*(g_)]=lo_[0]; C[4*(g_)+1]=lo_[1]; C[4*(g_)+2]=hi_[0]; C[4*(g_)+3]=hi_[1]; SBAR(); } }while(0)
  DMA_K(0,0);DMA_V(0,0);DMA_K(1,SLOTB);
  { typedef float f32x4_t __attribute__((ext_vector_type(4))); float*bl=(float*)(shm+LDS_BIAS); const int nch=(q0+QB)/4;
    for(int c=tid;c<nch;c+=NW*64){ const f32x4_t v=*(const f32x4_t*)(BL2+4*c); *(f32x4_t*)(bl+4*c)=v; }
    asm volatile("s_waitcnt vmcnt(0)":::"memory"); }
  bf16x8 qr[4];
  #pragma unroll
  for(int d0=0;d0<4;++d0)qr[d0]=*reinterpret_cast<const bf16x8*>(&Qw[(long)r32*DM+d0*16+hi*8]);
  float mhat=0.f,l_reg=0.f;f32x16 o[2];o[0]=f32x16{};o[1]=f32x16{};
  const int qrel=wid*QBLK+r32;
  #define CMASK(P0,P1,t) do{int jb_=(t)-(NT-4); if(jb_>=0)cmask(P0,P1,jb_,qrel,hi);}while(0)
  bool resc=false;
  #define START(P0,P1) do{ const float rm=rowmax(P0,P1); resc=false; \
    { const float dl=rm; mhat=fadd_s(mhat,dl); \
      _Pragma("unroll") for(int r=0;r<16;++r){P0[r]=fsub_s(P0[r],dl);P1[r]=fsub_s(P1[r],dl);} } \
    _Pragma("unroll") for(int r=0;r<16;++r)P0[r]=__builtin_amdgcn_exp2f(P0[r]); }while(0)
  #define RESC() do{ if(resc){ asm volatile("s_waitcnt lgkmcnt(0)":::"memory"); \
      _Pragma("unroll") for(int d_=0;d_<2;++d_) _Pragma("unroll") for(int r=0;r<16;++r)o[d_][r]*=wsf[crow(r,hi)]; } }while(0)
  f32x16 pA0,pA1,pB0,pB1;
  int sl_prev=0,sl_cur=0,sl_next=SLOTB;
  #define ROT() do{sl_prev=sl_cur;sl_cur=sl_next;sl_next=(sl_next==(NSLOT-1)*SLOTB)?0:sl_next+SLOTB;}while(0)
  DMA_K(2,2*SLOTB);
  WAIT_BAR(3);
  { f32x16 i0_,i1_; BINIT(i0_,i1_,0); qkt(pA0,pA1,Kbase,qr,i0_,i1_,r32,hi); } asm volatile("s_nop 15\n\ts_nop 7":"+v"(pA0),"+v"(pA1));CMASK(pA0,pA1,0);
  START(pA0,pA1);
  _Pragma("unroll") for(int r=0;r<16;++r)pA1[r]=__builtin_amdgcn_exp2f(pA1[r]);
  WAIT_BAR(0);
  DMA_K(3,0);DMA_V(1,SLOTB);
  ROT();
  kload8(kf,kp0+sl_cur);
  WAIT_BAR(2);
  s16x4 vlo[8],vhi[8]; u32x4 pw0,pw1,pw2,pw3;
  #define PKW(P,B) cvtpk_s(P[B],P[B+1])
  #define PAF(k) __builtin_bit_cast(bf16x8,pw##k)
  #define VFR(i) (bf16x8){vlo[i][0],vlo[i][1],vlo[i][2],vlo[i][3],vhi[i][0],vhi[i][1],vhi[i][2],vhi[i][3]}
  #define PIN(x) asm volatile("":"+v"(x))
  #define MX3(a,b,c) __builtin_fmaxf(__builtin_fmaxf((a),(b)),(c))
  #define GAPA(MF,A0,A1,A2,A3,W0,W1,PW) do{ MF; sacc+=A0; sacc+=A1; sacc+=A2; sacc+=A3; PIN(sacc); W0; W1; PIN(PW); SBAR(); }while(0)
  #define EX(v) __builtin_amdgcn_exp2f(v)
  #define GAPB(MF,X,B) do{ MF; X[B]=EX(X[B]); X[B+1]=EX(X[B+1]); X[B+2]=EX(X[B+2]); X[B+3]=EX(X[B+3]); PIN(X); SBAR(); }while(0)
  #define VRD(i) do{ vlo[i]=vtr(vp_+(((i)>>2)*4096+((i)&3)*1024)); vhi[i]=vtr(vp_+(((i)>>2)*4096+((i)&3)*1024+512)); }while(0)
  #define KRD(G,j) do{ if(G){ kload2(kf,kp0+sl_next,j); SBAR(); } }while(0)
  #define STEP(C0,C1,P0,P1,t,GK,GV,GL) do{ SBAR(); \
    const lds_cptr vp_=vp0+sl_prev; \
    VRD(0); SBAR(); float sacc=(P0[0]+P0[1]); \
    GAPA(C0=__builtin_amdgcn_mfma_f32_32x32x16_bf16(kf[0],qr[0],C0,0,0,0), P0[2],P0[3],P0[4],P0[5],     pw0[0]=PKW(P0,0), pw0[1]=PKW(P0,2), pw0); \
    VRD(4); SBAR(); GAPA(C1=__builtin_amdgcn_mfma_f32_32x32x16_bf16(kf[1],qr[0],C1,0,0,0), P0[6],P0[7],P0[8],P0[9],     pw0[2]=PKW(P0,4), pw0[3]=PKW(P0,6), pw0); \
    VRD(1); SBAR(); GAPA(C0=__builtin_amdgcn_mfma_f32_32x32x16_bf16(kf[2],qr[1],C0,0,0,0),   P0[10],P0[11],P0[12],P0[13], pw1[0]=PKW(P0,8), pw1[1]=PKW(P0,10), pw1); \
    VRD(5); SBAR(); GAPA(C1=__builtin_amdgcn_mfma_f32_32x32x16_bf16(kf[3],qr[1],C1,0,0,0),   P0[14],P0[15],P1[0],P1[1],   pw1[2]=PKW(P0,12),pw1[3]=PKW(P0,14), pw1); \
    VRD(2); SBAR(); GAPA(C0=__builtin_amdgcn_mfma_f32_32x32x16_bf16(kf[4],qr[2],C0,0,0,0),   P1[2],P1[3],P1[4],P1[5],     pw2[0]=PKW(P1,0), pw2[1]=PKW(P1,2), pw2); \
    VRD(6); SBAR(); GAPA(C1=__builtin_amdgcn_mfma_f32_32x32x16_bf16(kf[5],qr[2],C1,0,0,0),   P1[6],P1[7],P1[8],P1[9],     pw2[2]=PKW(P1,4), pw2[3]=PKW(P1,6), pw2); \
    VRD(3); SBAR(); GAPA(C0=__builtin_amdgcn_mfma_f32_32x32x16_bf16(kf[6],qr[3],C0,0,0,0),   P1[10],P1[11],P1[12],P1[13], pw3[0]=PKW(P1,8), pw3[1]=PKW(P1,10), pw3); \
    VRD(7); SBAR(); GAPA(C1=__builtin_amdgcn_mfma_f32_32x32x16_bf16(kf[7],qr[3],C1,0,0,0),   P1[14],P1[15],0.f,0.f,       pw3[2]=PKW(P1,12),pw3[3]=PKW(P1,14), pw3); \
    l_reg+=sacc; \
    if(GK){DMA_K((t)+3,sl_cur);} if(GV){DMA_V((t)+1,sl_next);} \
    CMASK(C0,C1,t); \
    { float a=MX3(C0[0],C0[1],C1[0]),b=MX3(C0[2],C0[3],C1[1]); a=MX3(a,C1[2],C1[3]); \
      _Pragma("unroll") for(int r=4;r<16;r+=4){a=MX3(a,C0[r],C0[r+1]);b=MX3(b,C0[r+2],C0[r+3]);a=MX3(a,C1[r],C1[r+1]);b=MX3(b,C1[r+2],C1[r+3]);} \
      float rm=__builtin_fmaxf(a,b); { auto rr=__builtin_amdgcn_permlane32_swap(__float_as_uint(rm),__float_as_uint(rm),false,false); rm=__builtin_fmaxf(__uint_as_float(rr[0]),__uint_as_float(rr[1])); } \
      resc=false; \
      if(__builtin_expect(__any(rm>(float)THRL),0)){ const float dl=__builtin_fmaxf(rm,0.f); mhat+=dl; \
        _Pragma("unroll") for(int r=0;r<16;++r){C0[r]-=dl;C1[r]-=dl;} \
        const float f=__builtin_amdgcn_exp2f(-dl); l_reg*=f; if(hi==0)wsf[r32]=f; resc=true; } } \
    SBAR(); \
    GAPB(o[0]=__builtin_amdgcn_mfma_f32_32x32x16_bf16(PAF(0),VFR(0),o[0],0,0,0), C0,0); BG(GL,P0,(t)+1,0,0); \
    GAPB(o[1]=__builtin_amdgcn_mfma_f32_32x32x16_bf16(PAF(0),VFR(4),o[1],0,0,0), C0,4); BG(GL,P0,(t)+1,0,1); \
    KRD(GL,0); GAPB(o[0]=__builtin_amdgcn_mfma_f32_32x32x16_bf16(PAF(1),VFR(1),o[0],0,0,0), C0,8); BG(GL,P0,(t)+1,0,2); \
    KRD(GL,1); GAPB(o[1]=__builtin_amdgcn_mfma_f32_32x32x16_bf16(PAF(1),VFR(5),o[1],0,0,0), C0,12); BG(GL,P0,(t)+1,0,3); \
    KRD(GL,2); GAPB(o[0]=__builtin_amdgcn_mfma_f32_32x32x16_bf16(PAF(2),VFR(2),o[0],0,0,0), C1,0); BG(GL,P1,(t)+1,32,0); \
    KRD(GL,3); GAPB(o[1]=__builtin_amdgcn_mfma_f32_32x32x16_bf16(PAF(2),VFR(6),o[1],0,0,0), C1,4); BG(GL,P1,(t)+1,32,1); \
    GAPB(o[0]=__builtin_amdgcn_mfma_f32_32x32x16_bf16(PAF(3),VFR(3),o[0],0,0,0), C1,8); BG(GL,P1,(t)+1,32,2); \
    GAPB(o[1]=__builtin_amdgcn_mfma_f32_32x32x16_bf16(PAF(3),VFR(7),o[1],0,0,0), C1,12); BG(GL,P1,(t)+1,32,3); \
    }while(0)
  int t=1;
  BINIT(pB0,pB1,1);
  #undef CMASK
  #define CMASK(P0,P1,t) do{}while(0)
  for(;t+5<NT;t+=2){
    STEP(pB0,pB1,pA0,pA1,t,true,true,true);     WAIT_BAR(2); RESC(); ROT();
    STEP(pA0,pA1,pB0,pB1,t+1,true,true,true);   WAIT_BAR(2); RESC(); ROT();
  }
  #undef CMASK
  #define CMASK(P0,P1,t) do{int jb_=(t)-(NT-4); if(jb_>=0)cmask(P0,P1,jb_,qrel,hi);}while(0)
  #define ENDW(tt) do{ if((tt)+3<NT){WAIT_BAR(2);} else if((tt)+2<NT){WAIT_BAR(1);} else {WAIT_BAR(0);} }while(0)
  for(;t+1<NT;t+=2){
    STEP(pB0,pB1,pA0,pA1,t,(t+3<NT),(t+1<NT),(t+1<NT));       ENDW(t);   RESC(); ROT();
    STEP(pA0,pA1,pB0,pB1,t+1,(t+4<NT),(t+2<NT),(t+2<NT));     ENDW(t+1); RESC(); ROT();
  }
  STEP(pB0,pB1,pA0,pA1,NT-1,false,false,false); RESC();
  { float sacc=pB0[0]+pB0[1]; _Pragma("unroll") for(int r=2;r<16;++r)sacc+=pB0[r]; _Pragma("unroll") for(int r=0;r<16;++r)sacc+=pB1[r]; l_reg+=sacc;
    pw0=(u32x4){PKW(pB0,0),PKW(pB0,2),PKW(pB0,4),PKW(pB0,6)};pw1=(u32x4){PKW(pB0,8),PKW(pB0,10),PKW(pB0,12),PKW(pB0,14)};pw2=(u32x4){PKW(pB1,0),PKW(pB1,2),PKW(pB1,4),PKW(pB1,6)};pw3=(u32x4){PKW(pB1,8),PKW(pB1,10),PKW(pB1,12),PKW(pB1,14)};
    SBAR(); pv(o,vb0+sl_cur,PAF(0),PAF(1),PAF(2),PAF(3)); }
  #undef PKW
  #undef PAF
  #undef VFR
  #undef PIN
  #undef MX3
  #undef GAPA
  #undef GAPB
  #undef EX
  #undef VRD
  #undef KRD
  #undef STEP
  #undef ENDW
  {auto rr=__builtin_amdgcn_permlane32_swap(__float_as_uint(l_reg),__float_as_uint(l_reg),false,false);l_reg=__uint_as_float(rr[0])+__uint_as_float(rr[1]);}
  if(hi==0)wsf[32+r32]=l_reg;asm volatile("s_waitcnt lgkmcnt(0)":::"memory");
  float rli[16];
  #pragma unroll
  for(int r=0;r<16;++r)rli[r]=__builtin_amdgcn_rcpf(wsf[32+crow(r,hi)]);
  bf16*Ow=O+(rowbase+q0+wid*QBLK)*DM+h*D;
  { bf16*stg=(bf16*)(shm+LDS_OST)+wid*2048;
    #pragma unroll
    for(int r=0;r<16;++r){const int orow=crow(r,hi);
      #pragma unroll
      for(int d0=0;d0<2;++d0)stg[orow*64+d0*32+r32]=__float2bfloat16(o[d0][r]*rli[r]);}
    asm volatile("s_waitcnt lgkmcnt(0)":::"memory");
    #pragma unroll
    for(int i=0;i<4;++i){const int row=i*8+(lane>>3),ch=lane&7; const u32x4 v=*(const u32x4*)(stg+row*64+ch*8); ATTN_STORE16(Ow+(long)row*DM+ch*8,v);} }
  asm volatile("s_waitcnt lgkmcnt(0)\n\ts_barrier":::"memory");
  #undef BINIT
  #undef BINIT1
  #undef BG
  #undef DMA_K
  #undef DMA_V
  #undef CMASK
  #undef START
  #undef RESC
  #undef ROT
}
constexpr int ATTN_LDS_BYTES=LDS_BYTES;
struct AttnTensors { const bf16* Q; const bf16* K; const bf16* V; bf16* O; const float* BL2; };
struct AttnUnit { int bh; int qb; };
struct StaticOrder {
  int vcu;
  __device__ __forceinline__ explicit StaticOrder(int grid,int block):vcu((block%8)*(grid/8)+block/8){}
  __device__ __forceinline__ bool next(int i,AttnUnit&u)const{ if(i>=8)return false; const int s=vcu&7,j=i&3; u.bh=(vcu>>3)+32*(i>>2); u.qb=(j==0)?31-s:(j==1)?16+s:(j==2)?15-s:s; return true; }
  __device__ __forceinline__ void a_ready(const AttnUnit&)const{}
  __device__ __forceinline__ void done(const AttnUnit&)const{}
};
template<class Sched,int THRL=ATT_THRL> __device__ __forceinline__ void attn_phase(char*lds,const AttnTensors&T,const Sched&S){
  AttnUnit u;
  for(int i=0;S.next(i,u);++i){ S.a_ready(u); attn_unit<THRL>(u.bh/NHEAD,u.bh%NHEAD,u.qb,T.Q,T.K,T.V,T.O,T.BL2+(long)u.bh*SEQ,lds); S.done(u); }
}
#undef SBAR
#undef WAIT_BAR
}

#define XB_TMO      128
#define XB_XCNT(j)  (256  + 64 * (j))
#define XB_XSUB(j)  (1280 + 64 * (j))
#define XB_XGEN(j)  (2304 + 64 * (j))
#define XB_TOP      3328
#define XB_TOPGEN   3392
#define XCD_BAR_WORDS 3456
#define XB_SPIN_CAP (1u << 18)

__device__ __forceinline__ unsigned xb_ld(unsigned* p)              { return __hip_atomic_load(p, __ATOMIC_RELAXED, __HIP_MEMORY_SCOPE_AGENT); }
__device__ __forceinline__ unsigned xb_add(unsigned* p, unsigned v) { return __hip_atomic_fetch_add(p, v, __ATOMIC_RELAXED, __HIP_MEMORY_SCOPE_AGENT); }
__device__ __forceinline__ unsigned xb_xcc_id() { return (unsigned)__builtin_amdgcn_s_getreg((3 << 11) | 20) & 0xFu; }
#define XB_SPIN(cond, bar) do { unsigned _sp = 0; while (cond) { __builtin_amdgcn_s_sleep(1); \
    if ((++_sp & 255u) == 0u) { if (xb_ld(&(bar)[XB_TMO])) break; if (_sp > XB_SPIN_CAP) { atomicAdd(&(bar)[XB_TMO], 1u); break; } } } } while (0)

struct XcdBarrier {
    unsigned* bar; unsigned x;
    volatile LAS unsigned* st;
};

__device__ __forceinline__ XcdBarrier xcd_barrier_post(unsigned* bar, volatile LAS unsigned* st) {
    XcdBarrier b; b.bar = bar; b.x = xb_xcc_id(); b.st = st;
    if (threadIdx.x == 0) (void)xb_add(&bar[XB_XCNT(b.x)], 1u);
    return b;
}
__device__ __forceinline__ void xcd_barrier_complete(unsigned* bar, unsigned x, unsigned& nloc, unsigned& nx) {
    const unsigned G = gridDim.x * gridDim.y * gridDim.z;
    unsigned sum, cnt, mine, sp = 0u;
    for (;;) {
        sum = 0u; cnt = 0u; mine = 0u;
#pragma unroll
        for (unsigned j = 0; j < 16; ++j) { const unsigned c = xb_ld(&bar[XB_XCNT(j)]); sum += c; cnt += (c > 0u) ? 1u : 0u; mine = (j == x) ? c : mine; }
        if (sum == G) break;
        __builtin_amdgcn_s_sleep(1);
        if ((++sp & 255u) == 0u) { if (xb_ld(&bar[XB_TMO])) break; if (sp > XB_SPIN_CAP) { atomicAdd(&bar[XB_TMO], 1u); break; } }
    }
    nloc = mine > 0u ? mine : 1u; nx = cnt > 0u ? cnt : 1u;
}

__device__ __forceinline__ void xcd_barrier(const XcdBarrier& b) {
    asm volatile("s_waitcnt vmcnt(0)" ::: "memory");
    __syncthreads();
    if (threadIdx.x == 0) {
        unsigned* bar = b.bar;
        __builtin_amdgcn_s_waitcnt(0);
        unsigned nloc = b.st[0], nx = b.st[1];
        if (nloc == 0u) { xcd_barrier_complete(bar, b.x, nloc, nx); b.st[0] = nloc; b.st[1] = nx; }
        const unsigned old = xb_add(&bar[XB_XSUB(b.x)], 1u);
        const unsigned gen = old / nloc;
        if (old + 1u == (gen + 1u) * nloc) {
            __builtin_amdgcn_fence(__ATOMIC_RELEASE, "agent");
            asm volatile("s_waitcnt vmcnt(0)" ::: "memory");
            const unsigned og = xb_add(&bar[XB_TOP], 1u);
            const unsigned tg = og / nx;
            if (og + 1u == (tg + 1u) * nx) xb_add(&bar[XB_TOPGEN], 1u);
            else XB_SPIN(xb_ld(&bar[XB_TOPGEN]) == tg, bar);
            __builtin_amdgcn_fence(__ATOMIC_ACQUIRE, "agent");
            xb_add(&bar[XB_XGEN(b.x)], 1u);
            asm volatile("s_waitcnt vmcnt(0)" ::: "memory");
        } else {
            XB_SPIN(xb_ld(&bar[XB_XGEN(b.x)]) == gen, bar);
            __builtin_amdgcn_fence(__ATOMIC_ACQUIRE, "agent");
            asm volatile("s_waitcnt vmcnt(0)" ::: "memory");
        }
    }
    __syncthreads();
}


#ifndef MK_UNROLL
#define MK_UNROLL 1
#endif
#ifndef DIS
#define DIS 0
#endif
#ifndef SSD_LT_UNROLL
#define SSD_LT_UNROLL 4
#endif
#define MFMA16(A, B, C) __builtin_amdgcn_mfma_f32_16x16x32_bf16((A), (B), (C), 0, 0, 0)
#define MFMA32(A, B, C) __builtin_amdgcn_mfma_f32_32x32x16_bf16((A), (B), (C), 0, 0, 0)
__device__ __forceinline__ bf16* bcc_row(const Args& a, size_t m) { return m < (size_t)MP ? (bf16*)(a.out + O_KP) + m * 2048 : (bf16*)(a.out + O_VP) + (m - MP) * 2048; }
__device__ __forceinline__ float* segst_ptr(const Args& a) { return a.out + O_VP + (1u << 20); }

__device__ __forceinline__ void conv8x8(const u32x4 (&xr)[11], const float (&cw)[4][8], const float (&cbias)[8], int nvalid, u32x4 (&orow)[8], u32x4 (&otr)[8]) {
#pragma unroll
    for (int j2 = 0; j2 < 4; ++j2) { float xl[11], xh[11];
#pragma unroll
        for (int i = 0; i < 11; ++i) { xl[i] = bflo(xr[i][j2]); xh[i] = bfhi(xr[i][j2]); }
        float ol[8], oh[8];
#pragma unroll
        for (int tt = 0; tt < 8; ++tt) { float v0 = cbias[2 * j2] + cw[0][2 * j2] * xl[tt] + cw[1][2 * j2] * xl[tt + 1] + cw[2][2 * j2] * xl[tt + 2] + cw[3][2 * j2] * xl[tt + 3];
            float v1 = cbias[2 * j2 + 1] + cw[0][2 * j2 + 1] * xh[tt] + cw[1][2 * j2 + 1] * xh[tt + 1] + cw[2][2 * j2 + 1] * xh[tt + 2] + cw[3][2 * j2 + 1] * xh[tt + 3];
            v0 = v0 * sigmoidf_(v0); v1 = v1 * sigmoidf_(v1); if (tt >= nvalid) { v0 = 0.f; v1 = 0.f; } ol[tt] = v0; oh[tt] = v1; orow[tt][j2] = pk2(v0, v1); }
#pragma unroll
        for (int t2 = 0; t2 < 4; ++t2) { otr[2 * j2][t2] = pk2(ol[2 * t2], ol[2 * t2 + 1]); otr[2 * j2 + 1][t2] = pk2(oh[2 * t2], oh[2 * t2 + 1]); } }
}
__device__ __forceinline__ u32x4 xbc_row8(const Args& a, const bf16* XBC, size_t seqbase, int smp, int b, int ts, int cc) {
    if (ts >= 0 && (!smp || ts < TS)) return *(const u32x4*)(XBC + (seqbase + ts) * CONVD + cc);
    if (smp && ts < 0) { const float* sp = a.state_conv + ((size_t)b * 3 + (ts + 3)) * CONVD + cc; return pack8(*(const f32x4*)sp, *(const f32x4*)(sp + 4)); }
    return (u32x4){0u, 0u, 0u, 0u};
}
__device__ __forceinline__ void phase_bc_conv(const Args& a) {
    const int tid = threadIdx.x, G = gridDim.x, cc = 8 * tid;
    const bf16* XBC = (const bf16*)(a.ws + WS_BIG); bf16* XC = (bf16*)(a.ws + WS_SG);
    float cw[4][8], cbias[8];
#pragma unroll
    for (int i = 0; i < 4; ++i)
#pragma unroll
        for (int j = 0; j < 8; ++j) cw[i][j] = a.conv_w[(size_t)i * CONVD + cc + j];
#pragma unroll
    for (int j = 0; j < 8; ++j) cbias[j] = a.conv_b[cc + j];
    const int nP = MP / 8, nS = MS / 8;
    const bool contig = (nP % G) == 0; const int per = contig ? nP / G : (nP - (int)blockIdx.x + G - 1) / G, nsm = ((int)blockIdx.x < nS) ? 1 : 0, nst = per + nsm;
#define BCC_IT(j) ((j) < per ? (contig ? (int)blockIdx.x * per + (j) : (int)blockIdx.x + (j) * G) : nP + (int)blockIdx.x)
    u32x4 xn[11];
#define BCC_LD(itv, lo) do { const int smp_ = (itv) >= nP, to_ = smp_ ? (itv) - nP : (itv); const int b_ = smp_ ? to_ / (TS / 8) : to_ / (TP / 8), t0_ = smp_ ? (to_ % (TS / 8)) * 8 : (to_ % (TP / 8)) * 8; \
        const size_t sb_ = smp_ ? (size_t)MP + (size_t)b_ * TS : (size_t)b_ * TP; _Pragma("unroll") for (int i_ = 0; i_ < 11; ++i_) if (i_ >= (lo)) xn[i_] = xbc_row8(a, XBC, sb_, smp_, b_, t0_ - 3 + i_, cc); } while (0)
    if (nst > 0) BCC_LD(BCC_IT(0), 0);
    for (int j = 0; j < nst; ++j) {
        const int it = BCC_IT(j);
        const int smp = it >= nP; const int to = smp ? it - nP : it;
        const int b = smp ? to / (TS / 8) : to / (TP / 8), t0 = smp ? (to % (TS / 8)) * 8 : (to % (TP / 8)) * 8;
        const size_t seqbase = smp ? (size_t)MP + (size_t)b * TS : (size_t)b * TP;
        u32x4 xr[11];
#pragma unroll
        for (int i = 0; i < 11; ++i) xr[i] = xn[i];
        if (j + 1 < nst) { const int itn = BCC_IT(j + 1);
            if (contig && itn == it + 1 && (itn % (TP / 8)) != 0) { xn[0] = xr[8]; xn[1] = xr[9]; xn[2] = xr[10]; BCC_LD(itn, 3); } else BCC_LD(itn, 0); }
        u32x4 orow[8], otr[8]; conv8x8(xr, cw, cbias, 8, orow, otr);
        if (tid < 256) {
#pragma unroll
            for (int tt = 0; tt < 8; ++tt) *(u32x4*)(XC + (seqbase + t0 + tt) * 2048 + cc) = orow[tt];
        } else {
#pragma unroll
            for (int tt = 0; tt < 8; ++tt) *(u32x4*)(bcc_row(a, seqbase + t0 + tt) + (cc - 2048)) = orow[tt];
        }
        const int tl = smp ? TS : TP;
        if (t0 + 8 == tl) { float* cs = smp ? a.out + O_CS + (size_t)b * 3 * CONVD : a.out + O_CP + (size_t)b * 3 * CONVD;
#pragma unroll
            for (int i = 0; i < 3; ++i) { const u32x4 w = xr[8 + i]; float* o = cs + (size_t)i * CONVD + cc;
                *(f32x4*)o = (f32x4){bflo(w.x), bfhi(w.x), bflo(w.y), bfhi(w.y)}; *(f32x4*)(o + 4) = (f32x4){bflo(w.z), bfhi(w.z), bflo(w.w), bfhi(w.w)}; } }
    }
#undef BCC_LD
#undef BCC_IT
}

constexpr int SSD_CS = 0, SSD_BS = 17408, SSD_BT = 34816, SSD_XT = 53248, SSD_MM = 90112, SSD_FA = 126976;
__device__ __forceinline__ void ssd_item(const Args& a, LAS unsigned char* lds, const int mode, const int smp, const int b, const int seg, const int g) {
    const int tid = threadIdx.x, lane = tid & 63, wid = __builtin_amdgcn_readfirstlane(tid >> 6), fr = lane & 15, fq = lane >> 4, hh = wid >> 1, ph = wid & 1, head = 4 * g + hh;
    LAS bf16* Cs = (LAS bf16*)(lds + SSD_CS); LAS bf16* Bs = (LAS bf16*)(lds + SSD_BS); LAS bf16* BT = (LAS bf16*)(lds + SSD_BT);
    LAS bf16* XTh = (LAS bf16*)(lds + SSD_XT) + hh * 4608; LAS bf16* MMh = (LAS bf16*)(lds + SSD_MM) + hh * 4608;
    LAS float* FAh = (LAS float*)(lds + SSD_FA) + hh * 256;
    const size_t seqbase = smp ? (size_t)MP + (size_t)b * TS : (size_t)b * TP;
    const int tseg = smp ? 0 : seg * 1024, nch = smp ? 1 : 16;
    const float Dh = a.D_skip[head];
    const bf16* XBC = (const bf16*)(a.ws + WS_BIG);
    const float* DTW = (const float*)(a.ws + WS_DT);
    float* SEGST = segst_ptr(a); float* SEGDEC = (float*)(a.ws + WS_SEGDEC);
    f32x4 st[8][2];
    if (mode == 1 && smp) { const float* h0 = a.state_ssm + ((size_t)b * NHS + head) * 8192;
#pragma unroll
        for (int nt = 0; nt < 8; ++nt)
#pragma unroll
            for (int pt2 = 0; pt2 < 2; ++pt2) st[nt][pt2] = *(const f32x4*)(h0 + (32 * ph + 16 * pt2 + fr) * 128 + 16 * nt + 4 * fq);
    } else if (mode == 1) {
#pragma unroll
        for (int nt = 0; nt < 8; ++nt)
#pragma unroll
            for (int pt2 = 0; pt2 < 2; ++pt2) st[nt][pt2] = (f32x4){0.f, 0.f, 0.f, 0.f};
#pragma unroll 1
        for (int s = 0; s < seg; ++s) { const float* h0 = SEGST + (((size_t)b * 8 + s) * NHS + head) * 8192; const float dec = SEGDEC[(b * 8 + s) * NHS + head];
#pragma unroll
            for (int nt = 0; nt < 8; ++nt)
#pragma unroll
                for (int pt2 = 0; pt2 < 2; ++pt2) st[nt][pt2] = st[nt][pt2] * dec + *(const f32x4*)(h0 + (32 * ph + 16 * pt2 + fr) * 128 + 16 * nt + 4 * fq); }
    } else {
#pragma unroll
        for (int nt = 0; nt < 8; ++nt)
#pragma unroll
            for (int pt2 = 0; pt2 < 2; ++pt2) st[nt][pt2] = (f32x4){0.f, 0.f, 0.f, 0.f};
    }
    const int xco = tid & 31, xtq = (tid >> 5) & 7, bno = tid & 15, btq = (tid >> 4) & 7;
    const bool isX = tid < 256, isB = !isX && tid < 384, ldact = isX || isB || mode == 1;
    const int tq = isX ? xtq : btq;
    const bf16* rbase = isX ? (const bf16*)(a.ws + WS_SG) + (seqbase + tseg + 8 * tq) * 2048 + g * 256 + 8 * xco
                            : bcc_row(a, seqbase + tseg + 8 * tq) + (isB ? 0 : 1024) + g * 128 + 8 * bno;
    u32x4 pf[8];
#define SSD_PF(cn) do { _Pragma("unroll") for (int tt_ = 0; tt_ < 8; ++tt_) pf[tt_] = (ldact && (!smp || 8 * tq + tt_ < TS)) ? *(const u32x4*)(rbase + ((size_t)(cn) * 64 + tt_) * 2048) : (u32x4){0u, 0u, 0u, 0u}; \
        } while (0)
    SSD_PF(0);
    if (mode == 1) { for (int e = lane + 64 * ph; e < 64 * 72 / 2; e += 128) ((LAS unsigned*)MMh)[e] = 0u; }
    const float Ah = -expf(a.A_log[4 * g + (wid & 3)]), dtb = a.dt_bias[4 * g + (wid & 3)];
    float decsum = 0.f;
    bf16* ZB = (bf16*)(a.out + O_Y); LAS float* NS = (LAS float*)(lds + 131072);
    int ypend = -1;
#define SSD_YFIN() do { if (mode == 1 && ypend >= 0) { const float* nwp_ = a.ssm_norm_w + head * 64 + 32 * ph + 4 * fq; const f32x4 nw0_ = *(const f32x4*)nwp_, nw1_ = *(const f32x4*)(nwp_ + 16); \
        const float nwv[8] = {nw0_[0], nw0_[1], nw0_[2], nw0_[3], nw1_[0], nw1_[1], nw1_[2], nw1_[3]}; _Pragma("unroll") for (int lt = 0; lt < 4; ++lt) { const int l = 16 * lt + fr; float tot = 0.f; \
        _Pragma("unroll") for (int w = 0; w < 8; ++w) tot += NS[w * 64 + l]; const float rs = rsqrtf(tot * (1.f / 256.f) + EPS); \
        if (!smp || l < TS) { bf16* zo = ZB + (seqbase + ypend + l) * DI + head * 64 + 32 * ph + 4 * fq; const u32x2 g0 = *(const u32x2*)zo, g1 = *(const u32x2*)(zo + 16); \
            *(u32x2*)zo = (u32x2){pk2(bflo(g0.x) * rs * nwv[0], bfhi(g0.x) * rs * nwv[1]), pk2(bflo(g0.y) * rs * nwv[2], bfhi(g0.y) * rs * nwv[3])}; \
            *(u32x2*)(zo + 16) = (u32x2){pk2(bflo(g1.x) * rs * nwv[4], bfhi(g1.x) * rs * nwv[5]), pk2(bflo(g1.y) * rs * nwv[6], bfhi(g1.y) * rs * nwv[7])}; } } } } while (0)
    for (int c = 0; c < nch; ++c) {
        const int t0 = tseg + c * 64;
        const float dtraw = (tid >= 256 && (!smp || lane < TS)) ? DTW[(seqbase + t0 + lane) * 32 + 4 * g + (wid & 3)] : -1e30f;
        SSD_YFIN();
        if (isX || isB) {
            LAS bf16* T = isX ? (LAS bf16*)(lds + SSD_XT) + (xco >> 3) * 4608 + (8 * (xco & 7)) * 72 + 8 * tq : BT + (8 * bno) * 72 + 8 * tq;
#pragma unroll
            for (int j = 0; j < 8; ++j) { u32x4 w;
#pragma unroll
                for (int t2 = 0; t2 < 4; ++t2) { const unsigned lo = pf[2 * t2][j >> 1], hi = pf[2 * t2 + 1][j >> 1]; w[t2] = (j & 1) ? ((lo >> 16) | (hi & 0xffff0000u)) : ((lo & 0xffffu) | (hi << 16)); }
                *(LAS u32x4*)(T + j * 72) = w; }
        }
        if (!isX && mode == 1) { LAS bf16* R = isB ? Bs : Cs;
#pragma unroll
            for (int tt = 0; tt < 8; ++tt) *(LAS u32x4*)(R + (8 * tq + tt) * 136 + 8 * bno) = pf[tt]; }
        if (tid >= 256) {
            LAS float* F = (LAS float*)(lds + SSD_FA) + (wid & 3) * 256;
            const float dtv = dtraw > -1e29f ? softplusf_(dtraw + dtb) : 0.f; float av = dtv * Ah;
#pragma unroll
            for (int o = 1; o < 64; o <<= 1) { const float tv = __shfl_up(av, o); if (lane >= o) av += tv; }
            const float alast = __shfl(av, 63);
            F[lane] = dtv; F[64 + lane] = av; F[128 + lane] = __expf(av); F[192 + lane] = __expf(alast - av) * dtv; }
        if (c + 1 < nch) SSD_PF(c + 1);
        __syncthreads();
        const float acl = FAh[64 + 63]; if (mode == 0) decsum += acl;
        u32x2 zpre[4][2];
        if (mode == 1) {
#pragma unroll
            for (int lt = 0; lt < 4; ++lt) { const int l = 16 * lt + fr; if (!smp || l < TS) { const bf16* zp = ZB + (seqbase + t0 + l) * DI + head * 64 + 32 * ph + 4 * fq; zpre[lt][0] = *(const u32x2*)zp; zpre[lt][1] = *(const u32x2*)(zp + 16); } else { zpre[lt][0] = (u32x2){0u, 0u}; zpre[lt][1] = (u32x2){0u, 0u}; } }
        }
        if (mode == 1 && !(DIS & 4)) {
#pragma unroll MK_UNROLL
            for (int k = 0; k < 2; ++k) { const int lt = ph ? 1 + k : 3 * k;
_Pragma("unroll 1")
                for (int jt = 0; jt <= lt; ++jt) { f32x4 acc = {0.f, 0.f, 0.f, 0.f};
#pragma unroll
                    for (int ks = 0; ks < 4; ++ks) { const bf16x8 A = *(const LAS bf16x8*)(Cs + (16 * lt + fr) * 136 + 32 * ks + 8 * fq), B = *(const LAS bf16x8*)(Bs + (16 * jt + fr) * 136 + 32 * ks + 8 * fq); acc = MFMA16(A, B, acc); }
                    const int s = 16 * jt + fr; const float as_ = FAh[64 + s], ds = FAh[s];
#pragma unroll
                    for (int r = 0; r < 4; ++r) { const int l = 16 * lt + 4 * fq + r; float v = (l >= s) ? acc[r] * __expf(FAh[64 + l] - as_) * ds : 0.f; if (l == s) v += Dh; MMh[l * 72 + s] = (bf16)f2bf(v); } } }
            __syncthreads();
            if (!(DIS & 8)) {
            u32x2 hp[4][2][2];
#pragma unroll
            for (int kk = 0; kk < 4; ++kk)
#pragma unroll
                for (int pt2 = 0; pt2 < 2; ++pt2) { hp[kk][pt2][0] = (u32x2){pk2(st[2 * kk][pt2][0], st[2 * kk][pt2][1]), pk2(st[2 * kk][pt2][2], st[2 * kk][pt2][3])};
                    hp[kk][pt2][1] = (u32x2){pk2(st[2 * kk + 1][pt2][0], st[2 * kk + 1][pt2][1]), pk2(st[2 * kk + 1][pt2][2], st[2 * kk + 1][pt2][3])}; }
#pragma unroll SSD_LT_UNROLL
            for (int lt = 0; lt < 4; ++lt) { f32x4 y0 = {0.f, 0.f, 0.f, 0.f}, y1 = y0;
#pragma unroll
                for (int kk = 0; kk < 4; ++kk) { const LAS bf16* cp = Cs + (16 * lt + fr) * 136 + 32 * kk + 4 * fq; const u32x2 c0 = *(const LAS u32x2*)cp, c1 = *(const LAS u32x2*)(cp + 16);
                    const bf16x8 Bc = __builtin_bit_cast(bf16x8, (u32x4){c0.x, c0.y, c1.x, c1.y});
                    const bf16x8 A0 = __builtin_bit_cast(bf16x8, (u32x4){hp[kk][0][0].x, hp[kk][0][0].y, hp[kk][0][1].x, hp[kk][0][1].y}), A1 = __builtin_bit_cast(bf16x8, (u32x4){hp[kk][1][0].x, hp[kk][1][0].y, hp[kk][1][1].x, hp[kk][1][1].y});
                    y0 = MFMA16(A0, Bc, y0); y1 = MFMA16(A1, Bc, y1); }
                const int l = 16 * lt + fr; const float e = FAh[128 + l]; y0 = y0 * e; y1 = y1 * e;
#pragma unroll
                for (int ks = 0; ks < 2; ++ks) { const bf16x8 Bm = *(const LAS bf16x8*)(MMh + (16 * lt + fr) * 72 + 32 * ks + 8 * fq);
                    const bf16x8 A0 = *(const LAS bf16x8*)(XTh + (32 * ph + fr) * 72 + 32 * ks + 8 * fq), A1 = *(const LAS bf16x8*)(XTh + (32 * ph + 16 + fr) * 72 + 32 * ks + 8 * fq);
                    y0 = MFMA16(A0, Bm, y0); y1 = MFMA16(A1, Bm, y1); }
                float ss = 0.f;
                if (!smp || l < TS) { bf16* zp = ZB + (seqbase + t0 + l) * DI + head * 64 + 32 * ph + 4 * fq; const u32x2 z0 = zpre[lt][0], z1 = zpre[lt][1];
                    const float zf[8] = {bflo(z0.x), bfhi(z0.x), bflo(z0.y), bfhi(z0.y), bflo(z1.x), bfhi(z1.x), bflo(z1.y), bfhi(z1.y)};
#pragma unroll
                    for (int r = 0; r < 4; ++r) { y0[r] = y0[r] * zf[r] * sigmoidf_(zf[r]); y1[r] = y1[r] * zf[4 + r] * sigmoidf_(zf[4 + r]); ss += y0[r] * y0[r] + y1[r] * y1[r]; }
                    *(u32x2*)zp = (u32x2){pk2(y0[0], y0[1]), pk2(y0[2], y0[3])}; *(u32x2*)(zp + 16) = (u32x2){pk2(y1[0], y1[1]), pk2(y1[2], y1[3])}; }
                ss += __shfl_xor(ss, 16); ss += __shfl_xor(ss, 32);
                if (fq == 0) NS[wid * 64 + l] = ss; }
            ypend = t0;
            }
        }
        if (!(DIS & 16)) { const float cd = __expf(acl);
#pragma unroll
            for (int nt = 0; nt < 8; ++nt) { st[nt][0] = st[nt][0] * cd; st[nt][1] = st[nt][1] * cd; }
#pragma unroll
            for (int ks = 0; ks < 2; ++ks) { const f32x4 w0 = *(const LAS f32x4*)(FAh + 192 + 32 * ks + 8 * fq), w1 = *(const LAS f32x4*)(FAh + 192 + 32 * ks + 8 * fq + 4);
                bf16x8 Bx[2];
#pragma unroll
                for (int pt2 = 0; pt2 < 2; ++pt2) { const u32x4 x = *(const LAS u32x4*)(XTh + (32 * ph + 16 * pt2 + fr) * 72 + 32 * ks + 8 * fq);
                    Bx[pt2] = __builtin_bit_cast(bf16x8, (u32x4){pk2(bflo(x.x) * w0[0], bfhi(x.x) * w0[1]), pk2(bflo(x.y) * w0[2], bfhi(x.y) * w0[3]), pk2(bflo(x.z) * w1[0], bfhi(x.z) * w1[1]), pk2(bflo(x.w) * w1[2], bfhi(x.w) * w1[3])}); }
#pragma unroll
                for (int nt = 0; nt < 8; ++nt) { const bf16x8 An = *(const LAS bf16x8*)(BT + (16 * nt + fr) * 72 + 32 * ks + 8 * fq); st[nt][0] = MFMA16(An, Bx[0], st[nt][0]); st[nt][1] = MFMA16(An, Bx[1], st[nt][1]); if (nt & 1) __builtin_amdgcn_sched_barrier(0); } } }
        __syncthreads();
    }
    SSD_YFIN();
#undef SSD_YFIN
    float* dst = nullptr;
    if (mode == 0) { dst = SEGST + (((size_t)b * 8 + seg) * NHS + head) * 8192; if (lane == 0 && ph == 0) SEGDEC[(b * 8 + seg) * NHS + head] = expf(decsum); }
    else if (smp) dst = a.out + O_SS + ((size_t)b * NHS + head) * 8192;
    else if (seg == 7) dst = a.out + O_SP + ((size_t)b * NHS + head) * 8192;
    if (dst) {
#pragma unroll
        for (int nt = 0; nt < 8; ++nt)
#pragma unroll
            for (int pt2 = 0; pt2 < 2; ++pt2) *(f32x4*)(dst + (32 * ph + 16 * pt2 + fr) * 128 + 16 * nt + 4 * fq) = st[nt][pt2];
    }
#undef SSD_PF
    __syncthreads();
}
__device__ __forceinline__ void phase_ssd_b(const Args& a) {
    float* SEGST = segst_ptr(a); const float* SEGDEC = (const float*)(a.ws + WS_SEGDEC);
    const int n = NBP * NHS * 8192;
    for (int e = blockIdx.x * 512 + threadIdx.x; e < n; e += gridDim.x * 512) { const int b = e / (NHS * 8192), rem = e % (NHS * 8192), head = rem / 8192; float H = 0.f;
#pragma unroll
        for (int s = 0; s < 8; ++s) { const size_t idx = ((size_t)b * 8 + s) * NHS * 8192 + rem; const float loc = s < 7 ? SEGST[idx] : 0.f; SEGST[idx] = H; H = H * SEGDEC[(b * 8 + s) * NHS + head] + loc; } }
}

#ifndef ATT_THRL
#define ATT_THRL 60
#endif
template <bool SMP> __device__ __forceinline__ void attn_unit(const Args& a, LAS unsigned char* lds, const int b, const int h, const int qb) {
    const int tid = threadIdx.x, lane = tid & 63, r32 = lane & 31, hi = lane >> 5, wid = __builtin_amdgcn_readfirstlane(tid >> 6);
    bf16* QB = (bf16*)(a.ws + WS_BIG); const bf16* KB = QB + (size_t)MT * DM; const bf16* VB = KB + (size_t)MT * DM;
    bf16* OB = QB + (size_t)3 * MT * DM;
    if (SMP) { QB = (bf16*)(a.ws + WS_QS) - (size_t)MP * DM; KB = (const bf16*)(a.ws + WS_KS) - (size_t)MP * DM; VB = (const bf16*)(a.ws + WS_VS) - (size_t)MP * DM; }
    LAS bf16* Ks = (LAS bf16*)lds; LAS bf16* VT = (LAS bf16*)(lds + 18432); LAS float* CBs = (LAS float*)(lds + 36864);
    const int NT = SMP ? (SKV + 63) / 64 : 4 * qb + 4;
    const bool active = SMP ? (wid == 0) : true;
    const size_t qrow0 = SMP ? (size_t)MP + (size_t)b * TS : (size_t)b * TP + (size_t)qb * 256 + wid * 32;
    const int qpos0 = SMP ? PAST : qb * 256 + wid * 32;
    const float* CUM = SMP ? (const float*)(a.ws + WS_CUMS) + (size_t)b * SKV * 16 + h : (const float*)(a.ws + WS_CUMP) + (size_t)b * TP * 16 + h;
    bf16x8 qr[4];
#pragma unroll
    for (int d0 = 0; d0 < 4; ++d0) qr[d0] = active ? *(const bf16x8*)(QB + (qrow0 + r32) * DM + h * 64 + 16 * d0 + 8 * hi) : (bf16x8){0, 0, 0, 0, 0, 0, 0, 0};
    float mrun = -1e30f, lrun = 0.f; f32x16 o0, o1;
#pragma unroll
    for (int r = 0; r < 16; ++r) { o0[r] = 0.f; o1[r] = 0.f; }
    const int srow = tid >> 3, sch = tid & 7;
    u32x4 kreg, vreg; float breg = 0.f;
#define ATT_LOAD(t) do { const int kv0_ = 64 * (t); \
        if (!SMP) { const size_t ro = ((size_t)b * TP + kv0_ + srow) * DM + h * 64 + sch * 8; kreg = *(const u32x4*)(KB + ro); vreg = *(const u32x4*)(VB + ro); if (tid < 64) breg = -CUM[(size_t)(kv0_ + tid) * 16] * LOG2E; } \
        else if (kv0_ < PAST) { const size_t ro = (((size_t)b * PAST + kv0_ + srow) * NH + h) * 64 + sch * 8; const f32x4 k0 = *(const f32x4*)(a.cache_k + ro), k1 = *(const f32x4*)(a.cache_k + ro + 4), v0 = *(const f32x4*)(a.cache_v + ro), v1 = *(const f32x4*)(a.cache_v + ro + 4); \
            kreg = pack8(k0, k1); vreg = pack8(v0, v1); if (tid < 64) breg = -CUM[(size_t)(kv0_ + tid) * 16] * LOG2E; } \
        else { if (srow < TS) { const size_t ro = ((size_t)MP + (size_t)b * TS + srow) * DM + h * 64 + sch * 8; kreg = *(const u32x4*)(KB + ro); vreg = *(const u32x4*)(VB + ro); } else { kreg = (u32x4){0u, 0u, 0u, 0u}; vreg = kreg; } \
            if (tid < 64) breg = tid < TS ? -CUM[(size_t)(kv0_ + tid) * 16] * LOG2E : 0.f; } } while (0)
#define ATT_STORE(buf) do { *(LAS u32x4*)(Ks + (buf) * 4608 + srow * 72 + sch * 8) = kreg; LAS bf16* vt_ = VT + (buf) * 4608 + (sch * 8) * 72 + srow; \
        vt_[0] = (bf16)(vreg.x & 0xffffu); vt_[72] = (bf16)(vreg.x >> 16); vt_[144] = (bf16)(vreg.y & 0xffffu); vt_[216] = (bf16)(vreg.y >> 16); \
        vt_[288] = (bf16)(vreg.z & 0xffffu); vt_[360] = (bf16)(vreg.z >> 16); vt_[432] = (bf16)(vreg.w & 0xffffu); vt_[504] = (bf16)(vreg.w >> 16); \
        if (tid < 64) CBs[(buf) * 64 + tid] = breg; } while (0)
    ATT_LOAD(0); ATT_STORE(0); __syncthreads();
    for (int t = 0; t < NT; ++t) {
        const int buf = t & 1, kv0 = 64 * t;
        if (t + 1 < NT) ATT_LOAD(t + 1);
        if (active && kv0 <= qpos0 + 31) {
            const LAS bf16* kb = Ks + buf * 4608; const LAS bf16* vb = VT + buf * 4608; const LAS float* cb = CBs + buf * 64;
            f32x16 p0, p1;
#pragma unroll
            for (int r = 0; r < 16; ++r) { p0[r] = 0.f; p1[r] = 0.f; }
#pragma unroll
            for (int d0 = 0; d0 < 4; ++d0) { const bf16x8 a0 = *(const LAS bf16x8*)(kb + r32 * 72 + 16 * d0 + 8 * hi), a1 = *(const LAS bf16x8*)(kb + (32 + r32) * 72 + 16 * d0 + 8 * hi);
                p0 = MFMA32(a0, qr[d0], p0); p1 = MFMA32(a1, qr[d0], p1); }
#pragma unroll
            for (int gq = 0; gq < 4; ++gq) { const f32x4 b0 = *(const LAS f32x4*)(cb + 8 * gq + 4 * hi), b1 = *(const LAS f32x4*)(cb + 32 + 8 * gq + 4 * hi);
#pragma unroll
                for (int i = 0; i < 4; ++i) { p0[4 * gq + i] += b0[i]; p1[4 * gq + i] += b1[i]; } }
            if (kv0 + 63 > qpos0) { const int q = qpos0 + r32;
#pragma unroll
                for (int r = 0; r < 16; ++r) { const int kv = kv0 + (r & 3) + 8 * (r >> 2) + 4 * hi; if (kv > q) p0[r] = -INFINITY; if (kv + 32 > q) p1[r] = -INFINITY; } }
            float mx = fmaxf(p0[0], p1[0]);
#pragma unroll
            for (int r = 1; r < 16; ++r) mx = fmaxf(mx, fmaxf(p0[r], p1[r]));
            mx = fmaxf(mx, __shfl_xor(mx, 32));
            const float mnew = fmaxf(mrun, mx), alpha = __builtin_amdgcn_exp2f(mrun - mnew); mrun = mnew;
            float sum = 0.f;
#pragma unroll
            for (int r = 0; r < 16; ++r) { p0[r] = __builtin_amdgcn_exp2f(p0[r] - mnew); p1[r] = __builtin_amdgcn_exp2f(p1[r] - mnew); sum += p0[r] + p1[r]; }
            lrun = lrun * alpha + sum;
#pragma unroll
            for (int r = 0; r < 16; ++r) { o0[r] *= alpha; o1[r] *= alpha; }
            u32x4 pw[2][2];
#pragma unroll
            for (int hf = 0; hf < 2; ++hf) { pw[0][hf] = (u32x4){pk2(p0[8 * hf], p0[8 * hf + 1]), pk2(p0[8 * hf + 2], p0[8 * hf + 3]), pk2(p0[8 * hf + 4], p0[8 * hf + 5]), pk2(p0[8 * hf + 6], p0[8 * hf + 7])};
                pw[1][hf] = (u32x4){pk2(p1[8 * hf], p1[8 * hf + 1]), pk2(p1[8 * hf + 2], p1[8 * hf + 3]), pk2(p1[8 * hf + 4], p1[8 * hf + 5]), pk2(p1[8 * hf + 6], p1[8 * hf + 7])}; }
#pragma unroll
            for (int kt = 0; kt < 2; ++kt)
#pragma unroll
                for (int hf = 0; hf < 2; ++hf) { const bf16x8 pb = __builtin_bit_cast(bf16x8, pw[kt][hf]);
                    { const LAS bf16* vp = vb + r32 * 72 + 32 * kt + 16 * hf + 4 * hi; const s16x4 lo = *(const LAS s16x4*)vp, h4 = *(const LAS s16x4*)(vp + 8);
                      const bf16x8 av = {lo[0], lo[1], lo[2], lo[3], h4[0], h4[1], h4[2], h4[3]}; o0 = MFMA32(av, pb, o0); }
                    { const LAS bf16* vp = vb + (32 + r32) * 72 + 32 * kt + 16 * hf + 4 * hi; const s16x4 lo = *(const LAS s16x4*)vp, h4 = *(const LAS s16x4*)(vp + 8);
                      const bf16x8 av = {lo[0], lo[1], lo[2], lo[3], h4[0], h4[1], h4[2], h4[3]}; o1 = MFMA32(av, pb, o1); } }
        }
        if (t + 1 < NT) ATT_STORE(buf ^ 1);
        __syncthreads();
    }
    if (active) { const float lt = lrun + __shfl_xor(lrun, 32), inv = 1.f / lt; bf16* orow = OB + (qrow0 + r32) * DM + h * 64;
#pragma unroll
        for (int gq = 0; gq < 4; ++gq) { u32x2 w0, w1; w0.x = pk2(o0[4 * gq] * inv, o0[4 * gq + 1] * inv); w0.y = pk2(o0[4 * gq + 2] * inv, o0[4 * gq + 3] * inv);
            w1.x = pk2(o1[4 * gq] * inv, o1[4 * gq + 1] * inv); w1.y = pk2(o1[4 * gq + 2] * inv, o1[4 * gq + 3] * inv);
            *(u32x2*)(orow + 8 * gq + 4 * hi) = w0; *(u32x2*)(orow + 32 + 8 * gq + 4 * hi) = w1; } }
#undef ATT_LOAD
#undef ATT_STORE
}
__device__ __forceinline__ void phase_attention(const Args& a, LAS unsigned char* lds, char* lds_gen) {
    const attn_body::AttnTensors AT{(const attn_body::bf16*)(a.ws + WS_BIG), (const attn_body::bf16*)(a.ws + WS_BIG) + (size_t)MT * DM, (const attn_body::bf16*)(a.ws + WS_BIG) + (size_t)2 * MT * DM,
                                    (attn_body::bf16*)(a.ws + WS_BIG) + (size_t)3 * MT * DM, (const float*)(a.ws + WS_CUMP)};
    const attn_body::StaticOrder S((int)gridDim.x, (int)blockIdx.x);
    attn_body::attn_phase<attn_body::StaticOrder>(lds_gen, AT, S);
    for (int u = blockIdx.x; u < NBS * NH; u += gridDim.x) attn_unit<true>(a, lds, u >> 4, u & 15, 0);
}

struct SampleOrder {
    int pn;
    __device__ __forceinline__ bool next(int i, pg8::Unit& u) const { if (i > 0 || pn < 0) return false; u.pm = MP / 256; u.pn = pn; return true; }
    __device__ __forceinline__ void a_ready(const pg8::Unit&) const {}
    __device__ __forceinline__ void done(const pg8::Unit&) const {}
};
constexpr int N_PHASES = 14;
__global__ void __launch_bounds__(512, 2) fox_ssd_fwd(Args a) {
    extern __shared__ __attribute__((aligned(16))) unsigned char lds_raw[];
    LAS unsigned char* lds = (LAS unsigned char*)lds_raw;
    const int lo = a.ph_lo, hi = a.ph_hi, G = gridDim.x, bx = blockIdx.x, tid = threadIdx.x;
#ifndef REPMASK
#define REPMASK 0
#endif
#ifndef PHMASK
#define PHMASK 0x3fff
#endif
#define IN(k) (((PHMASK >> (k)) & 1) && lo <= (k) && (k) < hi)
#ifndef FAST_BAR
#define FAST_BAR 1
#endif
#define SEAM(k) do { if (IN(k) && IN((k) + 1)) { if (a.coop) { if (!FAST_BAR || ((k) == 0 && a.pad != 0)) cg::this_grid().sync(); else xcd_barrier(xbar); } } } while (0)
    XcdBarrier xbar; xbar.bar = (unsigned*)a.ws; xbar.x = 0; xbar.st = nullptr;
    if (FAST_BAR && a.coop) { volatile LAS unsigned* stw = (volatile LAS unsigned*)(lds + 139264); if (tid < 2) stw[tid] = 0u; __syncthreads(); xbar = xcd_barrier_post((unsigned*)a.ws, stw); }
    bf16* WIN = (bf16*)(a.ws + WS_WIN); bf16* XN = (bf16*)(a.ws + WS_XN); bf16* BIG = (bf16*)(a.ws + WS_BIG); bf16* SG = (bf16*)(a.ws + WS_SG);
    bf16* QB = BIG; bf16* KB = BIG + (size_t)MT * DM; bf16* VB = KB + (size_t)MT * DM; bf16* TMP = VB + (size_t)MT * DM; bf16* SGA = SG; bf16* SGS = SG + (size_t)MT * DM;
    bf16* Z = (bf16*)(a.out + O_Y);
    if (IN(0)) for (int rep_ = 0; rep_ <= ((REPMASK >> 0) & 1); ++rep_) phase_prologue(a);
    SEAM(0);
    if (IN(1)) for (int rep_ = 0; rep_ <= ((REPMASK >> 1) & 1); ++rep_) { EpiP1 E{Z, BIG, (float*)(a.ws + WS_LOGF), (float*)(a.ws + WS_DT), a.out, a.b_f, a.dt_bias}; run_gemm(lds, XN, WIN, 25 * 256, DM, E);
        { const int spn = (int)bx - (G - 20); SampleOrder SO{(G == 256 && spn >= 0) ? spn : -1};
          EpiP3 ES{(bf16*)(a.ws + WS_QS) - (size_t)MP * DM, (bf16*)(a.ws + WS_KS) - (size_t)MP * DM, (bf16*)(a.ws + WS_VS) - (size_t)MP * DM, (bf16*)(a.ws + WS_SGAS) - (size_t)MP * DM, (bf16*)(a.ws + WS_SGSS) - (size_t)MP * DM, a.out, a.q_norm_w, a.k_norm_w};
          pg8::Gemm gs{XN, WIN + (size_t)25 * 256 * DM, MT, 20 * 256, DM};
          pg8::gemm_phase<EpiP3, SampleOrder, true, true>(lds, gs, SO, ES); } }
    SEAM(1);
    if (IN(2)) for (int rep_ = 0; rep_ <= ((REPMASK >> 2) & 1); ++rep_) {
        phase_bc_conv(a);
        { const int nC = NBP * 16 + NBS * 5; for (int it = G - 1 - bx; it < nC; it += G) cumsum_item(a, lds, it); }
    }
    SEAM(2);
    if (IN(3)) {
        const int nA = NBP * 7 * 8;
        for (int rep = 0; rep <= ((REPMASK >> 3) & 1); ++rep)
        for (int it = bx; it < nA; it += G) { const int g = it & 7, r = it >> 3; ssd_item(a, lds, 0, 0, r / 7, r % 7, g); }

    }
    SEAM(3);
    if (IN(5)) {
        const int nP = NBP * 8 * 8, nS = NBS * 8;
        for (int rep = 0; rep <= ((REPMASK >> 5) & 1); ++rep)
        for (int it = bx; it < nP + nS; it += G) { if (it < nP) { const int g = it & 7, r = it >> 3; ssd_item(a, lds, 1, 0, r >> 3, r & 7, g); } else { const int r = it - nP; ssd_item(a, lds, 1, 1, r >> 3, 0, r & 7); } }
    }
    SEAM(5);
    if (IN(7)) cumsum_fixup(a, lds);
    if (IN(7)) for (int rep_ = 0; rep_ <= ((REPMASK >> 7) & 1); ++rep_) { EpiP3 E{QB, KB, VB, SGA, SGS, a.out, a.q_norm_w, a.k_norm_w}; run_gemm(lds, XN, WIN + (size_t)25 * 256 * DM, 20 * 256, DM, E, MP); }
    SEAM(7);
    if (IN(8)) { for (int rep = 0; rep <= ((REPMASK >> 8) & 1); ++rep) phase_attention(a, lds, (char*)lds_raw); }
    SEAM(8);
    if (IN(9)) for (int rep_ = 0; rep_ <= ((REPMASK >> 9) & 1); ++rep_) { EpiGate<0> E{SGA, nullptr, VB}; run_gemm(lds, TMP, (const bf16*)(a.ws + WS_WPA), DM, DM, E, MP); mini_gemm<0>(a, lds, TMP, (const bf16*)(a.ws + WS_WPA), DM, (const bf16*)(a.ws + WS_SGAS) - (size_t)MP * DM, nullptr, VB, nullptr, nullptr); }
    if (IN(10)) for (int rep_ = 0; rep_ <= ((REPMASK >> 10) & 1); ++rep_) { EpiGate<1> E{SGS, VB, KB}; run_gemm(lds, Z, (const bf16*)(a.ws + WS_WPB), DM, DI, E, MP); mini_gemm<1>(a, lds, Z, (const bf16*)(a.ws + WS_WPB), DI, (const bf16*)(a.ws + WS_SGSS) - (size_t)MP * DM, VB, KB, nullptr, nullptr); }
    SEAM(10);
    if (IN(11)) for (int rep_ = 0; rep_ <= ((REPMASK >> 11) & 1); ++rep_) { EpiRes E{a.x_prompt, a.x_sample, a.out, 1, XN, a.norm2_w, (float*)(a.ws + WS_LOGF)}; run_gemm(lds, KB, (const bf16*)(a.ws + WS_WOUT), DM, DM, E, MP); mini_gemm<2>(a, lds, KB, (const bf16*)(a.ws + WS_WOUT), DM, nullptr, nullptr, nullptr, XN, (float*)(a.ws + WS_LOGF)); }
    SEAM(11);
    if (IN(12)) for (int rep_ = 0; rep_ <= ((REPMASK >> 12) & 1); ++rep_) { EpiRelu2 E{BIG, FF, (const float*)(a.ws + WS_LOGF)}; run_gemm(lds, XN, (const bf16*)(a.ws + WS_WUP), FF, DM, E); }
    SEAM(12);
    if (IN(13)) { EpiRes E{nullptr, nullptr, a.out, 0, nullptr, nullptr, nullptr}; run_gemm(lds, BIG, (const bf16*)(a.ws + WS_WDN), DM, FF, E, MP); mini_gemm<3>(a, lds, BIG, (const bf16*)(a.ws + WS_WDN), FF, nullptr, nullptr, nullptr, nullptr, nullptr); }
#undef IN
#undef SEAM
}

extern "C" void kernel_launch(void* const* d_in, const int* in_sizes, int n_in, void* d_out, int out_size, void* d_ws, size_t ws_size, hipStream_t stream) {
    static int grid = 0;
    if (grid == 0) {
        if (n_in != 24 || (size_t)out_size != O_END || ws_size < WS_END) { fprintf(stderr, "kernel_launch: unexpected shapes: n_in %d out %d ws %zu\n", n_in, out_size, ws_size); grid = -1; return; }
        int dev = 0, cus = 0, per_cu = 0;
        if (hipGetDevice(&dev) != hipSuccess || hipDeviceGetAttribute(&cus, hipDeviceAttributeMultiprocessorCount, dev) != hipSuccess) { grid = -1; return; }
        if (hipFuncSetAttribute((const void*)fox_ssd_fwd, hipFuncAttributeMaxDynamicSharedMemorySize, LDS_BYTES) != hipSuccess) { fprintf(stderr, "kernel_launch: hipFuncSetAttribute failed\n"); grid = -1; return; }
        if (hipOccupancyMaxActiveBlocksPerMultiprocessor(&per_cu, (const void*)fox_ssd_fwd, 512, LDS_BYTES) != hipSuccess || per_cu < 1) per_cu = 1;
        (void)hipGetLastError();
        grid = cus * per_cu;
    }
    if (grid < 0) return;
    Args a{};
    const float** pp = (const float**)&a;
    for (int i = 0; i < 24; ++i) pp[i] = (const float*)d_in[i];
    a.out = (float*)d_out; a.ws = (unsigned char*)d_ws;
#if MK_MULTI
    for (int p = 0; p < N_PHASES; ++p) { a.ph_lo = p; a.ph_hi = p + 1; a.coop = 0; hipLaunchKernelGGL(fox_ssd_fwd, dim3(grid), dim3(512), LDS_BYTES, stream, a); }
#else
    a.ph_lo = 0; a.ph_hi = N_PHASES; a.coop = 1;
    (void)hipMemsetAsync(d_ws, 0, 16384, stream);
    void* args[] = {&a};
    hipError_t e = hipLaunchCooperativeKernel((const void*)fox_ssd_fwd, dim3(grid), dim3(512), args, LDS_BYTES, stream);
    if (e != hipSuccess) fprintf(stderr, "cooperative launch failed: %s (grid %d)\n", hipGetErrorString(e), grid);
#endif
}
```

```cpp
#include <hip/hip_runtime.h>
#include <hip/hip_cooperative_groups.h>
#include <cstdio>
#include <cstdint>
#include <cmath>
namespace cg = cooperative_groups;
namespace pg8 {
#define PG8_LAS __attribute__((address_space(3)))
typedef unsigned short bf16_t;
typedef short bf16x8 __attribute__((ext_vector_type(8)));
typedef float f32x4 __attribute__((ext_vector_type(4)));
typedef unsigned u32x4 __attribute__((ext_vector_type(4)));
constexpr int BM = 256, BK = 64, HALF = 128, HTB = HALF * BK * 2  , STAGE_BYTES = 8 * HTB, NXCD = 8, WGM = 8;

__host__ __device__ __forceinline__ int lds_byte(int r, int c) { const int st = (r >> 4) * 2 + (c >> 5), rr = r & 15, cc = c & 31, ob = rr * 64 + cc * 2; return st * 1024 + (ob ^ (((ob >> 9) & 1) << 5)); }
__host__ __device__ __forceinline__ void stage_rc(int b, int& R, int& C) { const int st = b / 1024, sb = b % 1024, swz = sb ^ (((sb >> 9) & 1) << 5); R = (st >> 1) * 16 + swz / 64; C = (st & 1) * 32 + (swz % 64) / 2; }
__host__ __device__ __forceinline__ int perm32(int rho) { const int n = rho >> 4, i = rho & 15; return 8 * (i >> 2) + 4 * n + (i & 3); }

struct Unit { int pm, pn; };
struct Gemm { const bf16_t* A; const bf16_t* Bt; int M, N, K; };

struct StaticOrder {
    int nM, nN, nwg, G, c;
    __host__ __device__ void init(int M, int N, int G_, int c_) { nM = M / BM; nN = N / BM; nwg = nM * nN; G = G_; c = c_; }
    __host__ __device__ bool next(int i, Unit& u) const {
        const long L = (long)i * G + c; if (L >= nwg) return false;
        int wgid = (int)L; { const int q = nwg / NXCD, r = nwg % NXCD, xcd = wgid % NXCD, off = wgid / NXCD; wgid = (xcd < r ? xcd * (q + 1) : r * (q + 1) + (xcd - r) * q) + off; }
        const int nig = WGM * nN, gid = wgid / nig, fm = gid * WGM, gsz = (nM - fm) < WGM ? (nM - fm) : WGM;
        u.pm = fm + ((wgid % nig) % gsz); u.pn = (wgid % nig) / gsz; return true;
    }
    __device__ __forceinline__ void a_ready(const Unit&) const {}
    __device__ __forceinline__ void done(const Unit&) const {}
};

__device__ __forceinline__ unsigned cvt_pk_bf16(float lo, float hi) { unsigned r; asm volatile("v_cvt_pk_bf16_f32 %0, %1, %2" : "=v"(r) : "v"(lo), "v"(hi)); return r; }
typedef float f32x2 __attribute__((ext_vector_type(2)));
template <class Epi, class Sched, bool ALIGN_EPI = false, bool SP2 = false>
__device__ __forceinline__ void gemm_phase(PG8_LAS unsigned char* lds, const Gemm g, const Sched& S, const Epi& E) {
    const int tid = threadIdx.x, wid = __builtin_amdgcn_readfirstlane(tid >> 6), lane = tid & 63, wr = wid >> 2, wc = wid & 3, fr = lane & 15, fq = lane >> 4;
    const int K = g.K, nt = K / BK;
    unsigned voffA[2], voffB[2];
#pragma unroll
    for (int i = 0; i < 2; ++i) { int R, C; stage_rc(tid * 16 + i * 8192, R, C); const int Rb = Epi::PERM ? ((R & ~31) + perm32(R & 31)) : R;
        voffA[i] = (unsigned)(R * K + C) * 2u; voffB[i] = (unsigned)(Rb * K + C) * 2u; }
    const size_t kstep = (size_t)(BK * 2);
    const size_t hstep = (size_t)HALF * K * 2;
    const size_t tstep = 2 * hstep;
    const unsigned ldsw = (unsigned)wid * 1024u;
    const int aoff = lds_byte(wr * 64 + fr, fq * 8), boff = lds_byte(wc * 32 + fr, fq * 8);
#define PG8_SA(b, h) (((b) * 2 + (h)) * HTB)
#define PG8_SB(b, h) ((4 + (b) * 2 + (h)) * HTB)
#define PG8_STAGE(bufoff, gbase, voff) do { _Pragma("unroll") for (int _i = 0; _i < 2; ++_i) \
        __builtin_amdgcn_global_load_lds((const unsigned*)((const char*)(gbase) + (voff)[_i]), (PG8_LAS unsigned*)(lds + (bufoff) + ldsw + _i * 8192), 16, 0, 0); } while (0)
#define PG8_LDA(dst, b, h) do { _Pragma("unroll") for (int m = 0; m < 4; ++m) _Pragma("unroll") for (int k = 0; k < 2; ++k) dst[m][k] = *(const PG8_LAS bf16x8*)(lds + PG8_SA(b, h) + aoff + m * 2048 + k * 1024); } while (0)
#define PG8_LDB(dst, b, h) do { _Pragma("unroll") for (int n = 0; n < 2; ++n) _Pragma("unroll") for (int k = 0; k < 2; ++k) dst[n][k] = *(const PG8_LAS bf16x8*)(lds + PG8_SB(b, h) + boff + n * 2048 + k * 1024); } while (0)
#define PG8_MMA(ai, bj, At, Bt) do { __builtin_amdgcn_s_setprio(1); _Pragma("unroll") for (int m = 0; m < 4; ++m) _Pragma("unroll") for (int n = 0; n < 2; ++n) _Pragma("unroll") for (int k = 0; k < 2; ++k) \
        acc[ai][bj][m][n] = __builtin_amdgcn_mfma_f32_16x16x32_bf16(Bt[n][k], At[m][k], acc[ai][bj][m][n], 0, 0, 0); __builtin_amdgcn_s_setprio(0); } while (0)
#define PG8_WAIT_V(n) asm volatile("s_waitcnt vmcnt(" #n ")" ::: "memory")
#define PG8_WAIT_L(n) asm volatile("s_waitcnt lgkmcnt(" #n ")" ::: "memory")
#define PG8_BAR __builtin_amdgcn_s_barrier()
#define PG8_SCHED __builtin_amdgcn_sched_barrier(0)
    Unit cur, nxt; int ui = 0;
    if (!S.next(0, cur)) return;
    f32x4 acc[2][2][4][2];
#pragma unroll
    for (int a = 0; a < 2; ++a)
#pragma unroll
        for (int b = 0; b < 2; ++b)
#pragma unroll
            for (int m = 0; m < 4; ++m)
#pragma unroll
                for (int n = 0; n < 2; ++n) acc[a][b][m][n] = (f32x4){0.f, 0.f, 0.f, 0.f};
    bf16x8 At[4][2], B0[2][2], B1[2][2];
    const char* cA = (const char*)g.A + (size_t)cur.pm * tstep; const char* cB = (const char*)g.Bt + (size_t)cur.pn * tstep;
    S.a_ready(cur);
    if constexpr (SP2) {
        PG8_STAGE(PG8_SB(0, 0), cB, voffB); PG8_STAGE(PG8_SB(0, 1), cB + hstep, voffB); PG8_STAGE(PG8_SA(0, 0), cA, voffA); PG8_STAGE(PG8_SA(0, 1), cA + hstep, voffA);
        if (wr == 1) PG8_BAR;
        PG8_WAIT_V(2); PG8_BAR;
        PG8_STAGE(PG8_SB(1, 0), cB + kstep, voffB); PG8_STAGE(PG8_SA(1, 0), cA + kstep, voffA); PG8_STAGE(PG8_SB(1, 1), cB + hstep + kstep, voffB);
        PG8_WAIT_V(6); PG8_BAR;
    } else {
        PG8_STAGE(PG8_SB(0, 0), cB, voffB); PG8_STAGE(PG8_SA(0, 0), cA, voffA); PG8_STAGE(PG8_SB(0, 1), cB + hstep, voffB); PG8_STAGE(PG8_SA(0, 1), cA + hstep, voffA);
        if (wr == 1) PG8_BAR;
        PG8_WAIT_V(4); PG8_BAR;
        PG8_STAGE(PG8_SB(1, 0), cB + kstep, voffB); PG8_STAGE(PG8_SA(1, 0), cA + kstep, voffA); PG8_STAGE(PG8_SB(1, 1), cB + hstep + kstep, voffB);
        PG8_WAIT_V(6); PG8_BAR;
    }
    for (;;) {
        const bool has_next = S.next(ui + 1, nxt);
        const char* nA = has_next ? (const char*)g.A + (size_t)nxt.pm * tstep : cA; const char* nB = has_next ? (const char*)g.Bt + (size_t)nxt.pn * tstep : cB;
        for (int t = 0; t < nt; t += 2) {
            const bool last = (t == nt - 2);
            const char* a1 = cA + (size_t)(t + 1) * kstep;
            const char* a2 = last ? nA : cA + (size_t)(t + 2) * kstep; const char* b2 = last ? nB : cB + (size_t)(t + 2) * kstep;
            const char* a3 = a2 + kstep; const char* b3 = b2 + kstep;
            if (last && has_next) S.a_ready(nxt);
            if constexpr (SP2) {
            PG8_LDB(B0, 0, 0); PG8_LDB(B1, 0, 1); PG8_SCHED; PG8_LDA(At, 0, 0); PG8_STAGE(PG8_SA(1, 1), a1 + hstep, voffA);
            PG8_WAIT_V(8); PG8_WAIT_L(0); PG8_BAR; PG8_MMA(0, 0, At, B0); PG8_MMA(0, 1, At, B1); PG8_BAR; PG8_SCHED;
            PG8_LDA(At, 0, 1); PG8_STAGE(PG8_SB(0, 0), b2, voffB); PG8_STAGE(PG8_SB(0, 1), b2 + hstep, voffB); PG8_STAGE(PG8_SA(0, 0), a2, voffA);
            PG8_WAIT_V(8); PG8_WAIT_L(0); PG8_BAR; PG8_MMA(1, 0, At, B0); PG8_MMA(1, 1, At, B1); PG8_BAR; PG8_SCHED;
            PG8_LDB(B0, 1, 0); PG8_LDB(B1, 1, 1); PG8_SCHED; PG8_LDA(At, 1, 0); PG8_STAGE(PG8_SA(0, 1), a2 + hstep, voffA);
            PG8_WAIT_V(8); PG8_WAIT_L(0); PG8_BAR; PG8_MMA(0, 0, At, B0); PG8_MMA(0, 1, At, B1); PG8_BAR; PG8_SCHED;
            PG8_LDA(At, 1, 1); PG8_STAGE(PG8_SB(1, 0), b3, voffB); PG8_STAGE(PG8_SB(1, 1), b3 + hstep, voffB); PG8_STAGE(PG8_SA(1, 0), a3, voffA);
            PG8_WAIT_V(8); PG8_WAIT_L(0); PG8_BAR; PG8_MMA(1, 0, At, B0); PG8_MMA(1, 1, At, B1); PG8_BAR; PG8_SCHED;
            } else {
            PG8_LDB(B0, 0, 0); PG8_SCHED; PG8_LDA(At, 0, 0); PG8_STAGE(PG8_SA(1, 1), a1 + hstep, voffA);
            PG8_WAIT_L(8); PG8_BAR; PG8_WAIT_L(0); PG8_MMA(0, 0, At, B0); PG8_BAR; PG8_SCHED;
            PG8_LDB(B1, 0, 1); PG8_STAGE(PG8_SB(0, 0), b2, voffB);
            PG8_BAR; PG8_WAIT_L(0); PG8_MMA(0, 1, At, B1); PG8_BAR;
            PG8_LDA(At, 0, 1); PG8_STAGE(PG8_SA(0, 0), a2, voffA);
            PG8_BAR; PG8_WAIT_L(0); PG8_MMA(1, 0, At, B0); PG8_BAR; PG8_SCHED;
            PG8_STAGE(PG8_SB(0, 1), b2 + hstep, voffB);
            PG8_WAIT_V(6); PG8_BAR; PG8_MMA(1, 1, At, B1); PG8_BAR;
            PG8_LDB(B0, 1, 0); PG8_SCHED; PG8_LDA(At, 1, 0); PG8_STAGE(PG8_SA(0, 1), a2 + hstep, voffA);
            PG8_WAIT_L(8); PG8_BAR; PG8_WAIT_L(0); PG8_MMA(0, 0, At, B0); PG8_BAR; PG8_SCHED;
            PG8_LDB(B1, 1, 1); PG8_STAGE(PG8_SB(1, 0), b3, voffB);
            PG8_BAR; PG8_WAIT_L(0); PG8_MMA(0, 1, At, B1); PG8_BAR;
            PG8_LDA(At, 1, 1); PG8_STAGE(PG8_SA(1, 0), a3, voffA);
            PG8_BAR; PG8_WAIT_L(0); PG8_MMA(1, 0, At, B0); PG8_BAR; PG8_SCHED;
            PG8_STAGE(PG8_SB(1, 1), b3 + hstep, voffB);
            PG8_WAIT_V(6); PG8_BAR; PG8_MMA(1, 1, At, B1); PG8_BAR;
            }
        }
        if constexpr (ALIGN_EPI) { if (wr == 0) PG8_BAR; }
        if constexpr (!Epi::AFTER_DRAIN) { E(acc, cur, wr, wc, fr, fq); S.done(cur); }
        if (!has_next) break;
#pragma unroll
        for (int a = 0; a < 2; ++a)
#pragma unroll
            for (int b = 0; b < 2; ++b)
#pragma unroll
                for (int m = 0; m < 4; ++m)
#pragma unroll
                    for (int n = 0; n < 2; ++n) acc[a][b][m][n] = (f32x4){0.f, 0.f, 0.f, 0.f};
        cur = nxt; cA = nA; cB = nB; ++ui;
        if constexpr (ALIGN_EPI) { if (wr == 1) PG8_BAR; }
    }
    PG8_WAIT_V(0);
    if constexpr (!ALIGN_EPI) { if (wr == 0) PG8_BAR; }
    PG8_BAR;
    if constexpr (Epi::AFTER_DRAIN) { E.fused(acc, cur, wr, wc, fr, fq, lds, wid, lane); S.done(cur); }
#undef PG8_SA
#undef PG8_SB
#undef PG8_STAGE
#undef PG8_LDA
#undef PG8_LDB
#undef PG8_MMA
#undef PG8_WAIT_V
#undef PG8_WAIT_L
#undef PG8_BAR
#undef PG8_SCHED
}
}

#ifndef MK_MULTI
#define MK_MULTI 0
#endif
#define LAS __attribute__((address_space(3)))
typedef unsigned short bf16;
typedef short bf16x8 __attribute__((ext_vector_type(8)));
typedef short s16x4 __attribute__((ext_vector_type(4)));
typedef float f32x4 __attribute__((ext_vector_type(4)));
typedef float f32x16 __attribute__((ext_vector_type(16)));
typedef unsigned u32x4 __attribute__((ext_vector_type(4)));
typedef unsigned u32x2 __attribute__((ext_vector_type(2)));

constexpr int DM = 1024, TP = 8192, NBP = 4, NBS = 8, TS = 32, PAST = 2048, MP = NBP * TP, MS = NBS * TS, MT = MP + MS;
constexpr int NH = 16, DI = 2048, NHS = 32, DST = 128, CONVD = 4096, DPROJ = 11312, FF = 4096, NWIN = 11520, SKV = PAST + TS;
constexpr float EPS = 1e-6f, LOG2E = 1.4426950408889634f, QSCALE = 0.125f * LOG2E;
constexpr size_t O_Y = 0, O_KP = (size_t)MT * DM, O_VP = O_KP + (size_t)MP * DM, O_LP = O_VP + (size_t)MP * DM, O_CP = O_LP + (size_t)MP * NH,
                 O_SP = O_CP + (size_t)NBP * 3 * CONVD, O_KS = O_SP + (size_t)NBP * NHS * 64 * DST, O_VS = O_KS + (size_t)MS * DM, O_LS = O_VS + (size_t)MS * DM,
                 O_CS = O_LS + (size_t)MS * NH, O_SS = O_CS + (size_t)NBS * 3 * CONVD, O_END = O_SS + (size_t)NBS * NHS * 64 * DST;
static_assert(O_END == 105271296, "d_out map");
constexpr size_t MiB = 1u << 20, U1 = (size_t)MT * DM * 2;
constexpr size_t WS_WIN = 1 * MiB, WS_WPA = 24 * MiB, WS_WPB = 26 * MiB, WS_WOUT = 30 * MiB, WS_WUP = 32 * MiB, WS_WDN = 40 * MiB;
constexpr size_t WS_LOGF = 48 * MiB, WS_CUMP = 51 * MiB, WS_CUMS = 53 * MiB, WS_DT = 55 * MiB, WS_SEGDEC = 59 * MiB + MiB / 2;
constexpr size_t WS_QS = 64 * 1024, WS_KS = 23 * MiB + MiB / 2, WS_VS = 50 * MiB + MiB / 4, WS_SGAS = 54 * MiB + MiB / 4, WS_SGSS = 511 * MiB + MiB / 2;
constexpr size_t WS_XN = 60 * MiB, WS_BIG = WS_XN + U1, WS_SG = WS_BIG + 4 * U1, WS_END = WS_SG + 2 * U1 + MiB / 2;
static_assert(WS_END <= 512 * MiB, "d_ws map");
constexpr int LDS_BYTES = 147456;

struct Args {
    const float *x_prompt, *x_sample, *cache_k, *cache_v, *cache_logf, *state_conv, *state_ssm, *norm1_w, *w_in, *b_f, *q_norm_w, *k_norm_w, *conv_w, *conv_b,
        *dt_bias, *A_log, *D_skip, *ssm_norm_w, *w_pa, *w_pb, *w_out, *norm2_w, *w_up, *w_down;
    float* out; unsigned char* ws; int ph_lo, ph_hi, coop, pad;
};

__device__ __forceinline__ unsigned f2bf(float f) { unsigned u = __builtin_bit_cast(unsigned, f); return (u + 0x7fffu + ((u >> 16) & 1u)) >> 16; }
typedef float f32x2_t __attribute__((ext_vector_type(2))); typedef __bf16 bf16x2_t __attribute__((ext_vector_type(2)));
__device__ __forceinline__ unsigned pk2(float lo, float hi) { f32x2_t v = {lo, hi}; bf16x2_t b = __builtin_convertvector(v, bf16x2_t); return __builtin_bit_cast(unsigned, b); }
__device__ __forceinline__ float bflo(unsigned w) { return __uint_as_float(w << 16); }
__device__ __forceinline__ float bfhi(unsigned w) { return __uint_as_float(w & 0xffff0000u); }
__device__ __forceinline__ float bf2f(bf16 v) { return __uint_as_float(((unsigned)v) << 16); }
__device__ __forceinline__ float wave_sum(float v) {
#pragma unroll
    for (int o = 1; o < 64; o <<= 1) v += __shfl_xor(v, o);
    return v;
}
__device__ __forceinline__ float sigmoidf_(float x) { return __builtin_amdgcn_rcpf(1.f + __expf(-x)); }
__device__ __forceinline__ float softplusf_(float x) { return fmaxf(x, 0.f) + __logf(1.f + __expf(-fabsf(x))); }
__device__ __forceinline__ const float* xrow_ptr(const Args& a, int m) { return m < MP ? a.x_prompt + (size_t)m * DM : a.x_sample + (size_t)(m - MP) * DM; }

__device__ __forceinline__ int win_src_col(int n) {
    if (n < 2048) return 3088 + n;
    if (n < 6144) return 5136 + (n - 2048);
    if (n < 6400) { const int j = n - 6144; if (j < 16) return 3072 + j; if (j < 48) return 9232 + (j - 16); return -1; }
    if (n < 8448) { int p = n - 6400; const int isk = p >= 1024; p &= 1023; const int tq = p >> 8, pp = p & 255, bj = pp >> 7, wc = (pp & 127) >> 5, e = pp & 31;
                    return (isk ? 1024 : 0) + (4 * tq + wc) * 64 + 32 * bj + e; }
    if (n < 9472) return 2048 + (n - 8448);
    if (n < 10496) return 9264 + (n - 9472);
    return 10288 + (n - 10496);
}
__device__ __forceinline__ void wt_item(const float* __restrict__ W, int K, int N, bf16* WT, int nblk, int item, bool is_win, int tid) {
    const int nb = item % nblk, kb = item / nblk, n = nb * 64 + (tid & 63), k0 = kb * 64 + (tid >> 6) * 8;
    const int sc = is_win ? win_src_col(n) : n;
    float v[8];
#pragma unroll
    for (int i = 0; i < 8; ++i) v[i] = sc >= 0 ? W[(size_t)(k0 + i) * N + sc] : 0.f;
    u32x4 o; o.x = pk2(v[0], v[1]); o.y = pk2(v[2], v[3]); o.z = pk2(v[4], v[5]); o.w = pk2(v[6], v[7]);
    *(u32x4*)(WT + (size_t)n * K + k0) = o;
}
__device__ __forceinline__ void rms_row_to_bf16(const float* xrow, const float* w, bf16* orow, int lane) {
    const f32x4* xr = (const f32x4*)xrow + lane; f32x4 v[4]; float s = 0.f;
#pragma unroll
    for (int j = 0; j < 4; ++j) { v[j] = xr[64 * j]; s += (v[j].x * v[j].x + v[j].y * v[j].y) + (v[j].z * v[j].z + v[j].w * v[j].w); }
    const float rstd = rsqrtf(wave_sum(s) * (1.f / DM) + EPS);
#pragma unroll
    for (int j = 0; j < 4; ++j) { const f32x4 wv = ((const f32x4*)w)[lane + 64 * j]; u32x2 o; o.x = pk2(v[j].x * rstd * wv.x, v[j].y * rstd * wv.y); o.y = pk2(v[j].z * rstd * wv.z, v[j].w * rstd * wv.w);
        *((u32x2*)orow + lane + 64 * j) = o; }
}
__device__ __forceinline__ void phase_prologue(const Args& a) {
    const int tid = threadIdx.x, lane = tid & 63, wid = tid >> 6, G = gridDim.x, bx = blockIdx.x;
    constexpr int I_WIN = (NWIN / 64) * (DM / 64), I_PA = 16 * 16, I_PB = 16 * 32, I_OUT = 16 * 16, I_UP = 64 * 16, I_DN = 16 * 64, NIT = I_WIN + I_PA + I_PB + I_OUT + I_UP + I_DN;
    for (int it = bx; it < NIT; it += G) {
        int r = it;
        if (r < I_WIN) { wt_item(a.w_in, DM, DPROJ, (bf16*)(a.ws + WS_WIN), NWIN / 64, r, true, tid); continue; } r -= I_WIN;
        if (r < I_PA) { wt_item(a.w_pa, DM, DM, (bf16*)(a.ws + WS_WPA), 16, r, false, tid); continue; } r -= I_PA;
        if (r < I_PB) { wt_item(a.w_pb, DI, DM, (bf16*)(a.ws + WS_WPB), 16, r, false, tid); continue; } r -= I_PB;
        if (r < I_OUT) { wt_item(a.w_out, DM, DM, (bf16*)(a.ws + WS_WOUT), 16, r, false, tid); continue; } r -= I_OUT;
        if (r < I_UP) { wt_item(a.w_up, DM, FF, (bf16*)(a.ws + WS_WUP), 64, r, false, tid); continue; } r -= I_UP;
        wt_item(a.w_down, FF, DM, (bf16*)(a.ws + WS_WDN), 16, r, false, tid);
    }
    bf16* XN = (bf16*)(a.ws + WS_XN);
    for (int m = bx * 8 + wid; m < MT; m += G * 8) rms_row_to_bf16(xrow_ptr(a, m), a.norm1_w, XN + (size_t)m * DM, lane);
}

#define EPI_ROW(u, ai, m) ((u).pm * 256 + (ai) * 128 + wr * 64 + (m) * 16 + fr)
#define EPI_CB(bj) ((bj) * 128 + wc * 32 + 8 * fq)
__device__ __forceinline__ u32x4 pack8(const f32x4 v0, const f32x4 v1) { u32x4 w; w.x = pk2(v0[0], v0[1]); w.y = pk2(v0[2], v0[3]); w.z = pk2(v1[0], v1[1]); w.w = pk2(v1[2], v1[3]); return w; }

struct EpiP1 {
    static constexpr bool PERM = true, AFTER_DRAIN = false;
    bf16* Z; bf16* XBC; float* logf_ws; float* dt_ws; float* out; const float* b_f; const float* dt_bias;
    __device__ __forceinline__ void operator()(const pg8::f32x4 (&acc)[2][2][4][2], const pg8::Unit& u, int wr, int wc, int fr, int fq) const {
        const int pn = u.pn;
        if (pn < 24) {
            bf16* base; int ldc, colt;
            if (pn < 8) { base = Z; ldc = DI; colt = pn * 256; } else { base = XBC; ldc = CONVD; colt = (pn - 8) * 256; }
#pragma unroll
            for (int ai = 0; ai < 2; ++ai)
#pragma unroll
                for (int m = 0; m < 4; ++m) { const int row = EPI_ROW(u, ai, m);
#pragma unroll
                    for (int bj = 0; bj < 2; ++bj) *(u32x4*)(base + (size_t)row * ldc + colt + EPI_CB(bj)) = pack8(acc[ai][bj][m][0], acc[ai][bj][m][1]);
                }
        } else if (wc < 2) {
#pragma unroll
            for (int ai = 0; ai < 2; ++ai)
#pragma unroll
                for (int m = 0; m < 4; ++m) { const int row = EPI_ROW(u, ai, m);
#pragma unroll
                    for (int n = 0; n < 2; ++n)
#pragma unroll
                        for (int i = 0; i < 4; ++i) { const int c = 32 * wc + 8 * fq + 4 * n + i; const float v = acc[ai][0][m][n][i];
                            if (c < 16) logf_ws[(size_t)row * 16 + c] = v; else if (c < 48) dt_ws[(size_t)row * 32 + (c - 16)] = v; }
                }
        }
    }
};

struct EpiP3 {
    static constexpr bool PERM = true, AFTER_DRAIN = false;
    bf16* QB; bf16* KB; bf16* VB; bf16* SGA; bf16* SGS; float* out; const float* qw; const float* kw;
    __device__ __forceinline__ void operator()(const pg8::f32x4 (&acc)[2][2][4][2], const pg8::Unit& u, int wr, int wc, int fr, int fq) const {
        const int pn = u.pn;
        if (pn < 8) {
            const bool isk = pn >= 4; const int head = 4 * (pn & 3) + wc; const float* nw = isk ? kw : qw;
            f32x4 wv[2][2];
#pragma unroll
            for (int bj = 0; bj < 2; ++bj)
#pragma unroll
                for (int n = 0; n < 2; ++n) wv[bj][n] = *(const f32x4*)(nw + 32 * bj + 8 * fq + 4 * n);
#pragma unroll
            for (int ai = 0; ai < 2; ++ai)
#pragma unroll
                for (int m = 0; m < 4; ++m) { const int row = EPI_ROW(u, ai, m); float ss = 0.f;
#pragma unroll
                    for (int bj = 0; bj < 2; ++bj)
#pragma unroll
                        for (int n = 0; n < 2; ++n) { const f32x4 x = acc[ai][bj][m][n]; ss += (x[0] * x[0] + x[1] * x[1]) + (x[2] * x[2] + x[3] * x[3]); }
                    ss += __shfl_xor(ss, 16); ss += __shfl_xor(ss, 32);
                    const float rstd = rsqrtf(ss * (1.f / 64.f) + EPS), sc = isk ? rstd : rstd * QSCALE;
                    float* ko = (row < MP) ? out + O_KP + (size_t)row * DM : out + O_KS + (size_t)(row - MP) * DM;
#pragma unroll
                    for (int bj = 0; bj < 2; ++bj) { const f32x4 v0 = acc[ai][bj][m][0] * wv[bj][0] * sc, v1 = acc[ai][bj][m][1] * wv[bj][1] * sc; const int col = head * 64 + 32 * bj + 8 * fq;
                        *(u32x4*)((isk ? KB : QB) + (size_t)row * DM + col) = pack8(v0, v1);
                        if (isk) { *(f32x4*)(ko + col) = v0; *(f32x4*)(ko + col + 4) = v1; } }
                }
        } else if (pn < 12) {
#pragma unroll
            for (int ai = 0; ai < 2; ++ai)
#pragma unroll
                for (int m = 0; m < 4; ++m) { const int row = EPI_ROW(u, ai, m); float* vo = (row < MP) ? out + O_VP + (size_t)row * DM : out + O_VS + (size_t)(row - MP) * DM;
#pragma unroll
                    for (int bj = 0; bj < 2; ++bj) { const int col = (pn - 8) * 256 + EPI_CB(bj); *(u32x4*)(VB + (size_t)row * DM + col) = pack8(acc[ai][bj][m][0], acc[ai][bj][m][1]);
                        *(f32x4*)(vo + col) = acc[ai][bj][m][0]; *(f32x4*)(vo + col + 4) = acc[ai][bj][m][1]; } }
        } else {
            bf16* G = pn < 16 ? SGA : SGS; const int colt = ((pn - 12) & 3) * 256;
#pragma unroll
            for (int ai = 0; ai < 2; ++ai)
#pragma unroll
                for (int m = 0; m < 4; ++m) { const int row = EPI_ROW(u, ai, m);
#pragma unroll
                    for (int bj = 0; bj < 2; ++bj) { f32x4 v0 = acc[ai][bj][m][0], v1 = acc[ai][bj][m][1];
#pragma unroll
                        for (int i = 0; i < 4; ++i) { v0[i] = sigmoidf_(v0[i]); v1[i] = sigmoidf_(v1[i]); }
                        *(u32x4*)(G + (size_t)row * DM + colt + EPI_CB(bj)) = pack8(v0, v1); } }
        }
    }
};

template <int MODE> struct EpiGate {
    static constexpr bool PERM = true, AFTER_DRAIN = false;
    const bf16* G; const bf16* T; bf16* O;
    __device__ __forceinline__ void operator()(const pg8::f32x4 (&acc)[2][2][4][2], const pg8::Unit& u, int wr, int wc, int fr, int fq) const {
#pragma unroll
        for (int ai = 0; ai < 2; ++ai)
#pragma unroll
            for (int m = 0; m < 4; ++m) { const int row = EPI_ROW(u, ai, m);
#pragma unroll
                for (int bj = 0; bj < 2; ++bj) { const size_t off = (size_t)row * DM + u.pn * 256 + EPI_CB(bj); const u32x4 g = *(const u32x4*)(G + off);
                    f32x4 v0 = acc[ai][bj][m][0], v1 = acc[ai][bj][m][1];
                    v0[0] *= bflo(g.x); v0[1] *= bfhi(g.x); v0[2] *= bflo(g.y); v0[3] *= bfhi(g.y); v1[0] *= bflo(g.z); v1[1] *= bfhi(g.z); v1[2] *= bflo(g.w); v1[3] *= bfhi(g.w);
                    if (MODE == 1) { const u32x4 t = *(const u32x4*)(T + off);
                        v0[0] += bflo(t.x); v0[1] += bfhi(t.x); v0[2] += bflo(t.y); v0[3] += bfhi(t.y); v1[0] += bflo(t.z); v1[1] += bfhi(t.z); v1[2] += bflo(t.w); v1[3] += bfhi(t.w); }
                    *(u32x4*)(O + off) = pack8(v0, v1); } }
    }
};

struct EpiRes {
    static constexpr bool PERM = true, AFTER_DRAIN = false;
    const float* xp; const float* xs; float* out; int xin; bf16* xw; const float* nw; float* part;
    __device__ __forceinline__ void operator()(const pg8::f32x4 (&acc)[2][2][4][2], const pg8::Unit& u, int wr, int wc, int fr, int fq) const {
#pragma unroll
        for (int ai = 0; ai < 2; ++ai)
#pragma unroll
            for (int m = 0; m < 4; ++m) { const int row = EPI_ROW(u, ai, m);
                const float* b = xin ? ((row < MP) ? xp + (size_t)row * DM : xs + (size_t)(row - MP) * DM) : out + (size_t)row * DM; float* o = out + (size_t)row * DM; float ss = 0.f;
#pragma unroll
                for (int bj = 0; bj < 2; ++bj) { const int col = u.pn * 256 + EPI_CB(bj); const f32x4 b0 = *(const f32x4*)(b + col), b1 = *(const f32x4*)(b + col + 4);
                    const f32x4 v0 = b0 + acc[ai][bj][m][0], v1 = b1 + acc[ai][bj][m][1];
                    *(f32x4*)(o + col) = v0; *(f32x4*)(o + col + 4) = v1;
                    if (xw) { const f32x4 w0 = *(const f32x4*)(nw + col), w1 = *(const f32x4*)(nw + col + 4); *(u32x4*)(xw + (size_t)row * DM + col) = pack8(v0 * w0, v1 * w1);
                        ss += (v0[0] * v0[0] + v0[1] * v0[1]) + (v0[2] * v0[2] + v0[3] * v0[3]) + (v1[0] * v1[0] + v1[1] * v1[1]) + (v1[2] * v1[2] + v1[3] * v1[3]); } }
                if (xw) { ss += __shfl_xor(ss, 16); ss += __shfl_xor(ss, 32); if (fq == 0) part[(size_t)row * 16 + u.pn * 4 + wc] = ss; } }
    }
};

struct EpiRelu2 {
    static constexpr bool PERM = true, AFTER_DRAIN = false;
    bf16* O; int ldc; const float* part;
    __device__ __forceinline__ void operator()(const pg8::f32x4 (&acc)[2][2][4][2], const pg8::Unit& u, int wr, int wc, int fr, int fq) const {
#pragma unroll
        for (int ai = 0; ai < 2; ++ai)
#pragma unroll
            for (int m = 0; m < 4; ++m) { const int row = EPI_ROW(u, ai, m); const f32x4* pp = (const f32x4*)(part + (size_t)row * 16);
                const f32x4 s4 = (pp[0] + pp[1]) + (pp[2] + pp[3]); const float rstd = rsqrtf(((s4[0] + s4[1]) + (s4[2] + s4[3])) * (1.f / DM) + EPS);
#pragma unroll
                for (int bj = 0; bj < 2; ++bj) { f32x4 v0 = acc[ai][bj][m][0], v1 = acc[ai][bj][m][1];
#pragma unroll
                    for (int i = 0; i < 4; ++i) { const float a0 = fmaxf(v0[i], 0.f) * rstd, a1 = fmaxf(v1[i], 0.f) * rstd; v0[i] = a0 * a0; v1[i] = a1 * a1; }
                    *(u32x4*)(O + (size_t)row * ldc + u.pn * 256 + EPI_CB(bj)) = pack8(v0, v1); } }
    }
};

template <class Epi> __device__ __forceinline__ void run_gemm(LAS unsigned char* lds, const bf16* A, const bf16* Bt, int N, int K, const Epi& E, int M = MT) {
    pg8::Gemm g{A, Bt, M, N, K}; pg8::StaticOrder S; S.init(M, N, (int)gridDim.x, (int)blockIdx.x);
    pg8::gemm_phase<Epi, pg8::StaticOrder, true, true>(lds, g, S, E);
}
template <int MODE, int NCB = 16> __device__ __forceinline__ void mini_gemm(const Args& a, LAS unsigned char* lds, const bf16* A, const bf16* Bt, const int K, const bf16* Gt, const bf16* T, bf16* O, bf16* XW, float* part) {
    const int tid = threadIdx.x, lane = tid & 63, wid = __builtin_amdgcn_readfirstlane(tid >> 6), fr = lane & 15, fq = lane >> 4;
    LAS float* RED = (LAS float*)lds;
    typedef float f32x2v __attribute__((ext_vector_type(2)));
    for (int pc = blockIdx.x; pc < 16 * NCB; pc += gridDim.x) {
        const int row0 = MP + 16 * (pc / NCB), col0 = 64 * (pc % NCB), KS = K >> 8;
        f32x4 acc[4];
#pragma unroll
        for (int ct = 0; ct < 4; ++ct) acc[ct] = (f32x4){0.f, 0.f, 0.f, 0.f};
        const bf16* ap = A + (size_t)(row0 + fr) * K + (size_t)wid * (K >> 3) + 8 * fq;
        const bf16* bp = Bt + (size_t)(col0 + fr) * K + (size_t)wid * (K >> 3) + 8 * fq;
        for (int s0 = 0; s0 < KS; s0 += 4) {
            bf16x8 av[4], bv[4][4];
#pragma unroll
            for (int s = 0; s < 4; ++s) { av[s] = *(const bf16x8*)(ap + (s0 + s) * 32);
#pragma unroll
                for (int ct = 0; ct < 4; ++ct) bv[s][ct] = *(const bf16x8*)(bp + (size_t)(16 * ct) * K + (s0 + s) * 32); }
#pragma unroll
            for (int s = 0; s < 4; ++s)
#pragma unroll
                for (int ct = 0; ct < 4; ++ct) acc[ct] = __builtin_amdgcn_mfma_f32_16x16x32_bf16(bv[s][ct], av[s], acc[ct], 0, 0, 0);
        }
#pragma unroll
        for (int ct = 0; ct < 4; ++ct) *(LAS f32x4*)(RED + (wid * 16 + fr) * 64 + 16 * ct + 4 * fq) = acc[ct];
        __syncthreads();
        const int r = tid >> 5, c2 = (tid & 31) * 2; float v0 = 0.f, v1 = 0.f;
#pragma unroll
        for (int w = 0; w < 8; ++w) { const f32x2v t = *(const LAS f32x2v*)(RED + (w * 16 + r) * 64 + c2); v0 += t.x; v1 += t.y; }
        const int row = row0 + r, col = col0 + c2; const size_t off = (size_t)row * DM + col;
        if (MODE == 0 || MODE == 1) { const unsigned g = *(const unsigned*)(Gt + off); v0 *= bflo(g); v1 *= bfhi(g);
            if (MODE == 1) { const unsigned t = *(const unsigned*)(T + off); v0 += bflo(t); v1 += bfhi(t); }
            *(unsigned*)(O + off) = pk2(v0, v1); }
        if (MODE == 2) { const f32x2v x = *(const f32x2v*)(a.x_sample + (size_t)(row - MP) * DM + col), w = *(const f32x2v*)(a.norm2_w + col); v0 += x.x; v1 += x.y;
            *(f32x2v*)(a.out + off) = (f32x2v){v0, v1}; *(unsigned*)(XW + off) = pk2(v0 * w.x, v1 * w.y);
            float ss = v0 * v0 + v1 * v1;
#pragma unroll
            for (int o = 1; o < 32; o <<= 1) ss += __shfl_xor(ss, o);
            if ((tid & 31) == 0) part[(size_t)row * 16 + (pc & 15)] = ss; }
        if (MODE == 3) { f32x2v y = *(const f32x2v*)(a.out + off); y.x += v0; y.y += v1; *(f32x2v*)(a.out + off) = y; }
        if (MODE == 4) { const f32x4* pp = (const f32x4*)(part + (size_t)row * 16); const f32x4 s4 = (pp[0] + pp[1]) + (pp[2] + pp[3]); const float rstd = rsqrtf(((s4[0] + s4[1]) + (s4[2] + s4[3])) * (1.f / DM) + EPS);
            const float a0 = fmaxf(v0, 0.f) * rstd, a1 = fmaxf(v1, 0.f) * rstd; *(unsigned*)(O + (size_t)row * (64 * NCB) + col) = pk2(a0 * a0, a1 * a1); }
        __syncthreads();
    }
}

__device__ __forceinline__ float logf_at(const Args& a, const float* LOGF, int smp, int b, int t, int h, float bf) {
    if (smp) return t < PAST ? a.cache_logf[((size_t)b * PAST + t) * 16 + h] : -softplusf_(-(LOGF[((size_t)MP + b * TS + (t - PAST)) * 16 + h] + bf));
    return -softplusf_(-(LOGF[((size_t)b * TP + t) * 16 + h] + bf));
}
constexpr size_t WS_BTOT = WS_SEGDEC + 8192;
__device__ __forceinline__ void cumsum_item(const Args& a, LAS unsigned char* lds, int item) {
    const int tid = threadIdx.x, h = tid & 15, j = tid >> 4;
    LAS float* S = (LAS float*)lds;
    const float* LOGF = (const float*)(a.ws + WS_LOGF);
    const int smp = item >= NBP * 16; const int b = smp ? (item - NBP * 16) / 5 : item >> 4, blk = smp ? (item - NBP * 16) % 5 : item & 15;
    const int sl = smp ? 13 : 16, t0 = blk * 32 * sl;
    float* dst = smp ? (float*)(a.ws + WS_CUMS) + (size_t)b * SKV * 16 : (float*)(a.ws + WS_CUMP) + (size_t)b * TP * 16;
    const float bf = a.b_f[h];
    float off = 0.f;
    const int nit = smp ? (t0 >> 5) : 0;
    for (int i0 = 0; i0 < nit; i0 += 8) { float pv[8];
#pragma unroll
        for (int u = 0; u < 8; ++u) pv[u] = (i0 + u < nit) ? logf_at(a, LOGF, smp, b, j + 32 * (i0 + u), h, bf) : 0.f;
#pragma unroll
        for (int u = 0; u < 8; ++u) off += pv[u]; }
    float v[16]; float s = 0.f;
#pragma unroll
    for (int i = 0; i < 16; ++i) { v[i] = (i < sl) ? logf_at(a, LOGF, smp, b, t0 + j * sl + i, h, bf) : 0.f; s += v[i]; }
    S[j * 16 + h] = off; S[512 + j * 16 + h] = s; __syncthreads();
    float run = 0.f;
    for (int k = 0; k < 32; ++k) run += S[k * 16 + h];
    for (int k = 0; k < j; ++k) run += S[512 + k * 16 + h];
#pragma unroll
    for (int i = 0; i < 16; ++i) if (i < sl) { const int t = t0 + j * sl + i; run += v[i]; if (smp) dst[(size_t)t * 16 + h] = run; else dst[((size_t)h * TP) + t] = run;
        if (!smp) a.out[O_LP + ((size_t)b * TP + t) * 16 + h] = v[i]; else if (t >= PAST) a.out[O_LS + ((size_t)b * TS + (t - PAST)) * 16 + h] = v[i]; }
    if (j == 31) ((float*)(a.ws + WS_BTOT))[item * 16 + h] = run;
    __syncthreads();
}
__device__ __forceinline__ void cumsum_fixup(const Args& a, LAS unsigned char* lds) {
    const int tid = threadIdx.x;
    LAS float* OFF = (LAS float*)lds;
    const float* BT = (const float*)(a.ws + WS_BTOT);
    for (int e = tid; e < NBP * 16 * 16; e += 512) { const int blk = (e >> 4) & 15; float o = 0.f;
        for (int k = 0; k < blk; ++k) o += BT[e - 16 * (blk - k)];
        OFF[e] = o; }
    __syncthreads();
    float* CP = (float*)(a.ws + WS_CUMP);
    for (int e = blockIdx.x * 512 + tid; e < NBP * 16 * TP; e += gridDim.x * 512) CP[e] = -(CP[e] + OFF[((((e >> 17) << 4) + ((e >> 9) & 15)) << 4) + ((e >> 13) & 15)]) * LOG2E;
    __syncthreads();
}
__device__ __forceinline__ void phase_gate_norm(const Args& a) {
    const int tid = threadIdx.x, lane = tid & 63, wid = tid >> 6, G = gridDim.x;
    bf16* Z = (bf16*)(a.out + O_Y); const bf16* YR = (const bf16*)(a.ws + WS_BIG);
    for (int m = blockIdx.x * 8 + wid; m < MT; m += G * 8) {
#pragma unroll 2
        for (int gi = 0; gi < 8; ++gi) { const size_t off = (size_t)m * DI + gi * 256 + 4 * lane;
            const u32x2 yr = *(const u32x2*)(YR + off), zz = *(const u32x2*)(Z + off); const f32x4 wv = *(const f32x4*)(a.ssm_norm_w + gi * 256 + 4 * lane);
            float y[4] = {bflo(yr.x), bfhi(yr.x), bflo(yr.y), bfhi(yr.y)}; const float z[4] = {bflo(zz.x), bfhi(zz.x), bflo(zz.y), bfhi(zz.y)};
            float ss = 0.f;
#pragma unroll
            for (int i = 0; i < 4; ++i) { y[i] = y[i] * z[i] * sigmoidf_(z[i]); ss += y[i] * y[i]; }
            const float rstd = rsqrtf(wave_sum(ss) * (1.f / 256.f) + EPS);
            u32x2 o; o.x = pk2(y[0] * rstd * wv.x, y[1] * rstd * wv.y); o.y = pk2(y[2] * rstd * wv.z, y[3] * rstd * wv.w); *(u32x2*)(Z + off) = o; }
    }
}
#ifndef ATT_THRL
#define ATT_THRL 90
#endif
#include <hip/hip_bf16.h>
namespace attn_body {
using bf16=__hip_bfloat16;
using bf16x8=__attribute__((ext_vector_type(8)))short;
using s16x4=__attribute__((ext_vector_type(4)))short;
using f32x16=__attribute__((ext_vector_type(16)))float;
using u32x4=__attribute__((ext_vector_type(4)))unsigned;
constexpr int BATCH=4,NHEAD=16,SEQ=8192,D=64,DM=NHEAD*D;
constexpr int NW=8,QBLK=32,QB=QBLK*NW,KVBLK=64,NQB=SEQ/QB;
constexpr int ATTN_PITCH=DM, ATTN_UNIT_ROWS=QB;
__device__ __forceinline__ int crow(int r,int hi){return (r&3)+8*(r>>2)+4*hi;}
#define SBAR() __builtin_amdgcn_sched_barrier(0)
__device__ __forceinline__ void cmask(f32x16&p0,f32x16&p1,int jb,int qrel,int hi){
  const float NEG=-INFINITY; int kb=64*jb+4*hi;
  #pragma unroll
  for(int r=0;r<16;++r){int kv=kb+(r&3)+8*(r>>2); if(kv>qrel)p0[r]=NEG; if(kv+32>qrel)p1[r]=NEG;}
}

constexpr int NSLOT=3, SLOTB=8192;
constexpr int LDS_K=0, LDS_V=NSLOT*SLOTB, LDS_WS=2*NSLOT*SLOTB, LDS_OST=LDS_WS+NW*64*4, LDS_BYTES=LDS_OST+NW*4096, LDS_BIAS=86016;
constexpr float C2=0.125f*1.4426950408889634f;
__device__ __forceinline__ void glds16(const void*gsrc,unsigned lds_dst){unsigned keep;
  asm volatile("s_mov_b32 %0, m0\n\ts_mov_b32 m0, %2\n\ts_nop 0\n\tglobal_load_lds_dwordx4 %1, off\n\ts_mov_b32 m0, %0":"=&s"(keep):"v"(gsrc),"s"(lds_dst):"memory");}
__device__ __forceinline__ float max3f(float a,float b,float c){float r;asm("v_max3_f32 %0, %1, %2, %3":"=v"(r):"v"(a),"v"(b),"v"(c));return r;}
__device__ __forceinline__ float max2f(float a,float b){float r;asm("v_max_f32_e32 %0, %1, %2":"=v"(r):"v"(a),"v"(b));return r;}
__device__ __forceinline__ float fadd_s(float a,float b){float r;asm("v_add_f32_e32 %0, %1, %2":"=v"(r):"v"(a),"v"(b));return r;}
__device__ __forceinline__ float fsub_s(float a,float b){float r;asm("v_sub_f32_e32 %0, %1, %2":"=v"(r):"v"(a),"v"(b));return r;}
typedef float f32x2_t __attribute__((ext_vector_type(2))); typedef __bf16 bf16x2_t __attribute__((ext_vector_type(2)));
__device__ __forceinline__ unsigned cvtpk_s(float lo,float hi){f32x2_t v={lo,hi};bf16x2_t b=__builtin_convertvector(v,bf16x2_t);return __builtin_bit_cast(unsigned,b);}
#define WAIT_BAR(N) asm volatile("s_waitcnt vmcnt(" #N ") lgkmcnt(0)\n\ts_barrier":::"memory")

__device__ __forceinline__ void qkt(f32x16&p0,f32x16&p1,const char*Kslot,const bf16x8*qr,const f32x16&i0,const f32x16&i1,int r32,int hi){
  const char*kb=Kslot+hi*1024+r32*16;
  #pragma unroll
  for(int d0=0;d0<4;++d0){
    const bf16x8 b0=*reinterpret_cast<const bf16x8*>(kb+d0*2048);
    const bf16x8 b1=*reinterpret_cast<const bf16x8*>(kb+d0*2048+512);
    if(d0==0){p0=__builtin_amdgcn_mfma_f32_32x32x16_bf16(b0,qr[0],i0,0,0,0);p1=__builtin_amdgcn_mfma_f32_32x32x16_bf16(b1,qr[0],i1,0,0,0);}
    else{p0=__builtin_amdgcn_mfma_f32_32x32x16_bf16(b0,qr[d0],p0,0,0,0);p1=__builtin_amdgcn_mfma_f32_32x32x16_bf16(b1,qr[d0],p1,0,0,0);}}
}
typedef __attribute__((address_space(3))) const char* lds_cptr;
typedef short v4i16_t __attribute__((ext_vector_type(4)));
__device__ __forceinline__ void kload8(bf16x8*kf,lds_cptr kp){
  kf[0]=*(const __attribute__((address_space(3))) bf16x8*)(kp);      kf[1]=*(const __attribute__((address_space(3))) bf16x8*)(kp+512);
  kf[2]=*(const __attribute__((address_space(3))) bf16x8*)(kp+2048); kf[3]=*(const __attribute__((address_space(3))) bf16x8*)(kp+2560);
  kf[4]=*(const __attribute__((address_space(3))) bf16x8*)(kp+4096); kf[5]=*(const __attribute__((address_space(3))) bf16x8*)(kp+4608);
  kf[6]=*(const __attribute__((address_space(3))) bf16x8*)(kp+6144); kf[7]=*(const __attribute__((address_space(3))) bf16x8*)(kp+6656);
}
__device__ __forceinline__ void kload2(bf16x8*kf,lds_cptr kp,int j){ kf[2*j]=*(const __attribute__((address_space(3))) bf16x8*)(kp+j*2048); kf[2*j+1]=*(const __attribute__((address_space(3))) bf16x8*)(kp+j*2048+512); }
__device__ __forceinline__ s16x4 vtr(lds_cptr p){ return __builtin_bit_cast(s16x4,__builtin_amdgcn_ds_read_tr16_b64_v4i16((__attribute__((address_space(3))) v4i16_t*)p)); }
__device__ __forceinline__ float rowmax(const f32x16&p0,const f32x16&p1){
  float a=max3f(p0[0],p0[1],p1[0]),b=max3f(p0[2],p0[3],p1[1]);a=max3f(a,p1[2],p1[3]);
  #pragma unroll
  for(int r=4;r<16;r+=4){a=max3f(a,p0[r],p0[r+1]);b=max3f(b,p0[r+2],p0[r+3]);a=max3f(a,p1[r],p1[r+1]);b=max3f(b,p1[r+2],p1[r+3]);}
  const float m=max2f(a,b);
  auto rr=__builtin_amdgcn_permlane32_swap(__float_as_uint(m),__float_as_uint(m),false,false);
  return max2f(__uint_as_float(rr[0]),__uint_as_float(rr[1]));
}
__device__ __forceinline__ void pv(f32x16*o,int vb,bf16x8 pa0,bf16x8 pa1,bf16x8 pa2,bf16x8 pa3){
  #pragma unroll
  for(int d0=0;d0<2;++d0){s16x4 lo[4],hi[4];
    #pragma unroll
    for(int ks=0;ks<4;++ks){
      asm volatile("ds_read_b64_tr_b16 %0,%1 offset:%c2":"=&v"(lo[ks]):"v"(vb),"i"(d0*4096+ks*1024):"memory");
      asm volatile("ds_read_b64_tr_b16 %0,%1 offset:%c2":"=&v"(hi[ks]):"v"(vb),"i"(d0*4096+ks*1024+512):"memory");}
    asm volatile("s_waitcnt lgkmcnt(0)":::"memory");SBAR();
    #define PK(k) (bf16x8){lo[k][0],lo[k][1],lo[k][2],lo[k][3],hi[k][0],hi[k][1],hi[k][2],hi[k][3]}
    o[d0]=__builtin_amdgcn_mfma_f32_32x32x16_bf16(pa0,PK(0),o[d0],0,0,0);
    o[d0]=__builtin_amdgcn_mfma_f32_32x32x16_bf16(pa1,PK(1),o[d0],0,0,0);
    o[d0]=__builtin_amdgcn_mfma_f32_32x32x16_bf16(pa2,PK(2),o[d0],0,0,0);
    o[d0]=__builtin_amdgcn_mfma_f32_32x32x16_bf16(pa3,PK(3),o[d0],0,0,0);
    #undef PK
  }
}

#ifndef ATTN_STORE16
#define ATTN_STORE16(p,v) (*(u32x4*)(p)=(v))
#endif
template<int THRL> __device__ __forceinline__ void attn_unit(int b,int h,int qb,const bf16*Q,const bf16*__restrict__ K,const bf16*__restrict__ V,bf16*O,const float*__restrict__ BL2,char*shm){
  const int tid=threadIdx.x,lane=tid&63,r32=lane&31,hi=lane>>5; const int wid=__builtin_amdgcn_readfirstlane(tid>>6);
  const long rowbase=(long)b*SEQ; const int q0=qb*QB;
  const bf16*Qw=Q+(rowbase+q0+wid*QBLK)*DM+h*D;
  const bf16*Kh=K+rowbase*DM+h*D,*Vh=V+rowbase*DM+h*D;
  const unsigned lds0=(unsigned)(uintptr_t)shm;
  float*wsf=(float*)(shm+LDS_WS)+wid*64;
  const bf16*ksrc=Kh+(long)lane*DM+wid*8;
  const bf16*vsrc=Vh+(long)(16*(wid&3)+(lane>>2))*DM+(wid>>2)*32+(lane&3)*8;
  const unsigned kdst=lds0+LDS_K+wid*1024, vdst=lds0+LDS_V+wid*1024;
  #define DMA_K(t,slot) glds16(ksrc+(long)(t)*KVBLK*DM,(unsigned)__builtin_amdgcn_readfirstlane(kdst+(slot)))
  #define DMA_V(t,slot) glds16(vsrc+(long)(t)*KVBLK*DM,(unsigned)__builtin_amdgcn_readfirstlane(vdst+(slot)))
  const int vb0=(int)(lds0+LDS_V)+((lane>>4)&1)*32+(lane&3)*8+(4*hi+((lane&15)>>2))*64;
  const char*Kbase=shm+LDS_K; bf16x8 kf[8];
  const lds_cptr shm3=(lds_cptr)shm; const lds_cptr kp0=shm3+LDS_K+hi*1024+r32*16; const lds_cptr vp0=shm3+LDS_V+((lane>>4)&1)*32+(lane&3)*8+(4*hi+((lane&15)>>2))*64;
  const int NT=(q0+QB)/KVBLK;
  const float*blh=(const float*)(shm+LDS_BIAS)+4*hi;
  #define BINIT1(C,t,o) do{ const float*bp_=blh+64*(t)+(o); \
    _Pragma("unroll") for(int g_=0;g_<4;++g_){ typedef float f32x4_t __attribute__((ext_vector_type(4))); const f32x4_t b0_=*(const f32x4_t*)(bp_+8*g_); \
      _Pragma("unroll") for(int i_=0;i_<4;++i_){ C[4*g_+i_]=b0_[i_]-mhat; } } }while(0)
  #define BINIT(C0,C1,t) do{ BINIT1(C0,t,0); BINIT1(C1,t,32); }while(0)
  #define BG(G,C,t,o,g_) do{ if(G){ typedef float f32x4_t __attribute__((ext_vector_type(4))); const f32x4_t b0_=*(const f32x4_t*)(blh+64*(t)+(o)+8*(g_)); \
      const f32x2_t m2_={mhat,mhat}; const f32x2_t lo_=(f32x2_t){b0_[0],b0_[1]}-m2_, hi_=(f32x2_t){b0_[2],b0_[3]}-m2_; \
      C[4*(g_)]=lo_[0]; C[4*(g_)+1]=lo_[1]; C[4*(g_)+2]=hi_[0]; C[4*(g_)+3]=hi_[1]; SBAR(); } }while(0)
  DMA_K(0,0);DMA_V(0,0);DMA_K(1,SLOTB);
  { typedef float f32x4_t __attribute__((ext_vector_type(4))); float*bl=(float*)(shm+LDS_BIAS); const int nch=(q0+QB)/4;
    for(int c=tid;c<nch;c+=NW*64){ const f32x4_t v=*(const f32x4_t*)(BL2+4*c); *(f32x4_t*)(bl+4*c)=v; }
    asm volatile("s_waitcnt vmcnt(0)":::"memory"); }
  bf16x8 qr[4];
  #pragma unroll
  for(int d0=0;d0<4;++d0)qr[d0]=*reinterpret_cast<const bf16x8*>(&Qw[(long)r32*DM+d0*16+hi*8]);
  float mhat=0.f,l_reg=0.f;f32x16 o[2];o[0]=f32x16{};o[1]=f32x16{};
  const int qrel=wid*QBLK+r32;
  #define CMASK(P0,P1,t) do{int jb_=(t)-(NT-4); if(jb_>=0)cmask(P0,P1,jb_,qrel,hi);}while(0)
  bool resc=false;
  #define START(P0,P1) do{ const float rm=rowmax(P0,P1); resc=false; \
    { const float dl=rm; mhat=fadd_s(mhat,dl); \
      _Pragma("unroll") for(int r=0;r<16;++r){P0[r]=fsub_s(P0[r],dl);P1[r]=fsub_s(P1[r],dl);} } \
    _Pragma("unroll") for(int r=0;r<16;++r)P0[r]=__builtin_amdgcn_exp2f(P0[r]); }while(0)
  #define RESC() do{ if(resc){ asm volatile("s_waitcnt lgkmcnt(0)":::"memory"); \
      _Pragma("unroll") for(int d_=0;d_<2;++d_) _Pragma("unroll") for(int r=0;r<16;++r)o[d_][r]*=wsf[crow(r,hi)]; } }while(0)
  f32x16 pA0,pA1,pB0,pB1;
  int sl_prev=0,sl_cur=0,sl_next=SLOTB;
  #define ROT() do{sl_prev=sl_cur;sl_cur=sl_next;sl_next=(sl_next==(NSLOT-1)*SLOTB)?0:sl_next+SLOTB;}while(0)
  DMA_K(2,2*SLOTB);
  WAIT_BAR(3);
  { f32x16 i0_,i1_; BINIT(i0_,i1_,0); qkt(pA0,pA1,Kbase,qr,i0_,i1_,r32,hi); } asm volatile("s_nop 15\n\ts_nop 7":"+v"(pA0),"+v"(pA1));CMASK(pA0,pA1,0);
  START(pA0,pA1);
  _Pragma("unroll") for(int r=0;r<16;++r)pA1[r]=__builtin_amdgcn_exp2f(pA1[r]);
  WAIT_BAR(0);
  DMA_K(3,0);DMA_V(1,SLOTB);
  ROT();
  kload8(kf,kp0+sl_cur);
  WAIT_BAR(2);
  s16x4 vlo[8],vhi[8]; u32x4 pw0,pw1,pw2,pw3;
  #define PKW(P,B) cvtpk_s(P[B],P[B+1])
  #define PAF(k) __builtin_bit_cast(bf16x8,pw##k)
  #define VFR(i) (bf16x8){vlo[i][0],vlo[i][1],vlo[i][2],vlo[i][3],vhi[i][0],vhi[i][1],vhi[i][2],vhi[i][3]}
  #define PIN(x) asm volatile("":"+v"(x))
  #define MX3(a,b,c) __builtin_fmaxf(__builtin_fmaxf((a),(b)),(c))
  #define GAPA(MF,A0,A1,A2,A3,W0,W1,PW) do{ MF; sacc+=A0; sacc+=A1; sacc+=A2; sacc+=A3; PIN(sacc); W0; W1; PIN(PW); SBAR(); }while(0)
  #define EX(v) __builtin_amdgcn_exp2f(v)
  #define GAPB(MF,X,B) do{ MF; X[B]=EX(X[B]); X[B+1]=EX(X[B+1]); X[B+2]=EX(X[B+2]); X[B+3]=EX(X[B+3]); PIN(X); SBAR(); }while(0)
  #define VRD(i) do{ vlo[i]=vtr(vp_+(((i)>>2)*4096+((i)&3)*1024)); vhi[i]=vtr(vp_+(((i)>>2)*4096+((i)&3)*1024+512)); }while(0)
  #define KRD(G,j) do{ if(G){ kload2(kf,kp0+sl_next,j); SBAR(); } }while(0)
  #define STEP(C0,C1,P0,P1,t,GK,GV,GL) do{ SBAR(); \
    const lds_cptr vp_=vp0+sl_prev; \
    VRD(0); SBAR(); float sacc=(P0[0]+P0[1]); \
    GAPA(C0=__builtin_amdgcn_mfma_f32_32x32x16_bf16(kf[0],qr[0],C0,0,0,0), P0[2],P0[3],P0[4],P0[5],     pw0[0]=PKW(P0,0), pw0[1]=PKW(P0,2), pw0); \
    VRD(4); SBAR(); GAPA(C1=__builtin_amdgcn_mfma_f32_32x32x16_bf16(kf[1],qr[0],C1,0,0,0), P0[6],P0[7],P0[8],P0[9],     pw0[2]=PKW(P0,4), pw0[3]=PKW(P0,6), pw0); \
    VRD(1); SBAR(); GAPA(C0=__builtin_amdgcn_mfma_f32_32x32x16_bf16(kf[2],qr[1],C0,0,0,0),   P0[10],P0[11],P0[12],P0[13], pw1[0]=PKW(P0,8), pw1[1]=PKW(P0,10), pw1); \
    VRD(5); SBAR(); GAPA(C1=__builtin_amdgcn_mfma_f32_32x32x16_bf16(kf[3],qr[1],C1,0,0,0),   P0[14],P0[15],P1[0],P1[1],   pw1[2]=PKW(P0,12),pw1[3]=PKW(P0,14), pw1); \
    VRD(2); SBAR(); GAPA(C0=__builtin_amdgcn_mfma_f32_32x32x16_bf16(kf[4],qr[2],C0,0,0,0),   P1[2],P1[3],P1[4],P1[5],     pw2[0]=PKW(P1,0), pw2[1]=PKW(P1,2), pw2); \
    VRD(6); SBAR(); GAPA(C1=__builtin_amdgcn_mfma_f32_32x32x16_bf16(kf[5],qr[2],C1,0,0,0),   P1[6],P1[7],P1[8],P1[9],     pw2[2]=PKW(P1,4), pw2[3]=PKW(P1,6), pw2); \
    VRD(3); SBAR(); GAPA(C0=__builtin_amdgcn_mfma_f32_32x32x16_bf16(kf[6],qr[3],C0,0,0,0),   P1[10],P1[11],P1[12],P1[13], pw3[0]=PKW(P1,8), pw3[1]=PKW(P1,10), pw3); \
    VRD(7); SBAR(); GAPA(C1=__builtin_amdgcn_mfma_f32_32x32x16_bf16(kf[7],qr[3],C1,0,0,0),   P1[14],P1[15],0.f,0.f,       pw3[2]=PKW(P1,12),pw3[3]=PKW(P1,14), pw3); \
    l_reg+=sacc; \
    if(GK){DMA_K((t)+3,sl_cur);} if(GV){DMA_V((t)+1,sl_next);} \
    CMASK(C0,C1,t); \
    { float a=MX3(C0[0],C0[1],C1[0]),b=MX3(C0[2],C0[3],C1[1]); a=MX3(a,C1[2],C1[3]); \
      _Pragma("unroll") for(int r=4;r<16;r+=4){a=MX3(a,C0[r],C0[r+1]);b=MX3(b,C0[r+2],C0[r+3]);a=MX3(a,C1[r],C1[r+1]);b=MX3(b,C1[r+2],C1[r+3]);} \
      float rm=__builtin_fmaxf(a,b); { auto rr=__builtin_amdgcn_permlane32_swap(__float_as_uint(rm),__float_as_uint(rm),false,false); rm=__builtin_fmaxf(__uint_as_float(rr[0]),__uint_as_float(rr[1])); } \
      resc=false; \
      if(__builtin_expect(__any(rm>(float)THRL),0)){ const float dl=__builtin_fmaxf(rm,0.f); mhat+=dl; \
        _Pragma("unroll") for(int r=0;r<16;++r){C0[r]-=dl;C1[r]-=dl;} \
        const float f=__builtin_amdgcn_exp2f(-dl); l_reg*=f; if(hi==0)wsf[r32]=f; resc=true; } } \
    SBAR(); \
    GAPB(o[0]=__builtin_amdgcn_mfma_f32_32x32x16_bf16(PAF(0),VFR(0),o[0],0,0,0), C0,0); BG(GL,P0,(t)+1,0,0); \
    GAPB(o[1]=__builtin_amdgcn_mfma_f32_32x32x16_bf16(PAF(0),VFR(4),o[1],0,0,0), C0,4); BG(GL,P0,(t)+1,0,1); \
    KRD(GL,0); GAPB(o[0]=__builtin_amdgcn_mfma_f32_32x32x16_bf16(PAF(1),VFR(1),o[0],0,0,0), C0,8); BG(GL,P0,(t)+1,0,2); \
    KRD(GL,1); GAPB(o[1]=__builtin_amdgcn_mfma_f32_32x32x16_bf16(PAF(1),VFR(5),o[1],0,0,0), C0,12); BG(GL,P0,(t)+1,0,3); \
    KRD(GL,2); GAPB(o[0]=__builtin_amdgcn_mfma_f32_32x32x16_bf16(PAF(2),VFR(2),o[0],0,0,0), C1,0); BG(GL,P1,(t)+1,32,0); \
    KRD(GL,3); GAPB(o[1]=__builtin_amdgcn_mfma_f32_32x32x16_bf16(PAF(2),VFR(6),o[1],0,0,0), C1,4); BG(GL,P1,(t)+1,32,1); \
    GAPB(o[0]=__builtin_amdgcn_mfma_f32_32x32x16_bf16(PAF(3),VFR(3),o[0],0,0,0), C1,8); BG(GL,P1,(t)+1,32,2); \
    GAPB(o[1]=__builtin_amdgcn_mfma_f32_32x32x16_bf16(PAF(3),VFR(7),o[1],0,0,0), C1,12); BG(GL,P1,(t)+1,32,3); \
    }while(0)
  int t=1;
  BINIT(pB0,pB1,1);
  #undef CMASK
  #define CMASK(P0,P1,t) do{}while(0)
  for(;t+5<NT;t+=2){
    STEP(pB0,pB1,pA0,pA1,t,true,true,true);     WAIT_BAR(2); RESC(); ROT();
    STEP(pA0,pA1,pB0,pB1,t+1,true,true,true);   WAIT_BAR(2); RESC(); ROT();
  }
  #undef CMASK
  #define CMASK(P0,P1,t) do{int jb_=(t)-(NT-4); if(jb_>=0)cmask(P0,P1,jb_,qrel,hi);}while(0)
  #define ENDW(tt) do{ if((tt)+3<NT){WAIT_BAR(2);} else if((tt)+2<NT){WAIT_BAR(1);} else {WAIT_BAR(0);} }while(0)
  for(;t+1<NT;t+=2){
    STEP(pB0,pB1,pA0,pA1,t,(t+3<NT),(t+1<NT),(t+1<NT));       ENDW(t);   RESC(); ROT();
    STEP(pA0,pA1,pB0,pB1,t+1,(t+4<NT),(t+2<NT),(t+2<NT));     ENDW(t+1); RESC(); ROT();
  }
  STEP(pB0,pB1,pA0,pA1,NT-1,false,false,false); RESC();
  { float sacc=pB0[0]+pB0[1]; _Pragma("unroll") for(int r=2;r<16;++r)sacc+=pB0[r]; _Pragma("unroll") for(int r=0;r<16;++r)sacc+=pB1[r]; l_reg+=sacc;
    pw0=(u32x4){PKW(pB0,0),PKW(pB0,2),PKW(pB0,4),PKW(pB0,6)};pw1=(u32x4){PKW(pB0,8),PKW(pB0,10),PKW(pB0,12),PKW(pB0,14)};pw2=(u32x4){PKW(pB1,0),PKW(pB1,2),PKW(pB1,4),PKW(pB1,6)};pw3=(u32x4){PKW(pB1,8),PKW(pB1,10),PKW(pB1,12),PKW(pB1,14)};
    SBAR(); pv(o,vb0+sl_cur,PAF(0),PAF(1),PAF(2),PAF(3)); }
  #undef PKW
  #undef PAF
  #undef VFR
  #undef PIN
  #undef MX3
  #undef GAPA
  #undef GAPB
  #undef EX
  #undef VRD
  #undef KRD
  #undef STEP
  #undef ENDW
  {auto rr=__builtin_amdgcn_permlane32_swap(__float_as_uint(l_reg),__float_as_uint(l_reg),false,false);l_reg=__uint_as_float(rr[0])+__uint_as_float(rr[1]);}
  if(hi==0)wsf[32+r32]=l_reg;asm volatile("s_waitcnt lgkmcnt(0)":::"memory");
  float rli[16];
  #pragma unroll
  for(int r=0;r<16;++r)rli[r]=__builtin_amdgcn_rcpf(wsf[32+crow(r,hi)]);
  bf16*Ow=O+(rowbase+q0+wid*QBLK)*DM+h*D;
  { bf16*stg=(bf16*)(shm+LDS_OST)+wid*2048;
    #pragma unroll
    for(int r=0;r<16;++r){const int orow=crow(r,hi);
      #pragma unroll
      for(int d0=0;d0<2;++d0)stg[orow*64+d0*32+r32]=__float2bfloat16(o[d0][r]*rli[r]);}
    asm volatile("s_waitcnt lgkmcnt(0)":::"memory");
    #pragma unroll
    for(int i=0;i<4;++i){const int row=i*8+(lane>>3),ch=lane&7; const u32x4 v=*(const u32x4*)(stg+row*64+ch*8); ATTN_STORE16(Ow+(long)row*DM+ch*8,v);} }
  asm volatile("s_waitcnt lgkmcnt(0)\n\ts_barrier":::"memory");
  #undef BINIT
  #undef BINIT1
  #undef BG
  #undef DMA_K
  #undef DMA_V
  #undef CMASK
  #undef START
  #undef RESC
  #undef ROT
}
constexpr int ATTN_LDS_BYTES=LDS_BYTES;
struct AttnTensors { const bf16* Q; const bf16* K; const bf16* V; bf16* O; const float* BL2; };
struct AttnUnit { int bh; int qb; };
struct StaticOrder {
  int vcu;
  __device__ __forceinline__ explicit StaticOrder(int grid,int block):vcu((block%8)*(grid/8)+block/8){}
  __device__ __forceinline__ bool next(int i,AttnUnit&u)const{ if(i>=8)return false; const int s=vcu&7,j=i&3; u.bh=(vcu>>3)+32*(i>>2); u.qb=(j==0)?31-s:(j==1)?16+s:(j==2)?15-s:s; return true; }
  __device__ __forceinline__ void a_ready(const AttnUnit&)const{}
  __device__ __forceinline__ void done(const AttnUnit&)const{}
};
template<class Sched,int THRL=ATT_THRL> __device__ __forceinline__ void attn_phase(char*lds,const AttnTensors&T,const Sched&S){
  AttnUnit u;
  for(int i=0;S.next(i,u);++i){ S.a_ready(u); attn_unit<THRL>(u.bh/NHEAD,u.bh%NHEAD,u.qb,T.Q,T.K,T.V,T.O,T.BL2+(long)u.bh*SEQ,lds); S.done(u); }
}
#undef SBAR
#undef WAIT_BAR
}

#define XB_TMO      128
#define XB_XCNT(j)  (256  + 64 * (j))
#define XB_XSUB(j)  (1280 + 64 * (j))
#define XB_XGEN(j)  (2304 + 64 * (j))
#define XB_TOP      3328
#define XB_TOPGEN   3392
#define XCD_BAR_WORDS 3456
#define XB_SPIN_CAP (1u << 18)

__device__ __forceinline__ unsigned xb_ld(unsigned* p)              { return __hip_atomic_load(p, __ATOMIC_RELAXED, __HIP_MEMORY_SCOPE_AGENT); }
__device__ __forceinline__ unsigned xb_add(unsigned* p, unsigned v) { return __hip_atomic_fetch_add(p, v, __ATOMIC_RELAXED, __HIP_MEMORY_SCOPE_AGENT); }
__device__ __forceinline__ unsigned xb_xcc_id() { return (unsigned)__builtin_amdgcn_s_getreg((3 << 11) | 20) & 0xFu; }
#define XB_SPIN(cond, bar) do { unsigned _sp = 0; while (cond) { __builtin_amdgcn_s_sleep(1); \
    if ((++_sp & 255u) == 0u) { if (xb_ld(&(bar)[XB_TMO])) break; if (_sp > XB_SPIN_CAP) { atomicAdd(&(bar)[XB_TMO], 1u); break; } } } } while (0)

struct XcdBarrier {
    unsigned* bar; unsigned x;
    volatile LAS unsigned* st;
};

__device__ __forceinline__ XcdBarrier xcd_barrier_post(unsigned* bar, volatile LAS unsigned* st) {
    XcdBarrier b; b.bar = bar; b.x = xb_xcc_id(); b.st = st;
    if (threadIdx.x == 0) (void)xb_add(&bar[XB_XCNT(b.x)], 1u);
    return b;
}
__device__ __forceinline__ void xcd_barrier_complete(unsigned* bar, unsigned x, unsigned& nloc, unsigned& nx) {
    const unsigned G = gridDim.x * gridDim.y * gridDim.z;
    unsigned sum, cnt, mine, sp = 0u;
    for (;;) {
        sum = 0u; cnt = 0u; mine = 0u;
#pragma unroll
        for (unsigned j = 0; j < 16; ++j) { const unsigned c = xb_ld(&bar[XB_XCNT(j)]); sum += c; cnt += (c > 0u) ? 1u : 0u; mine = (j == x) ? c : mine; }
        if (sum == G) break;
        __builtin_amdgcn_s_sleep(1);
        if ((++sp & 255u) == 0u) { if (xb_ld(&bar[XB_TMO])) break; if (sp > XB_SPIN_CAP) { atomicAdd(&bar[XB_TMO], 1u); break; } }
    }
    nloc = mine > 0u ? mine : 1u; nx = cnt > 0u ? cnt : 1u;
}

__device__ __forceinline__ void xcd_barrier(const XcdBarrier& b) {
    asm volatile("s_waitcnt vmcnt(0)" ::: "memory");
    __syncthreads();
    if (threadIdx.x == 0) {
        unsigned* bar = b.bar;
        __builtin_amdgcn_s_waitcnt(0);
        unsigned nloc = b.st[0], nx = b.st[1];
        if (nloc == 0u) { xcd_barrier_complete(bar, b.x, nloc, nx); b.st[0] = nloc; b.st[1] = nx; }
        const unsigned old = xb_add(&bar[XB_XSUB(b.x)], 1u);
        const unsigned gen = old / nloc;
        if (old + 1u == (gen + 1u) * nloc) {
            __builtin_amdgcn_fence(__ATOMIC_RELEASE, "agent");
            asm volatile("s_waitcnt vmcnt(0)" ::: "memory");
            const unsigned og = xb_add(&bar[XB_TOP], 1u);
            const unsigned tg = og / nx;
            if (og + 1u == (tg + 1u) * nx) xb_add(&bar[XB_TOPGEN], 1u);
            else XB_SPIN(xb_ld(&bar[XB_TOPGEN]) == tg, bar);
            __builtin_amdgcn_fence(__ATOMIC_ACQUIRE, "agent");
            xb_add(&bar[XB_XGEN(b.x)], 1u);
            asm volatile("s_waitcnt vmcnt(0)" ::: "memory");
        } else {
            XB_SPIN(xb_ld(&bar[XB_XGEN(b.x)]) == gen, bar);
            __builtin_amdgcn_fence(__ATOMIC_ACQUIRE, "agent");
            asm volatile("s_waitcnt vmcnt(0)" ::: "memory");
        }
    }
    __syncthreads();
}


#ifndef MK_UNROLL
#define MK_UNROLL 1
#endif
#ifndef DIS
#define DIS 0
#endif
#ifndef SSD_LT_UNROLL
#define SSD_LT_UNROLL 4
#endif
#define MFMA16(A, B, C) __builtin_amdgcn_mfma_f32_16x16x32_bf16((A), (B), (C), 0, 0, 0)
#define MFMA32(A, B, C) __builtin_amdgcn_mfma_f32_32x32x16_bf16((A), (B), (C), 0, 0, 0)
__device__ __forceinline__ bf16* bcc_row(const Args& a, size_t m) { return m < (size_t)MP ? (bf16*)(a.out + O_KP) + m * 2048 : (bf16*)(a.out + O_VP) + (m - MP) * 2048; }
__device__ __forceinline__ float* segst_ptr(const Args& a) { return a.out + O_VP + (1u << 20); }

__device__ __forceinline__ void conv8x8(const u32x4 (&xr)[11], const float (&cw)[4][8], const float (&cbias)[8], int nvalid, u32x4 (&orow)[8], u32x4 (&otr)[8]) {
#pragma unroll
    for (int j2 = 0; j2 < 4; ++j2) { float xl[11], xh[11];
#pragma unroll
        for (int i = 0; i < 11; ++i) { xl[i] = bflo(xr[i][j2]); xh[i] = bfhi(xr[i][j2]); }
        float ol[8], oh[8];
#pragma unroll
        for (int tt = 0; tt < 8; ++tt) { float v0 = cbias[2 * j2] + cw[0][2 * j2] * xl[tt] + cw[1][2 * j2] * xl[tt + 1] + cw[2][2 * j2] * xl[tt + 2] + cw[3][2 * j2] * xl[tt + 3];
            float v1 = cbias[2 * j2 + 1] + cw[0][2 * j2 + 1] * xh[tt] + cw[1][2 * j2 + 1] * xh[tt + 1] + cw[2][2 * j2 + 1] * xh[tt + 2] + cw[3][2 * j2 + 1] * xh[tt + 3];
            v0 = v0 * sigmoidf_(v0); v1 = v1 * sigmoidf_(v1); if (tt >= nvalid) { v0 = 0.f; v1 = 0.f; } ol[tt] = v0; oh[tt] = v1; orow[tt][j2] = pk2(v0, v1); }
#pragma unroll
        for (int t2 = 0; t2 < 4; ++t2) { otr[2 * j2][t2] = pk2(ol[2 * t2], ol[2 * t2 + 1]); otr[2 * j2 + 1][t2] = pk2(oh[2 * t2], oh[2 * t2 + 1]); } }
}
__device__ __forceinline__ u32x4 xbc_row8(const Args& a, const bf16* XBC, size_t seqbase, int smp, int b, int ts, int cc) {
    if (ts >= 0 && (!smp || ts < TS)) return *(const u32x4*)(XBC + (seqbase + ts) * CONVD + cc);
    if (smp && ts < 0) { const float* sp = a.state_conv + ((size_t)b * 3 + (ts + 3)) * CONVD + cc; return pack8(*(const f32x4*)sp, *(const f32x4*)(sp + 4)); }
    return (u32x4){0u, 0u, 0u, 0u};
}
__device__ __forceinline__ void phase_bc_conv(const Args& a) {
    const int tid = threadIdx.x, G = gridDim.x, cc = 8 * tid;
    const bf16* XBC = (const bf16*)(a.ws + WS_BIG); bf16* XC = (bf16*)(a.ws + WS_SG);
    float cw[4][8], cbias[8];
#pragma unroll
    for (int i = 0; i < 4; ++i)
#pragma unroll
        for (int j = 0; j < 8; ++j) cw[i][j] = a.conv_w[(size_t)i * CONVD + cc + j];
#pragma unroll
    for (int j = 0; j < 8; ++j) cbias[j] = a.conv_b[cc + j];
    const int nP = MP / 8, nS = MS / 8;
    const bool contig = (nP % G) == 0; const int per = contig ? nP / G : (nP - (int)blockIdx.x + G - 1) / G, nsm = ((int)blockIdx.x < nS) ? 1 : 0, nst = per + nsm;
#define BCC_IT(j) ((j) < per ? (contig ? (int)blockIdx.x * per + (j) : (int)blockIdx.x + (j) * G) : nP + (int)blockIdx.x)
    u32x4 xn[11];
#define BCC_LD(itv, lo) do { const int smp_ = (itv) >= nP, to_ = smp_ ? (itv) - nP : (itv); const int b_ = smp_ ? to_ / (TS / 8) : to_ / (TP / 8), t0_ = smp_ ? (to_ % (TS / 8)) * 8 : (to_ % (TP / 8)) * 8; \
        const size_t sb_ = smp_ ? (size_t)MP + (size_t)b_ * TS : (size_t)b_ * TP; _Pragma("unroll") for (int i_ = 0; i_ < 11; ++i_) if (i_ >= (lo)) xn[i_] = xbc_row8(a, XBC, sb_, smp_, b_, t0_ - 3 + i_, cc); } while (0)
    if (nst > 0) BCC_LD(BCC_IT(0), 0);
    for (int j = 0; j < nst; ++j) {
        const int it = BCC_IT(j);
        const int smp = it >= nP; const int to = smp ? it - nP : it;
        const int b = smp ? to / (TS / 8) : to / (TP / 8), t0 = smp ? (to % (TS / 8)) * 8 : (to % (TP / 8)) * 8;
        const size_t seqbase = smp ? (size_t)MP + (size_t)b * TS : (size_t)b * TP;
        u32x4 xr[11];
#pragma unroll
        for (int i = 0; i < 11; ++i) xr[i] = xn[i];
        if (j + 1 < nst) { const int itn = BCC_IT(j + 1);
            if (contig && itn == it + 1 && (itn % (TP / 8)) != 0) { xn[0] = xr[8]; xn[1] = xr[9]; xn[2] = xr[10]; BCC_LD(itn, 3); } else BCC_LD(itn, 0); }
        u32x4 orow[8], otr[8]; conv8x8(xr, cw, cbias, 8, orow, otr);
        if (tid < 256) {
#pragma unroll
            for (int tt = 0; tt < 8; ++tt) *(u32x4*)(XC + (seqbase + t0 + tt) * 2048 + cc) = orow[tt];
        } else {
#pragma unroll
            for (int tt = 0; tt < 8; ++tt) *(u32x4*)(bcc_row(a, seqbase + t0 + tt) + (cc - 2048)) = orow[tt];
        }
        const int tl = smp ? TS : TP;
        if (t0 + 8 == tl) { float* cs = smp ? a.out + O_CS + (size_t)b * 3 * CONVD : a.out + O_CP + (size_t)b * 3 * CONVD;
#pragma unroll
            for (int i = 0; i < 3; ++i) { const u32x4 w = xr[8 + i]; float* o = cs + (size_t)i * CONVD + cc;
                *(f32x4*)o = (f32x4){bflo(w.x), bfhi(w.x), bflo(w.y), bfhi(w.y)}; *(f32x4*)(o + 4) = (f32x4){bflo(w.z), bfhi(w.z), bflo(w.w), bfhi(w.w)}; } }
    }
#undef BCC_LD
#undef BCC_IT
}

constexpr int SSD_CS = 0, SSD_BS = 17408, SSD_BT = 34816, SSD_XT = 53248, SSD_MM = 90112, SSD_FA = 126976;
__device__ __forceinline__ void ssd_item(const Args& a, LAS unsigned char* lds, const int mode, const int smp, const int b, const int seg, const int g) {
    const int tid = threadIdx.x, lane = tid & 63, wid = __builtin_amdgcn_readfirstlane(tid >> 6), fr = lane & 15, fq = lane >> 4, hh = wid >> 1, ph = wid & 1, head = 4 * g + hh;
    LAS bf16* Cs = (LAS bf16*)(lds + SSD_CS); LAS bf16* Bs = (LAS bf16*)(lds + SSD_BS); LAS bf16* BT = (LAS bf16*)(lds + SSD_BT);
    LAS bf16* XTh = (LAS bf16*)(lds + SSD_XT) + hh * 4608; LAS bf16* MMh = (LAS bf16*)(lds + SSD_MM) + hh * 4608;
    LAS float* FAh = (LAS float*)(lds + SSD_FA) + hh * 256;
    const size_t seqbase = smp ? (size_t)MP + (size_t)b * TS : (size_t)b * TP;
    const int tseg = smp ? 0 : seg * 1024, nch = smp ? 1 : 16;
    const float Dh = a.D_skip[head];
    const bf16* XBC = (const bf16*)(a.ws + WS_BIG);
    const float* DTW = (const float*)(a.ws + WS_DT);
    float* SEGST = segst_ptr(a); float* SEGDEC = (float*)(a.ws + WS_SEGDEC);
    f32x4 st[8][2];
    if (mode == 1 && smp) { const float* h0 = a.state_ssm + ((size_t)b * NHS + head) * 8192;
#pragma unroll
        for (int nt = 0; nt < 8; ++nt)
#pragma unroll
            for (int pt2 = 0; pt2 < 2; ++pt2) st[nt][pt2] = *(const f32x4*)(h0 + (32 * ph + 16 * pt2 + fr) * 128 + 16 * nt + 4 * fq);
    } else if (mode == 1) {
#pragma unroll
        for (int nt = 0; nt < 8; ++nt)
#pragma unroll
            for (int pt2 = 0; pt2 < 2; ++pt2) st[nt][pt2] = (f32x4){0.f, 0.f, 0.f, 0.f};
#pragma unroll 1
        for (int s = 0; s < seg; ++s) { const float* h0 = SEGST + (((size_t)b * 8 + s) * NHS + head) * 8192; const float dec = SEGDEC[(b * 8 + s) * NHS + head];
#pragma unroll
            for (int nt = 0; nt < 8; ++nt)
#pragma unroll
                for (int pt2 = 0; pt2 < 2; ++pt2) st[nt][pt2] = st[nt][pt2] * dec + *(const f32x4*)(h0 + (32 * ph + 16 * pt2 + fr) * 128 + 16 * nt + 4 * fq); }
    } else {
#pragma unroll
        for (int nt = 0; nt < 8; ++nt)
#pragma unroll
            for (int pt2 = 0; pt2 < 2; ++pt2) st[nt][pt2] = (f32x4){0.f, 0.f, 0.f, 0.f};
    }
    const int xco = tid & 31, xtq = (tid >> 5) & 7, bno = tid & 15, btq = (tid >> 4) & 7;
    const bool isX = tid < 256, isB = !isX && tid < 384, ldact = isX || isB || mode == 1;
    const int tq = isX ? xtq : btq;
    const bf16* rbase = isX ? (const bf16*)(a.ws + WS_SG) + (seqbase + tseg + 8 * tq) * 2048 + g * 256 + 8 * xco
                            : bcc_row(a, seqbase + tseg + 8 * tq) + (isB ? 0 : 1024) + g * 128 + 8 * bno;
    u32x4 pf[8];
#define SSD_PF(cn) do { _Pragma("unroll") for (int tt_ = 0; tt_ < 8; ++tt_) pf[tt_] = (ldact && (!smp || 8 * tq + tt_ < TS)) ? *(const u32x4*)(rbase + ((size_t)(cn) * 64 + tt_) * 2048) : (u32x4){0u, 0u, 0u, 0u}; \
        } while (0)
    SSD_PF(0);
    if (mode == 1) { for (int e = lane + 64 * ph; e < 64 * 72 / 2; e += 128) ((LAS unsigned*)MMh)[e] = 0u; }
    const float Ah = -expf(a.A_log[4 * g + (wid & 3)]), dtb = a.dt_bias[4 * g + (wid & 3)];
    float decsum = 0.f;
    bf16* ZB = (bf16*)(a.out + O_Y); LAS float* NS = (LAS float*)(lds + 131072);
    int ypend = -1;
#define SSD_YFIN() do { if (mode == 1 && ypend >= 0) { const float* nwp_ = a.ssm_norm_w + head * 64 + 32 * ph + 4 * fq; const f32x4 nw0_ = *(const f32x4*)nwp_, nw1_ = *(const f32x4*)(nwp_ + 16); \
        const float nwv[8] = {nw0_[0], nw0_[1], nw0_[2], nw0_[3], nw1_[0], nw1_[1], nw1_[2], nw1_[3]}; _Pragma("unroll") for (int lt = 0; lt < 4; ++lt) { const int l = 16 * lt + fr; float tot = 0.f; \
        _Pragma("unroll") for (int w = 0; w < 8; ++w) tot += NS[w * 64 + l]; const float rs = rsqrtf(tot * (1.f / 256.f) + EPS); \
        if (!smp || l < TS) { bf16* zo = ZB + (seqbase + ypend + l) * DI + head * 64 + 32 * ph + 4 * fq; const u32x2 g0 = *(const u32x2*)zo, g1 = *(const u32x2*)(zo + 16); \
            *(u32x2*)zo = (u32x2){pk2(bflo(g0.x) * rs * nwv[0], bfhi(g0.x) * rs * nwv[1]), pk2(bflo(g0.y) * rs * nwv[2], bfhi(g0.y) * rs * nwv[3])}; \
            *(u32x2*)(zo + 16) = (u32x2){pk2(bflo(g1.x) * rs * nwv[4], bfhi(g1.x) * rs * nwv[5]), pk2(bflo(g1.y) * rs * nwv[6], bfhi(g1.y) * rs * nwv[7])}; } } } } while (0)
    for (int c = 0; c < nch; ++c) {
        const int t0 = tseg + c * 64;
        const float dtraw = (tid >= 256 && (!smp || lane < TS)) ? DTW[(seqbase + t0 + lane) * 32 + 4 * g + (wid & 3)] : -1e30f;
        SSD_YFIN();
        if (isX || isB) {
            LAS bf16* T = isX ? (LAS bf16*)(lds + SSD_XT) + (xco >> 3) * 4608 + (8 * (xco & 7)) * 72 + 8 * tq : BT + (8 * bno) * 72 + 8 * tq;
#pragma unroll
            for (int j = 0; j < 8; ++j) { u32x4 w;
#pragma unroll
                for (int t2 = 0; t2 < 4; ++t2) { const unsigned lo = pf[2 * t2][j >> 1], hi = pf[2 * t2 + 1][j >> 1]; w[t2] = (j & 1) ? ((lo >> 16) | (hi & 0xffff0000u)) : ((lo & 0xffffu) | (hi << 16)); }
                *(LAS u32x4*)(T + j * 72) = w; }
        }
        if (!isX && mode == 1) { LAS bf16* R = isB ? Bs : Cs;
#pragma unroll
            for (int tt = 0; tt < 8; ++tt) *(LAS u32x4*)(R + (8 * tq + tt) * 136 + 8 * bno) = pf[tt]; }
        if (tid >= 256) {
            LAS float* F = (LAS float*)(lds + SSD_FA) + (wid & 3) * 256;
            const float dtv = dtraw > -1e29f ? softplusf_(dtraw + dtb) : 0.f; float av = dtv * Ah;
#pragma unroll
            for (int o = 1; o < 64; o <<= 1) { const float tv = __shfl_up(av, o); if (lane >= o) av += tv; }
            const float alast = __shfl(av, 63);
            F[lane] = dtv; F[64 + lane] = av; F[128 + lane] = __expf(av); F[192 + lane] = __expf(alast - av) * dtv; }
        if (c + 1 < nch) SSD_PF(c + 1);
        __syncthreads();
        const float acl = FAh[64 + 63]; if (mode == 0) decsum += acl;
        u32x2 zpre[4][2];
        if (mode == 1) {
#pragma unroll
            for (int lt = 0; lt < 4; ++lt) { const int l = 16 * lt + fr; if (!smp || l < TS) { const bf16* zp = ZB + (seqbase + t0 + l) * DI + head * 64 + 32 * ph + 4 * fq; zpre[lt][0] = *(const u32x2*)zp; zpre[lt][1] = *(const u32x2*)(zp + 16); } else { zpre[lt][0] = (u32x2){0u, 0u}; zpre[lt][1] = (u32x2){0u, 0u}; } }
        }
        if (mode == 1 && !(DIS & 4)) {
#pragma unroll MK_UNROLL
            for (int k = 0; k < 2; ++k) { const int lt = ph ? 1 + k : 3 * k;
_Pragma("unroll 1")
                for (int jt = 0; jt <= lt; ++jt) { f32x4 acc = {0.f, 0.f, 0.f, 0.f};
#pragma unroll
                    for (int ks = 0; ks < 4; ++ks) { const bf16x8 A = *(const LAS bf16x8*)(Cs + (16 * lt + fr) * 136 + 32 * ks + 8 * fq), B = *(const LAS bf16x8*)(Bs + (16 * jt + fr) * 136 + 32 * ks + 8 * fq); acc = MFMA16(A, B, acc); }
                    const int s = 16 * jt + fr; const float as_ = FAh[64 + s], ds = FAh[s];
#pragma unroll
                    for (int r = 0; r < 4; ++r) { const int l = 16 * lt + 4 * fq + r; float v = (l >= s) ? acc[r] * __expf(FAh[64 + l] - as_) * ds : 0.f; if (l == s) v += Dh; MMh[l * 72 + s] = (bf16)f2bf(v); } } }
            __syncthreads();
            if (!(DIS & 8)) {
            u32x2 hp[4][2][2];
#pragma unroll
            for (int kk = 0; kk < 4; ++kk)
#pragma unroll
                for (int pt2 = 0; pt2 < 2; ++pt2) { hp[kk][pt2][0] = (u32x2){pk2(st[2 * kk][pt2][0], st[2 * kk][pt2][1]), pk2(st[2 * kk][pt2][2], st[2 * kk][pt2][3])};
                    hp[kk][pt2][1] = (u32x2){pk2(st[2 * kk + 1][pt2][0], st[2 * kk + 1][pt2][1]), pk2(st[2 * kk + 1][pt2][2], st[2 * kk + 1][pt2][3])}; }
#pragma unroll SSD_LT_UNROLL
            for (int lt = 0; lt < 4; ++lt) { f32x4 y0 = {0.f, 0.f, 0.f, 0.f}, y1 = y0;
#pragma unroll
                for (int kk = 0; kk < 4; ++kk) { const LAS bf16* cp = Cs + (16 * lt + fr) * 136 + 32 * kk + 4 * fq; const u32x2 c0 = *(const LAS u32x2*)cp, c1 = *(const LAS u32x2*)(cp + 16);
                    const bf16x8 Bc = __builtin_bit_cast(bf16x8, (u32x4){c0.x, c0.y, c1.x, c1.y});
                    const bf16x8 A0 = __builtin_bit_cast(bf16x8, (u32x4){hp[kk][0][0].x, hp[kk][0][0].y, hp[kk][0][1].x, hp[kk][0][1].y}), A1 = __builtin_bit_cast(bf16x8, (u32x4){hp[kk][1][0].x, hp[kk][1][0].y, hp[kk][1][1].x, hp[kk][1][1].y});
                    y0 = MFMA16(A0, Bc, y0); y1 = MFMA16(A1, Bc, y1); }
                const int l = 16 * lt + fr; const float e = FAh[128 + l]; y0 = y0 * e; y1 = y1 * e;
#pragma unroll
                for (int ks = 0; ks < 2; ++ks) { const bf16x8 Bm = *(const LAS bf16x8*)(MMh + (16 * lt + fr) * 72 + 32 * ks + 8 * fq);
                    const bf16x8 A0 = *(const LAS bf16x8*)(XTh + (32 * ph + fr) * 72 + 32 * ks + 8 * fq), A1 = *(const LAS bf16x8*)(XTh + (32 * ph + 16 + fr) * 72 + 32 * ks + 8 * fq);
                    y0 = MFMA16(A0, Bm, y0); y1 = MFMA16(A1, Bm, y1); }
                float ss = 0.f;
                if (!smp || l < TS) { bf16* zp = ZB + (seqbase + t0 + l) * DI + head * 64 + 32 * ph + 4 * fq; const u32x2 z0 = zpre[lt][0], z1 = zpre[lt][1];
                    const float zf[8] = {bflo(z0.x), bfhi(z0.x), bflo(z0.y), bfhi(z0.y), bflo(z1.x), bfhi(z1.x), bflo(z1.y), bfhi(z1.y)};
#pragma unroll
                    for (int r = 0; r < 4; ++r) { y0[r] = y0[r] * zf[r] * sigmoidf_(zf[r]); y1[r] = y1[r] * zf[4 + r] * sigmoidf_(zf[4 + r]); ss += y0[r] * y0[r] + y1[r] * y1[r]; }
                    *(u32x2*)zp = (u32x2){pk2(y0[0], y0[1]), pk2(y0[2], y0[3])}; *(u32x2*)(zp + 16) = (u32x2){pk2(y1[0], y1[1]), pk2(y1[2], y1[3])}; }
                ss += __shfl_xor(ss, 16); ss += __shfl_xor(ss, 32);
                if (fq == 0) NS[wid * 64 + l] = ss; }
            ypend = t0;
            }
        }
        if (!(DIS & 16)) { const float cd = __expf(acl);
#pragma unroll
            for (int nt = 0; nt < 8; ++nt) { st[nt][0] = st[nt][0] * cd; st[nt][1] = st[nt][1] * cd; }
#pragma unroll
            for (int ks = 0; ks < 2; ++ks) { const f32x4 w0 = *(const LAS f32x4*)(FAh + 192 + 32 * ks + 8 * fq), w1 = *(const LAS f32x4*)(FAh + 192 + 32 * ks + 8 * fq + 4);
                bf16x8 Bx[2];
#pragma unroll
                for (int pt2 = 0; pt2 < 2; ++pt2) { const u32x4 x = *(const LAS u32x4*)(XTh + (32 * ph + 16 * pt2 + fr) * 72 + 32 * ks + 8 * fq);
                    Bx[pt2] = __builtin_bit_cast(bf16x8, (u32x4){pk2(bflo(x.x) * w0[0], bfhi(x.x) * w0[1]), pk2(bflo(x.y) * w0[2], bfhi(x.y) * w0[3]), pk2(bflo(x.z) * w1[0], bfhi(x.z) * w1[1]), pk2(bflo(x.w) * w1[2], bfhi(x.w) * w1[3])}); }
#pragma unroll
                for (int nt = 0; nt < 8; ++nt) { const bf16x8 An = *(const LAS bf16x8*)(BT + (16 * nt + fr) * 72 + 32 * ks + 8 * fq); st[nt][0] = MFMA16(An, Bx[0], st[nt][0]); st[nt][1] = MFMA16(An, Bx[1], st[nt][1]); if (nt & 1) __builtin_amdgcn_sched_barrier(0); } } }
        __syncthreads();
    }
    SSD_YFIN();
#undef SSD_YFIN
    float* dst = nullptr;
    if (mode == 0) { dst = SEGST + (((size_t)b * 8 + seg) * NHS + head) * 8192; if (lane == 0 && ph == 0) SEGDEC[(b * 8 + seg) * NHS + head] = expf(decsum); }
    else if (smp) dst = a.out + O_SS + ((size_t)b * NHS + head) * 8192;
    else if (seg == 7) dst = a.out + O_SP + ((size_t)b * NHS + head) * 8192;
    if (dst) {
#pragma unroll
        for (int nt = 0; nt < 8; ++nt)
#pragma unroll
            for (int pt2 = 0; pt2 < 2; ++pt2) *(f32x4*)(dst + (32 * ph + 16 * pt2 + fr) * 128 + 16 * nt + 4 * fq) = st[nt][pt2];
    }
#undef SSD_PF
    __syncthreads();
}
__device__ __forceinline__ void phase_ssd_b(const Args& a) {
    float* SEGST = segst_ptr(a); const float* SEGDEC = (const float*)(a.ws + WS_SEGDEC);
    const int n = NBP * NHS * 8192;
    for (int e = blockIdx.x * 512 + threadIdx.x; e < n; e += gridDim.x * 512) { const int b = e / (NHS * 8192), rem = e % (NHS * 8192), head = rem / 8192; float H = 0.f;
#pragma unroll
        for (int s = 0; s < 8; ++s) { const size_t idx = ((size_t)b * 8 + s) * NHS * 8192 + rem; const float loc = s < 7 ? SEGST[idx] : 0.f; SEGST[idx] = H; H = H * SEGDEC[(b * 8 + s) * NHS + head] + loc; } }
}

#ifndef ATT_THRL
#define ATT_THRL 60
#endif
template <bool SMP> __device__ __forceinline__ void attn_unit(const Args& a, LAS unsigned char* lds, const int b, const int h, const int qb) {
    const int tid = threadIdx.x, lane = tid & 63, r32 = lane & 31, hi = lane >> 5, wid = __builtin_amdgcn_readfirstlane(tid >> 6);
    bf16* QB = (bf16*)(a.ws + WS_BIG); const bf16* KB = QB + (size_t)MT * DM; const bf16* VB = KB + (size_t)MT * DM;
    bf16* OB = QB + (size_t)3 * MT * DM;
    if (SMP) { QB = (bf16*)(a.ws + WS_QS) - (size_t)MP * DM; KB = (const bf16*)(a.ws + WS_KS) - (size_t)MP * DM; VB = (const bf16*)(a.ws + WS_VS) - (size_t)MP * DM; }
    LAS bf16* Ks = (LAS bf16*)lds; LAS bf16* VT = (LAS bf16*)(lds + 18432); LAS float* CBs = (LAS float*)(lds + 36864);
    const int NT = SMP ? (SKV + 63) / 64 : 4 * qb + 4;
    const bool active = SMP ? (wid == 0) : true;
    const size_t qrow0 = SMP ? (size_t)MP + (size_t)b * TS : (size_t)b * TP + (size_t)qb * 256 + wid * 32;
    const int qpos0 = SMP ? PAST : qb * 256 + wid * 32;
    const float* CUM = SMP ? (const float*)(a.ws + WS_CUMS) + (size_t)b * SKV * 16 + h : (const float*)(a.ws + WS_CUMP) + (size_t)b * TP * 16 + h;
    bf16x8 qr[4];
#pragma unroll
    for (int d0 = 0; d0 < 4; ++d0) qr[d0] = active ? *(const bf16x8*)(QB + (qrow0 + r32) * DM + h * 64 + 16 * d0 + 8 * hi) : (bf16x8){0, 0, 0, 0, 0, 0, 0, 0};
    float mrun = -1e30f, lrun = 0.f; f32x16 o0, o1;
#pragma unroll
    for (int r = 0; r < 16; ++r) { o0[r] = 0.f; o1[r] = 0.f; }
    const int srow = tid >> 3, sch = tid & 7;
    u32x4 kreg, vreg; float breg = 0.f;
#define ATT_LOAD(t) do { const int kv0_ = 64 * (t); \
        if (!SMP) { const size_t ro = ((size_t)b * TP + kv0_ + srow) * DM + h * 64 + sch * 8; kreg = *(const u32x4*)(KB + ro); vreg = *(const u32x4*)(VB + ro); if (tid < 64) breg = -CUM[(size_t)(kv0_ + tid) * 16] * LOG2E; } \
        else if (kv0_ < PAST) { const size_t ro = (((size_t)b * PAST + kv0_ + srow) * NH + h) * 64 + sch * 8; const f32x4 k0 = *(const f32x4*)(a.cache_k + ro), k1 = *(const f32x4*)(a.cache_k + ro + 4), v0 = *(const f32x4*)(a.cache_v + ro), v1 = *(const f32x4*)(a.cache_v + ro + 4); \
            kreg = pack8(k0, k1); vreg = pack8(v0, v1); if (tid < 64) breg = -CUM[(size_t)(kv0_ + tid) * 16] * LOG2E; } \
        else { if (srow < TS) { const size_t ro = ((size_t)MP + (size_t)b * TS + srow) * DM + h * 64 + sch * 8; kreg = *(const u32x4*)(KB + ro); vreg = *(const u32x4*)(VB + ro); } else { kreg = (u32x4){0u, 0u, 0u, 0u}; vreg = kreg; } \
            if (tid < 64) breg = tid < TS ? -CUM[(size_t)(kv0_ + tid) * 16] * LOG2E : 0.f; } } while (0)
#define ATT_STORE(buf) do { *(LAS u32x4*)(Ks + (buf) * 4608 + srow * 72 + sch * 8) = kreg; LAS bf16* vt_ = VT + (buf) * 4608 + (sch * 8) * 72 + srow; \
        vt_[0] = (bf16)(vreg.x & 0xffffu); vt_[72] = (bf16)(vreg.x >> 16); vt_[144] = (bf16)(vreg.y & 0xffffu); vt_[216] = (bf16)(vreg.y >> 16); \
        vt_[288] = (bf16)(vreg.z & 0xffffu); vt_[360] = (bf16)(vreg.z >> 16); vt_[432] = (bf16)(vreg.w & 0xffffu); vt_[504] = (bf16)(vreg.w >> 16); \
        if (tid < 64) CBs[(buf) * 64 + tid] = breg; } while (0)
    ATT_LOAD(0); ATT_STORE(0); __syncthreads();
    for (int t = 0; t < NT; ++t) {
        const int buf = t & 1, kv0 = 64 * t;
        if (t + 1 < NT) ATT_LOAD(t + 1);
        if (active && kv0 <= qpos0 + 31) {
            const LAS bf16* kb = Ks + buf * 4608; const LAS bf16* vb = VT + buf * 4608; const LAS float* cb = CBs + buf * 64;
            f32x16 p0, p1;
#pragma unroll
            for (int r = 0; r < 16; ++r) { p0[r] = 0.f; p1[r] = 0.f; }
#pragma unroll
            for (int d0 = 0; d0 < 4; ++d0) { const bf16x8 a0 = *(const LAS bf16x8*)(kb + r32 * 72 + 16 * d0 + 8 * hi), a1 = *(const LAS bf16x8*)(kb + (32 + r32) * 72 + 16 * d0 + 8 * hi);
                p0 = MFMA32(a0, qr[d0], p0); p1 = MFMA32(a1, qr[d0], p1); }
#pragma unroll
            for (int gq = 0; gq < 4; ++gq) { const f32x4 b0 = *(const LAS f32x4*)(cb + 8 * gq + 4 * hi), b1 = *(const LAS f32x4*)(cb + 32 + 8 * gq + 4 * hi);
#pragma unroll
                for (int i = 0; i < 4; ++i) { p0[4 * gq + i] += b0[i]; p1[4 * gq + i] += b1[i]; } }
            if (kv0 + 63 > qpos0) { const int q = qpos0 + r32;
#pragma unroll
                for (int r = 0; r < 16; ++r) { const int kv = kv0 + (r & 3) + 8 * (r >> 2) + 4 * hi; if (kv > q) p0[r] = -INFINITY; if (kv + 32 > q) p1[r] = -INFINITY; } }
            float mx = fmaxf(p0[0], p1[0]);
#pragma unroll
            for (int r = 1; r < 16; ++r) mx = fmaxf(mx, fmaxf(p0[r], p1[r]));
            mx = fmaxf(mx, __shfl_xor(mx, 32));
            const float mnew = fmaxf(mrun, mx), alpha = __builtin_amdgcn_exp2f(mrun - mnew); mrun = mnew;
            float sum = 0.f;
#pragma unroll
            for (int r = 0; r < 16; ++r) { p0[r] = __builtin_amdgcn_exp2f(p0[r] - mnew); p1[r] = __builtin_amdgcn_exp2f(p1[r] - mnew); sum += p0[r] + p1[r]; }
            lrun = lrun * alpha + sum;
#pragma unroll
            for (int r = 0; r < 16; ++r) { o0[r] *= alpha; o1[r] *= alpha; }
            u32x4 pw[2][2];
#pragma unroll
            for (int hf = 0; hf < 2; ++hf) { pw[0][hf] = (u32x4){pk2(p0[8 * hf], p0[8 * hf + 1]), pk2(p0[8 * hf + 2], p0[8 * hf + 3]), pk2(p0[8 * hf + 4], p0[8 * hf + 5]), pk2(p0[8 * hf + 6], p0[8 * hf + 7])};
                pw[1][hf] = (u32x4){pk2(p1[8 * hf], p1[8 * hf + 1]), pk2(p1[8 * hf + 2], p1[8 * hf + 3]), pk2(p1[8 * hf + 4], p1[8 * hf + 5]), pk2(p1[8 * hf + 6], p1[8 * hf + 7])}; }
#pragma unroll
            for (int kt = 0; kt < 2; ++kt)
#pragma unroll
                for (int hf = 0; hf < 2; ++hf) { const bf16x8 pb = __builtin_bit_cast(bf16x8, pw[kt][hf]);
                    { const LAS bf16* vp = vb + r32 * 72 + 32 * kt + 16 * hf + 4 * hi; const s16x4 lo = *(const LAS s16x4*)vp, h4 = *(const LAS s16x4*)(vp + 8);
                      const bf16x8 av = {lo[0], lo[1], lo[2], lo[3], h4[0], h4[1], h4[2], h4[3]}; o0 = MFMA32(av, pb, o0); }
                    { const LAS bf16* vp = vb + (32 + r32) * 72 + 32 * kt + 16 * hf + 4 * hi; const s16x4 lo = *(const LAS s16x4*)vp, h4 = *(const LAS s16x4*)(vp + 8);
                      const bf16x8 av = {lo[0], lo[1], lo[2], lo[3], h4[0], h4[1], h4[2], h4[3]}; o1 = MFMA32(av, pb, o1); } }
        }
        if (t + 1 < NT) ATT_STORE(buf ^ 1);
        __syncthreads();
    }
    if (active) { const float lt = lrun + __shfl_xor(lrun, 32), inv = 1.f / lt; bf16* orow = OB + (qrow0 + r32) * DM + h * 64;
#pragma unroll
        for (int gq = 0; gq < 4; ++gq) { u32x2 w0, w1; w0.x = pk2(o0[4 * gq] * inv, o0[4 * gq + 1] * inv); w0.y = pk2(o0[4 * gq + 2] * inv, o0[4 * gq + 3] * inv);
            w1.x = pk2(o1[4 * gq] * inv, o1[4 * gq + 1] * inv); w1.y = pk2(o1[4 * gq + 2] * inv, o1[4 * gq + 3] * inv);
            *(u32x2*)(orow + 8 * gq + 4 * hi) = w0; *(u32x2*)(orow + 32 + 8 * gq + 4 * hi) = w1; } }
#undef ATT_LOAD
#undef ATT_STORE
}
__device__ __forceinline__ void phase_attention(const Args& a, LAS unsigned char* lds, char* lds_gen) {
    const attn_body::AttnTensors AT{(const attn_body::bf16*)(a.ws + WS_BIG), (const attn_body::bf16*)(a.ws + WS_BIG) + (size_t)MT * DM, (const attn_body::bf16*)(a.ws + WS_BIG) + (size_t)2 * MT * DM,
                                    (attn_body::bf16*)(a.ws + WS_BIG) + (size_t)3 * MT * DM, (const float*)(a.ws + WS_CUMP)};
    const attn_body::StaticOrder S((int)gridDim.x, (int)blockIdx.x);
    attn_body::attn_phase<attn_body::StaticOrder>(lds_gen, AT, S);
    for (int u = blockIdx.x; u < NBS * NH; u += gridDim.x) attn_unit<true>(a, lds, u >> 4, u & 15, 0);
}

struct SampleOrder {
    int pn;
    __device__ __forceinline__ bool next(int i, pg8::Unit& u) const { if (i > 0 || pn < 0) return false; u.pm = MP / 256; u.pn = pn; return true; }
    __device__ __forceinline__ void a_ready(const pg8::Unit&) const {}
    __device__ __forceinline__ void done(const pg8::Unit&) const {}
};
constexpr int N_PHASES = 14;
__global__ void __launch_bounds__(512, 2) fox_ssd_fwd(Args a) {
    extern __shared__ __attribute__((aligned(16))) unsigned char lds_raw[];
    LAS unsigned char* lds = (LAS unsigned char*)lds_raw;
    const int lo = a.ph_lo, hi = a.ph_hi, G = gridDim.x, bx = blockIdx.x, tid = threadIdx.x;
#ifndef REPMASK
#define REPMASK 0
#endif
#ifndef PHMASK
#define PHMASK 0x3fff
#endif
#define IN(k) (((PHMASK >> (k)) & 1) && lo <= (k) && (k) < hi)
#ifndef FAST_BAR
#define FAST_BAR 1
#endif
#define SEAM(k) do { if (IN(k) && IN((k) + 1)) { if (a.coop) { if (!FAST_BAR || ((k) == 0 && a.pad != 0)) cg::this_grid().sync(); else xcd_barrier(xbar); } } } while (0)
    XcdBarrier xbar; xbar.bar = (unsigned*)a.ws; xbar.x = 0; xbar.st = nullptr;
    if (FAST_BAR && a.coop) { volatile LAS unsigned* stw = (volatile LAS unsigned*)(lds + 139264); if (tid < 2) stw[tid] = 0u; __syncthreads(); xbar = xcd_barrier_post((unsigned*)a.ws, stw); }
    bf16* WIN = (bf16*)(a.ws + WS_WIN); bf16* XN = (bf16*)(a.ws + WS_XN); bf16* BIG = (bf16*)(a.ws + WS_BIG); bf16* SG = (bf16*)(a.ws + WS_SG);
    bf16* QB = BIG; bf16* KB = BIG + (size_t)MT * DM; bf16* VB = KB + (size_t)MT * DM; bf16* TMP = VB + (size_t)MT * DM; bf16* SGA = SG; bf16* SGS = SG + (size_t)MT * DM;
    bf16* Z = (bf16*)(a.out + O_Y);
    if (IN(0)) for (int rep_ = 0; rep_ <= ((REPMASK >> 0) & 1); ++rep_) phase_prologue(a);
    SEAM(0);
    if (IN(1)) for (int rep_ = 0; rep_ <= ((REPMASK >> 1) & 1); ++rep_) { EpiP1 E{Z, BIG, (float*)(a.ws + WS_LOGF), (float*)(a.ws + WS_DT), a.out, a.b_f, a.dt_bias}; run_gemm(lds, XN, WIN, 25 * 256, DM, E);
        { const int spn = (int)bx - (G - 20); SampleOrder SO{(G == 256 && spn >= 0) ? spn : -1};
          EpiP3 ES{(bf16*)(a.ws + WS_QS) - (size_t)MP * DM, (bf16*)(a.ws + WS_KS) - (size_t)MP * DM, (bf16*)(a.ws + WS_VS) - (size_t)MP * DM, (bf16*)(a.ws + WS_SGAS) - (size_t)MP * DM, (bf16*)(a.ws + WS_SGSS) - (size_t)MP * DM, a.out, a.q_norm_w, a.k_norm_w};
          pg8::Gemm gs{XN, WIN + (size_t)25 * 256 * DM, MT, 20 * 256, DM};
          pg8::gemm_phase<EpiP3, SampleOrder, true, true>(lds, gs, SO, ES); } }
    SEAM(1);
    if (IN(2)) for (int rep_ = 0; rep_ <= ((REPMASK >> 2) & 1); ++rep_) {
        phase_bc_conv(a);
        if (G <= NBP * 7 * 8) { const int nC = NBP * 16 + NBS * 5; for (int it = G - 1 - bx; it < nC; it += G) cumsum_item(a, lds, it); }
    }
    SEAM(2);
    if (IN(3)) {
        const int nA = NBP * 7 * 8;
        for (int rep = 0; rep <= ((REPMASK >> 3) & 1); ++rep)
        for (int it = bx; it < nA; it += G) { const int g = it & 7, r = it >> 3; ssd_item(a, lds, 0, 0, r / 7, r % 7, g); }
        if (G > nA && bx >= nA) { const int nC = NBP * 16 + NBS * 5; for (int it = bx - nA; it < nC; it += G - nA) cumsum_item(a, lds, it); }

    }
    SEAM(3);
    if (IN(5)) {
        const int nP = NBP * 8 * 8, nS = NBS * 8;
        for (int rep = 0; rep <= ((REPMASK >> 5) & 1); ++rep)
        for (int it = bx; it < nP + nS; it += G) { if (it < nP) { const int g = it & 7, r = it >> 3; ssd_item(a, lds, 1, 0, r >> 3, r & 7, g); } else { const int r = it - nP; ssd_item(a, lds, 1, 1, r >> 3, 0, r & 7); } }
    }
    SEAM(5);
    if (IN(7)) cumsum_fixup(a, lds);
    if (IN(7)) for (int rep_ = 0; rep_ <= ((REPMASK >> 7) & 1); ++rep_) { EpiP3 E{QB, KB, VB, SGA, SGS, a.out, a.q_norm_w, a.k_norm_w}; run_gemm(lds, XN, WIN + (size_t)25 * 256 * DM, 20 * 256, DM, E, MP); }
    SEAM(7);
    if (IN(8)) { for (int rep = 0; rep <= ((REPMASK >> 8) & 1); ++rep) phase_attention(a, lds, (char*)lds_raw); }
    SEAM(8);
    if (IN(9)) for (int rep_ = 0; rep_ <= ((REPMASK >> 9) & 1); ++rep_) { EpiGate<0> E{SGA, nullptr, VB}; run_gemm(lds, TMP, (const bf16*)(a.ws + WS_WPA), DM, DM, E, MP); mini_gemm<0>(a, lds, TMP, (const bf16*)(a.ws + WS_WPA), DM, (const bf16*)(a.ws + WS_SGAS) - (size_t)MP * DM, nullptr, VB, nullptr, nullptr); }
    if (IN(10)) for (int rep_ = 0; rep_ <= ((REPMASK >> 10) & 1); ++rep_) { EpiGate<1> E{SGS, VB, KB}; run_gemm(lds, Z, (const bf16*)(a.ws + WS_WPB), DM, DI, E, MP); mini_gemm<1>(a, lds, Z, (const bf16*)(a.ws + WS_WPB), DI, (const bf16*)(a.ws + WS_SGSS) - (size_t)MP * DM, VB, KB, nullptr, nullptr); }
    SEAM(10);
    if (IN(11)) for (int rep_ = 0; rep_ <= ((REPMASK >> 11) & 1); ++rep_) { EpiRes E{a.x_prompt, a.x_sample, a.out, 1, XN, a.norm2_w, (float*)(a.ws + WS_LOGF)}; run_gemm(lds, KB, (const bf16*)(a.ws + WS_WOUT), DM, DM, E, MP); mini_gemm<2>(a, lds, KB, (const bf16*)(a.ws + WS_WOUT), DM, nullptr, nullptr, nullptr, XN, (float*)(a.ws + WS_LOGF)); }
    SEAM(11);
    if (IN(12)) for (int rep_ = 0; rep_ <= ((REPMASK >> 12) & 1); ++rep_) { EpiRelu2 E{BIG, FF, (const float*)(a.ws + WS_LOGF)}; run_gemm(lds, XN, (const bf16*)(a.ws + WS_WUP), FF, DM, E); }
    SEAM(12);
    if (IN(13)) { EpiRes E{nullptr, nullptr, a.out, 0, nullptr, nullptr, nullptr}; run_gemm(lds, BIG, (const bf16*)(a.ws + WS_WDN), DM, FF, E, MP); mini_gemm<3>(a, lds, BIG, (const bf16*)(a.ws + WS_WDN), FF, nullptr, nullptr, nullptr, nullptr, nullptr); }
#undef IN
#undef SEAM
}

extern "C" void kernel_launch(void* const* d_in, const int* in_sizes, int n_in, void* d_out, int out_size, void* d_ws, size_t ws_size, hipStream_t stream) {
    static int grid = 0;
    if (grid == 0) {
        if (n_in != 24 || (size_t)out_size != O_END || ws_size < WS_END) { fprintf(stderr, "kernel_launch: unexpected shapes: n_in %d out %d ws %zu\n", n_in, out_size, ws_size); grid = -1; return; }
        int dev = 0, cus = 0, per_cu = 0;
        if (hipGetDevice(&dev) != hipSuccess || hipDeviceGetAttribute(&cus, hipDeviceAttributeMultiprocessorCount, dev) != hipSuccess) { grid = -1; return; }
        if (hipFuncSetAttribute((const void*)fox_ssd_fwd, hipFuncAttributeMaxDynamicSharedMemorySize, LDS_BYTES) != hipSuccess) { fprintf(stderr, "kernel_launch: hipFuncSetAttribute failed\n"); grid = -1; return; }
        if (hipOccupancyMaxActiveBlocksPerMultiprocessor(&per_cu, (const void*)fox_ssd_fwd, 512, LDS_BYTES) != hipSuccess || per_cu < 1) per_cu = 1;
        (void)hipGetLastError();
        grid = cus * per_cu;
    }
    if (grid < 0) return;
    Args a{};
    const float** pp = (const float**)&a;
    for (int i = 0; i < 24; ++i) pp[i] = (const float*)d_in[i];
    a.out = (float*)d_out; a.ws = (unsigned char*)d_ws;
#if MK_MULTI
    for (int p = 0; p < N_PHASES; ++p) { a.ph_lo = p; a.ph_hi = p + 1; a.coop = 0; hipLaunchKernelGGL(fox_ssd_fwd, dim3(grid), dim3(512), LDS_BYTES, stream, a); }
#else
    a.ph_lo = 0; a.ph_hi = N_PHASES; a.coop = 1;
    (void)hipMemsetAsync(d_ws, 0, 16384, stream);
    void* args[] = {&a};
    hipError_t e = hipLaunchCooperativeKernel((const void*)fox_ssd_fwd, dim3(grid), dim3(512), args, LDS_BYTES, stream);
    if (e != hipSuccess) fprintf(stderr, "cooperative launch failed: %s (grid %d)\n", hipGetErrorString(e), grid);
#endif
}
```

```cpp
#include <hip/hip_runtime.h>
#include <hip/hip_cooperative_groups.h>
#include <cstdio>
#include <cstdint>
#include <cmath>
namespace cg = cooperative_groups;
namespace pg8 {
#define PG8_LAS __attribute__((address_space(3)))
typedef unsigned short bf16_t;
typedef short bf16x8 __attribute__((ext_vector_type(8)));
typedef float f32x4 __attribute__((ext_vector_type(4)));
typedef unsigned u32x4 __attribute__((ext_vector_type(4)));
constexpr int BM = 256, BK = 64, HALF = 128, HTB = HALF * BK * 2  , STAGE_BYTES = 8 * HTB, NXCD = 8, WGM = 8;

__host__ __device__ __forceinline__ int lds_byte(int r, int c) { const int st = (r >> 4) * 2 + (c >> 5), rr = r & 15, cc = c & 31, ob = rr * 64 + cc * 2; return st * 1024 + (ob ^ (((ob >> 9) & 1) << 5)); }
__host__ __device__ __forceinline__ void stage_rc(int b, int& R, int& C) { const int st = b / 1024, sb = b % 1024, swz = sb ^ (((sb >> 9) & 1) << 5); R = (st >> 1) * 16 + swz / 64; C = (st & 1) * 32 + (swz % 64) / 2; }
__host__ __device__ __forceinline__ int perm32(int rho) { const int n = rho >> 4, i = rho & 15; return 8 * (i >> 2) + 4 * n + (i & 3); }

struct Unit { int pm, pn; };
struct Gemm { const bf16_t* A; const bf16_t* Bt; int M, N, K; };

struct StaticOrder {
    int nM, nN, nwg, G, c;
    __host__ __device__ void init(int M, int N, int G_, int c_) { nM = M / BM; nN = N / BM; nwg = nM * nN; G = G_; c = c_; }
    __host__ __device__ bool next(int i, Unit& u) const {
        const long L = (long)i * G + c; if (L >= nwg) return false;
        int wgid = (int)L; { const int q = nwg / NXCD, r = nwg % NXCD, xcd = wgid % NXCD, off = wgid / NXCD; wgid = (xcd < r ? xcd * (q + 1) : r * (q + 1) + (xcd - r) * q) + off; }
        const int nig = WGM * nN, gid = wgid / nig, fm = gid * WGM, gsz = (nM - fm) < WGM ? (nM - fm) : WGM;
        u.pm = fm + ((wgid % nig) % gsz); u.pn = (wgid % nig) / gsz; return true;
    }
    __device__ __forceinline__ void a_ready(const Unit&) const {}
    __device__ __forceinline__ void done(const Unit&) const {}
};

__device__ __forceinline__ unsigned cvt_pk_bf16(float lo, float hi) { unsigned r; asm volatile("v_cvt_pk_bf16_f32 %0, %1, %2" : "=v"(r) : "v"(lo), "v"(hi)); return r; }
typedef float f32x2 __attribute__((ext_vector_type(2)));
template <class Epi, class Sched, bool ALIGN_EPI = false, bool SP2 = false>
__device__ __forceinline__ void gemm_phase(PG8_LAS unsigned char* lds, const Gemm g, const Sched& S, const Epi& E) {
    const int tid = threadIdx.x, wid = __builtin_amdgcn_readfirstlane(tid >> 6), lane = tid & 63, wr = wid >> 2, wc = wid & 3, fr = lane & 15, fq = lane >> 4;
    const int K = g.K, nt = K / BK;
    unsigned voffA[2], voffB[2];
#pragma unroll
    for (int i = 0; i < 2; ++i) { int R, C; stage_rc(tid * 16 + i * 8192, R, C); const int Rb = Epi::PERM ? ((R & ~31) + perm32(R & 31)) : R;
        voffA[i] = (unsigned)(R * K + C) * 2u; voffB[i] = (unsigned)(Rb * K + C) * 2u; }
    const size_t kstep = (size_t)(BK * 2);
    const size_t hstep = (size_t)HALF * K * 2;
    const size_t tstep = 2 * hstep;
    const unsigned ldsw = (unsigned)wid * 1024u;
    const int aoff = lds_byte(wr * 64 + fr, fq * 8), boff = lds_byte(wc * 32 + fr, fq * 8);
#define PG8_SA(b, h) (((b) * 2 + (h)) * HTB)
#define PG8_SB(b, h) ((4 + (b) * 2 + (h)) * HTB)
#define PG8_STAGE(bufoff, gbase, voff) do { _Pragma("unroll") for (int _i = 0; _i < 2; ++_i) \
        __builtin_amdgcn_global_load_lds((const unsigned*)((const char*)(gbase) + (voff)[_i]), (PG8_LAS unsigned*)(lds + (bufoff) + ldsw + _i * 8192), 16, 0, 0); } while (0)
#define PG8_LDA(dst, b, h) do { _Pragma("unroll") for (int m = 0; m < 4; ++m) _Pragma("unroll") for (int k = 0; k < 2; ++k) dst[m][k] = *(const PG8_LAS bf16x8*)(lds + PG8_SA(b, h) + aoff + m * 2048 + k * 1024); } while (0)
#define PG8_LDB(dst, b, h) do { _Pragma("unroll") for (int n = 0; n < 2; ++n) _Pragma("unroll") for (int k = 0; k < 2; ++k) dst[n][k] = *(const PG8_LAS bf16x8*)(lds + PG8_SB(b, h) + boff + n * 2048 + k * 1024); } while (0)
#define PG8_MMA(ai, bj, At, Bt) do { __builtin_amdgcn_s_setprio(1); _Pragma("unroll") for (int m = 0; m < 4; ++m) _Pragma("unroll") for (int n = 0; n < 2; ++n) _Pragma("unroll") for (int k = 0; k < 2; ++k) \
        acc[ai][bj][m][n] = __builtin_amdgcn_mfma_f32_16x16x32_bf16(Bt[n][k], At[m][k], acc[ai][bj][m][n], 0, 0, 0); __builtin_amdgcn_s_setprio(0); } while (0)
#define PG8_WAIT_V(n) asm volatile("s_waitcnt vmcnt(" #n ")" ::: "memory")
#define PG8_WAIT_L(n) asm volatile("s_waitcnt lgkmcnt(" #n ")" ::: "memory")
#define PG8_BAR __builtin_amdgcn_s_barrier()
#define PG8_SCHED __builtin_amdgcn_sched_barrier(0)
    Unit cur, nxt; int ui = 0;
    if (!S.next(0, cur)) return;
    f32x4 acc[2][2][4][2];
#pragma unroll
    for (int a = 0; a < 2; ++a)
#pragma unroll
        for (int b = 0; b < 2; ++b)
#pragma unroll
            for (int m = 0; m < 4; ++m)
#pragma unroll
                for (int n = 0; n < 2; ++n) acc[a][b][m][n] = (f32x4){0.f, 0.f, 0.f, 0.f};
    bf16x8 At[4][2], B0[2][2], B1[2][2];
    const char* cA = (const char*)g.A + (size_t)cur.pm * tstep; const char* cB = (const char*)g.Bt + (size_t)cur.pn * tstep;
    S.a_ready(cur);
    if constexpr (SP2) {
        PG8_STAGE(PG8_SB(0, 0), cB, voffB); PG8_STAGE(PG8_SB(0, 1), cB + hstep, voffB); PG8_STAGE(PG8_SA(0, 0), cA, voffA); PG8_STAGE(PG8_SA(0, 1), cA + hstep, voffA);
        if (wr == 1) PG8_BAR;
        PG8_WAIT_V(2); PG8_BAR;
        PG8_STAGE(PG8_SB(1, 0), cB + kstep, voffB); PG8_STAGE(PG8_SA(1, 0), cA + kstep, voffA); PG8_STAGE(PG8_SB(1, 1), cB + hstep + kstep, voffB);
        PG8_WAIT_V(6); PG8_BAR;
    } else {
        PG8_STAGE(PG8_SB(0, 0), cB, voffB); PG8_STAGE(PG8_SA(0, 0), cA, voffA); PG8_STAGE(PG8_SB(0, 1), cB + hstep, voffB); PG8_STAGE(PG8_SA(0, 1), cA + hstep, voffA);
        if (wr == 1) PG8_BAR;
        PG8_WAIT_V(4); PG8_BAR;
        PG8_STAGE(PG8_SB(1, 0), cB + kstep, voffB); PG8_STAGE(PG8_SA(1, 0), cA + kstep, voffA); PG8_STAGE(PG8_SB(1, 1), cB + hstep + kstep, voffB);
        PG8_WAIT_V(6); PG8_BAR;
    }
    for (;;) {
        const bool has_next = S.next(ui + 1, nxt);
        const char* nA = has_next ? (const char*)g.A + (size_t)nxt.pm * tstep : cA; const char* nB = has_next ? (const char*)g.Bt + (size_t)nxt.pn * tstep : cB;
        for (int t = 0; t < nt; t += 2) {
            const bool last = (t == nt - 2);
            const char* a1 = cA + (size_t)(t + 1) * kstep;
            const char* a2 = last ? nA : cA + (size_t)(t + 2) * kstep; const char* b2 = last ? nB : cB + (size_t)(t + 2) * kstep;
            const char* a3 = a2 + kstep; const char* b3 = b2 + kstep;
            if (last && has_next) S.a_ready(nxt);
            if constexpr (SP2) {
            PG8_LDB(B0, 0, 0); PG8_LDB(B1, 0, 1); PG8_SCHED; PG8_LDA(At, 0, 0); PG8_STAGE(PG8_SA(1, 1), a1 + hstep, voffA);
            PG8_WAIT_V(8); PG8_WAIT_L(0); PG8_BAR; PG8_MMA(0, 0, At, B0); PG8_MMA(0, 1, At, B1); PG8_BAR; PG8_SCHED;
            PG8_LDA(At, 0, 1); PG8_STAGE(PG8_SB(0, 0), b2, voffB); PG8_STAGE(PG8_SB(0, 1), b2 + hstep, voffB); PG8_STAGE(PG8_SA(0, 0), a2, voffA);
            PG8_WAIT_V(8); PG8_WAIT_L(0); PG8_BAR; PG8_MMA(1, 0, At, B0); PG8_MMA(1, 1, At, B1); PG8_BAR; PG8_SCHED;
            PG8_LDB(B0, 1, 0); PG8_LDB(B1, 1, 1); PG8_SCHED; PG8_LDA(At, 1, 0); PG8_STAGE(PG8_SA(0, 1), a2 + hstep, voffA);
            PG8_WAIT_V(8); PG8_WAIT_L(0); PG8_BAR; PG8_MMA(0, 0, At, B0); PG8_MMA(0, 1, At, B1); PG8_BAR; PG8_SCHED;
            PG8_LDA(At, 1, 1); PG8_STAGE(PG8_SB(1, 0), b3, voffB); PG8_STAGE(PG8_SB(1, 1), b3 + hstep, voffB); PG8_STAGE(PG8_SA(1, 0), a3, voffA);
            PG8_WAIT_V(8); PG8_WAIT_L(0); PG8_BAR; PG8_MMA(1, 0, At, B0); PG8_MMA(1, 1, At, B1); PG8_BAR; PG8_SCHED;
            } else {
            PG8_LDB(B0, 0, 0); PG8_SCHED; PG8_LDA(At, 0, 0); PG8_STAGE(PG8_SA(1, 1), a1 + hstep, voffA);
            PG8_WAIT_L(8); PG8_BAR; PG8_WAIT_L(0); PG8_MMA(0, 0, At, B0); PG8_BAR; PG8_SCHED;
            PG8_LDB(B1, 0, 1); PG8_STAGE(PG8_SB(0, 0), b2, voffB);
            PG8_BAR; PG8_WAIT_L(0); PG8_MMA(0, 1, At, B1); PG8_BAR;
            PG8_LDA(At, 0, 1); PG8_STAGE(PG8_SA(0, 0), a2, voffA);
            PG8_BAR; PG8_WAIT_L(0); PG8_MMA(1, 0, At, B0); PG8_BAR; PG8_SCHED;
            PG8_STAGE(PG8_SB(0, 1), b2 + hstep, voffB);
            PG8_WAIT_V(6); PG8_BAR; PG8_MMA(1, 1, At, B1); PG8_BAR;
            PG8_LDB(B0, 1, 0); PG8_SCHED; PG8_LDA(At, 1, 0); PG8_STAGE(PG8_SA(0, 1), a2 + hstep, voffA);
            PG8_WAIT_L(8); PG8_BAR; PG8_WAIT_L(0); PG8_MMA(0, 0, At, B0); PG8_BAR; PG8_SCHED;
            PG8_LDB(B1, 1, 1); PG8_STAGE(PG8_SB(1, 0), b3, voffB);
            PG8_BAR; PG8_WAIT_L(0); PG8_MMA(0, 1, At, B1); PG8_BAR;
            PG8_LDA(At, 1, 1); PG8_STAGE(PG8_SA(1, 0), a3, voffA);
            PG8_BAR; PG8_WAIT_L(0); PG8_MMA(1, 0, At, B0); PG8_BAR; PG8_SCHED;
            PG8_STAGE(PG8_SB(1, 1), b3 + hstep, voffB);
            PG8_WAIT_V(6); PG8_BAR; PG8_MMA(1, 1, At, B1); PG8_BAR;
            }
        }
        if constexpr (ALIGN_EPI) { if (wr == 0) PG8_BAR; }
        if constexpr (!Epi::AFTER_DRAIN) { E(acc, cur, wr, wc, fr, fq); S.done(cur); }
        if (!has_next) break;
#pragma unroll
        for (int a = 0; a < 2; ++a)
#pragma unroll
            for (int b = 0; b < 2; ++b)
#pragma unroll
                for (int m = 0; m < 4; ++m)
#pragma unroll
                    for (int n = 0; n < 2; ++n) acc[a][b][m][n] = (f32x4){0.f, 0.f, 0.f, 0.f};
        cur = nxt; cA = nA; cB = nB; ++ui;
        if constexpr (ALIGN_EPI) { if (wr == 1) PG8_BAR; }
    }
    PG8_WAIT_V(0);
    if constexpr (!ALIGN_EPI) { if (wr == 0) PG8_BAR; }
    PG8_BAR;
    if constexpr (Epi::AFTER_DRAIN) { E.fused(acc, cur, wr, wc, fr, fq, lds, wid, lane); S.done(cur); }
#undef PG8_SA
#undef PG8_SB
#undef PG8_STAGE
#undef PG8_LDA
#undef PG8_LDB
#undef PG8_MMA
#undef PG8_WAIT_V
#undef PG8_WAIT_L
#undef PG8_BAR
#undef PG8_SCHED
}
}

#ifndef MK_MULTI
#define MK_MULTI 0
#endif
#define LAS __attribute__((address_space(3)))
typedef unsigned short bf16;
typedef short bf16x8 __attribute__((ext_vector_type(8)));
typedef short s16x4 __attribute__((ext_vector_type(4)));
typedef float f32x4 __attribute__((ext_vector_type(4)));
typedef float f32x16 __attribute__((ext_vector_type(16)));
typedef unsigned u32x4 __attribute__((ext_vector_type(4)));
typedef unsigned u32x2 __attribute__((ext_vector_type(2)));

constexpr int DM = 1024, TP = 8192, NBP = 4, NBS = 8, TS = 32, PAST = 2048, MP = NBP * TP, MS = NBS * TS, MT = MP + MS;
constexpr int NH = 16, DI = 2048, NHS = 32, DST = 128, CONVD = 4096, DPROJ = 11312, FF = 4096, NWIN = 11520, SKV = PAST + TS;
constexpr float EPS = 1e-6f, LOG2E = 1.4426950408889634f, QSCALE = 0.125f * LOG2E;
constexpr size_t O_Y = 0, O_KP = (size_t)MT * DM, O_VP = O_KP + (size_t)MP * DM, O_LP = O_VP + (size_t)MP * DM, O_CP = O_LP + (size_t)MP * NH,
                 O_SP = O_CP + (size_t)NBP * 3 * CONVD, O_KS = O_SP + (size_t)NBP * NHS * 64 * DST, O_VS = O_KS + (size_t)MS * DM, O_LS = O_VS + (size_t)MS * DM,
                 O_CS = O_LS + (size_t)MS * NH, O_SS = O_CS + (size_t)NBS * 3 * CONVD, O_END = O_SS + (size_t)NBS * NHS * 64 * DST;
static_assert(O_END == 105271296, "d_out map");
constexpr size_t MiB = 1u << 20, U1 = (size_t)MT * DM * 2;
constexpr size_t WS_WIN = 1 * MiB, WS_WPA = 24 * MiB, WS_WPB = 26 * MiB, WS_WOUT = 30 * MiB, WS_WUP = 32 * MiB, WS_WDN = 40 * MiB;
constexpr size_t WS_LOGF = 48 * MiB, WS_CUMP = 51 * MiB, WS_CUMS = 53 * MiB, WS_DT = 55 * MiB, WS_SEGDEC = 59 * MiB + MiB / 2;
constexpr size_t WS_QS = 64 * 1024, WS_KS = 23 * MiB + MiB / 2, WS_VS = 50 * MiB + MiB / 4, WS_SGAS = 54 * MiB + MiB / 4, WS_SGSS = 511 * MiB + MiB / 2;
constexpr size_t WS_XN = 60 * MiB, WS_BIG = WS_XN + U1, WS_SG = WS_BIG + 4 * U1, WS_END = WS_SG + 2 * U1 + MiB / 2;
static_assert(WS_END <= 512 * MiB, "d_ws map");
constexpr int LDS_BYTES = 147456;

struct Args {
    const float *x_prompt, *x_sample, *cache_k, *cache_v, *cache_logf, *state_conv, *state_ssm, *norm1_w, *w_in, *b_f, *q_norm_w, *k_norm_w, *conv_w, *conv_b,
        *dt_bias, *A_log, *D_skip, *ssm_norm_w, *w_pa, *w_pb, *w_out, *norm2_w, *w_up, *w_down;
    float* out; unsigned char* ws; int ph_lo, ph_hi, coop, pad;
};

__device__ __forceinline__ unsigned f2bf(float f) { unsigned u = __builtin_bit_cast(unsigned, f); return (u + 0x7fffu + ((u >> 16) & 1u)) >> 16; }
typedef float f32x2_t __attribute__((ext_vector_type(2))); typedef __bf16 bf16x2_t __attribute__((ext_vector_type(2)));
__device__ __forceinline__ unsigned pk2(float lo, float hi) { f32x2_t v = {lo, hi}; bf16x2_t b = __builtin_convertvector(v, bf16x2_t); return __builtin_bit_cast(unsigned, b); }
__device__ __forceinline__ float bflo(unsigned w) { return __uint_as_float(w << 16); }
__device__ __forceinline__ float bfhi(unsigned w) { return __uint_as_float(w & 0xffff0000u); }
__device__ __forceinline__ float bf2f(bf16 v) { return __uint_as_float(((unsigned)v) << 16); }
__device__ __forceinline__ float wave_sum(float v) {
#pragma unroll
    for (int o = 1; o < 64; o <<= 1) v += __shfl_xor(v, o);
    return v;
}
__device__ __forceinline__ float sigmoidf_(float x) { return __builtin_amdgcn_rcpf(1.f + __expf(-x)); }
__device__ __forceinline__ float softplusf_(float x) { return fmaxf(x, 0.f) + __logf(1.f + __expf(-fabsf(x))); }
__device__ __forceinline__ const float* xrow_ptr(const Args& a, int m) { return m < MP ? a.x_prompt + (size_t)m * DM : a.x_sample + (size_t)(m - MP) * DM; }

__device__ __forceinline__ int win_src_col(int n) {
    if (n < 2048) return 3088 + n;
    if (n < 6144) return 5136 + (n - 2048);
    if (n < 6400) { const int j = n - 6144; if (j < 16) return 3072 + j; if (j < 48) return 9232 + (j - 16); return -1; }
    if (n < 8448) { int p = n - 6400; const int isk = p >= 1024; p &= 1023; const int tq = p >> 8, pp = p & 255, bj = pp >> 7, wc = (pp & 127) >> 5, e = pp & 31;
                    return (isk ? 1024 : 0) + (4 * tq + wc) * 64 + 32 * bj + e; }
    if (n < 9472) return 2048 + (n - 8448);
    if (n < 10496) return 9264 + (n - 9472);
    return 10288 + (n - 10496);
}
__device__ __forceinline__ void wt_item(const float* __restrict__ W, int K, int N, bf16* WT, int nblk, int item, bool is_win, int tid) {
    const int nb = item % nblk, kb = item / nblk, n = nb * 64 + (tid & 63), k0 = kb * 64 + (tid >> 6) * 8;
    const int sc = is_win ? win_src_col(n) : n;
    float v[8];
#pragma unroll
    for (int i = 0; i < 8; ++i) v[i] = sc >= 0 ? W[(size_t)(k0 + i) * N + sc] : 0.f;
    u32x4 o; o.x = pk2(v[0], v[1]); o.y = pk2(v[2], v[3]); o.z = pk2(v[4], v[5]); o.w = pk2(v[6], v[7]);
    *(u32x4*)(WT + (size_t)n * K + k0) = o;
}
__device__ __forceinline__ void rms_row_to_bf16(const float* xrow, const float* w, bf16* orow, int lane) {
    const f32x4* xr = (const f32x4*)xrow + lane; f32x4 v[4]; float s = 0.f;
#pragma unroll
    for (int j = 0; j < 4; ++j) { v[j] = xr[64 * j]; s += (v[j].x * v[j].x + v[j].y * v[j].y) + (v[j].z * v[j].z + v[j].w * v[j].w); }
    const float rstd = rsqrtf(wave_sum(s) * (1.f / DM) + EPS);
#pragma unroll
    for (int j = 0; j < 4; ++j) { const f32x4 wv = ((const f32x4*)w)[lane + 64 * j]; u32x2 o; o.x = pk2(v[j].x * rstd * wv.x, v[j].y * rstd * wv.y); o.y = pk2(v[j].z * rstd * wv.z, v[j].w * rstd * wv.w);
        *((u32x2*)orow + lane + 64 * j) = o; }
}
__device__ __forceinline__ void phase_prologue(const Args& a) {
    const int tid = threadIdx.x, lane = tid & 63, wid = tid >> 6, G = gridDim.x, bx = blockIdx.x;
    constexpr int I_WIN = (NWIN / 64) * (DM / 64), I_PA = 16 * 16, I_PB = 16 * 32, I_OUT = 16 * 16, I_UP = 64 * 16, I_DN = 16 * 64, NIT = I_WIN + I_PA + I_PB + I_OUT + I_UP + I_DN;
    for (int it = bx; it < NIT; it += G) {
        int r = it;
        if (r < I_WIN) { wt_item(a.w_in, DM, DPROJ, (bf16*)(a.ws + WS_WIN), NWIN / 64, r, true, tid); continue; } r -= I_WIN;
        if (r < I_PA) { wt_item(a.w_pa, DM, DM, (bf16*)(a.ws + WS_WPA), 16, r, false, tid); continue; } r -= I_PA;
        if (r < I_PB) { wt_item(a.w_pb, DI, DM, (bf16*)(a.ws + WS_WPB), 16, r, false, tid); continue; } r -= I_PB;
        if (r < I_OUT) { wt_item(a.w_out, DM, DM, (bf16*)(a.ws + WS_WOUT), 16, r, false, tid); continue; } r -= I_OUT;
        if (r < I_UP) { wt_item(a.w_up, DM, FF, (bf16*)(a.ws + WS_WUP), 64, r, false, tid); continue; } r -= I_UP;
        wt_item(a.w_down, FF, DM, (bf16*)(a.ws + WS_WDN), 16, r, false, tid);
    }
    bf16* XN = (bf16*)(a.ws + WS_XN);
    for (int m = bx * 8 + wid; m < MT; m += G * 8) rms_row_to_bf16(xrow_ptr(a, m), a.norm1_w, XN + (size_t)m * DM, lane);
}

#define EPI_ROW(u, ai, m) ((u).pm * 256 + (ai) * 128 + wr * 64 + (m) * 16 + fr)
#define EPI_CB(bj) ((bj) * 128 + wc * 32 + 8 * fq)
__device__ __forceinline__ u32x4 pack8(const f32x4 v0, const f32x4 v1) { u32x4 w; w.x = pk2(v0[0], v0[1]); w.y = pk2(v0[2], v0[3]); w.z = pk2(v1[0], v1[1]); w.w = pk2(v1[2], v1[3]); return w; }

struct EpiP1 {
    static constexpr bool PERM = true, AFTER_DRAIN = false;
    bf16* Z; bf16* XBC; float* logf_ws; float* dt_ws; float* out; const float* b_f; const float* dt_bias;
    __device__ __forceinline__ void operator()(const pg8::f32x4 (&acc)[2][2][4][2], const pg8::Unit& u, int wr, int wc, int fr, int fq) const {
        const int pn = u.pn;
        if (pn < 24) {
            bf16* base; int ldc, colt;
            if (pn < 8) { base = Z; ldc = DI; colt = pn * 256; } else { base = XBC; ldc = CONVD; colt = (pn - 8) * 256; }
#pragma unroll
            for (int ai = 0; ai < 2; ++ai)
#pragma unroll
                for (int m = 0; m < 4; ++m) { const int row = EPI_ROW(u, ai, m);
#pragma unroll
                    for (int bj = 0; bj < 2; ++bj) *(u32x4*)(base + (size_t)row * ldc + colt + EPI_CB(bj)) = pack8(acc[ai][bj][m][0], acc[ai][bj][m][1]);
                }
        } else if (wc < 2) {
#pragma unroll
            for (int ai = 0; ai < 2; ++ai)
#pragma unroll
                for (int m = 0; m < 4; ++m) { const int row = EPI_ROW(u, ai, m);
#pragma unroll
                    for (int n = 0; n < 2; ++n)
#pragma unroll
                        for (int i = 0; i < 4; ++i) { const int c = 32 * wc + 8 * fq + 4 * n + i; const float v = acc[ai][0][m][n][i];
                            if (c < 16) logf_ws[(size_t)row * 16 + c] = v; else if (c < 48) dt_ws[(size_t)row * 32 + (c - 16)] = v; }
                }
        }
    }
};

struct EpiP3 {
    static constexpr bool PERM = true, AFTER_DRAIN = false;
    bf16* QB; bf16* KB; bf16* VB; bf16* SGA; bf16* SGS; float* out; const float* qw; const float* kw;
    __device__ __forceinline__ void operator()(const pg8::f32x4 (&acc)[2][2][4][2], const pg8::Unit& u, int wr, int wc, int fr, int fq) const {
        const int pn = u.pn;
        if (pn < 8) {
            const bool isk = pn >= 4; const int head = 4 * (pn & 3) + wc; const float* nw = isk ? kw : qw;
            f32x4 wv[2][2];
#pragma unroll
            for (int bj = 0; bj < 2; ++bj)
#pragma unroll
                for (int n = 0; n < 2; ++n) wv[bj][n] = *(const f32x4*)(nw + 32 * bj + 8 * fq + 4 * n);
#pragma unroll
            for (int ai = 0; ai < 2; ++ai)
#pragma unroll
                for (int m = 0; m < 4; ++m) { const int row = EPI_ROW(u, ai, m); float ss = 0.f;
#pragma unroll
                    for (int bj = 0; bj < 2; ++bj)
#pragma unroll
                        for (int n = 0; n < 2; ++n) { const f32x4 x = acc[ai][bj][m][n]; ss += (x[0] * x[0] + x[1] * x[1]) + (x[2] * x[2] + x[3] * x[3]); }
                    ss += __shfl_xor(ss, 16); ss += __shfl_xor(ss, 32);
                    const float rstd = rsqrtf(ss * (1.f / 64.f) + EPS), sc = isk ? rstd : rstd * QSCALE;
                    float* ko = (row < MP) ? out + O_KP + (size_t)row * DM : out + O_KS + (size_t)(row - MP) * DM;
#pragma unroll
                    for (int bj = 0; bj < 2; ++bj) { const f32x4 v0 = acc[ai][bj][m][0] * wv[bj][0] * sc, v1 = acc[ai][bj][m][1] * wv[bj][1] * sc; const int col = head * 64 + 32 * bj + 8 * fq;
                        *(u32x4*)((isk ? KB : QB) + (size_t)row * DM + col) = pack8(v0, v1);
                        if (isk) { *(f32x4*)(ko + col) = v0; *(f32x4*)(ko + col + 4) = v1; } }
                }
        } else if (pn < 12) {
#pragma unroll
            for (int ai = 0; ai < 2; ++ai)
#pragma unroll
                for (int m = 0; m < 4; ++m) { const int row = EPI_ROW(u, ai, m); float* vo = (row < MP) ? out + O_VP + (size_t)row * DM : out + O_VS + (size_t)(row - MP) * DM;
#pragma unroll
                    for (int bj = 0; bj < 2; ++bj) { const int col = (pn - 8) * 256 + EPI_CB(bj); *(u32x4*)(VB + (size_t)row * DM + col) = pack8(acc[ai][bj][m][0], acc[ai][bj][m][1]);
                        *(f32x4*)(vo + col) = acc[ai][bj][m][0]; *(f32x4*)(vo + col + 4) = acc[ai][bj][m][1]; } }
        } else {
            bf16* G = pn < 16 ? SGA : SGS; const int colt = ((pn - 12) & 3) * 256;
#pragma unroll
            for (int ai = 0; ai < 2; ++ai)
#pragma unroll
                for (int m = 0; m < 4; ++m) { const int row = EPI_ROW(u, ai, m);
#pragma unroll
                    for (int bj = 0; bj < 2; ++bj) { f32x4 v0 = acc[ai][bj][m][0], v1 = acc[ai][bj][m][1];
#pragma unroll
                        for (int i = 0; i < 4; ++i) { v0[i] = sigmoidf_(v0[i]); v1[i] = sigmoidf_(v1[i]); }
                        *(u32x4*)(G + (size_t)row * DM + colt + EPI_CB(bj)) = pack8(v0, v1); } }
        }
    }
};

template <int MODE> struct EpiGate {
    static constexpr bool PERM = true, AFTER_DRAIN = false;
    const bf16* G; const bf16* T; bf16* O;
    __device__ __forceinline__ void operator()(const pg8::f32x4 (&acc)[2][2][4][2], const pg8::Unit& u, int wr, int wc, int fr, int fq) const {
#pragma unroll
        for (int ai = 0; ai < 2; ++ai)
#pragma unroll
            for (int m = 0; m < 4; ++m) { const int row = EPI_ROW(u, ai, m);
#pragma unroll
                for (int bj = 0; bj < 2; ++bj) { const size_t off = (size_t)row * DM + u.pn * 256 + EPI_CB(bj); const u32x4 g = *(const u32x4*)(G + off);
                    f32x4 v0 = acc[ai][bj][m][0], v1 = acc[ai][bj][m][1];
                    v0[0] *= bflo(g.x); v0[1] *= bfhi(g.x); v0[2] *= bflo(g.y); v0[3] *= bfhi(g.y); v1[0] *= bflo(g.z); v1[1] *= bfhi(g.z); v1[2] *= bflo(g.w); v1[3] *= bfhi(g.w);
                    if (MODE == 1) { const u32x4 t = *(const u32x4*)(T + off);
                        v0[0] += bflo(t.x); v0[1] += bfhi(t.x); v0[2] += bflo(t.y); v0[3] += bfhi(t.y); v1[0] += bflo(t.z); v1[1] += bfhi(t.z); v1[2] += bflo(t.w); v1[3] += bfhi(t.w); }
                    *(u32x4*)(O + off) = pack8(v0, v1); } }
    }
};

struct EpiRes {
    static constexpr bool PERM = true, AFTER_DRAIN = false;
    const float* xp; const float* xs; float* out; int xin; bf16* xw; const float* nw; float* part;
    __device__ __forceinline__ void operator()(const pg8::f32x4 (&acc)[2][2][4][2], const pg8::Unit& u, int wr, int wc, int fr, int fq) const {
#pragma unroll
        for (int ai = 0; ai < 2; ++ai)
#pragma unroll
            for (int m = 0; m < 4; ++m) { const int row = EPI_ROW(u, ai, m);
                const float* b = xin ? ((row < MP) ? xp + (size_t)row * DM : xs + (size_t)(row - MP) * DM) : out + (size_t)row * DM; float* o = out + (size_t)row * DM; float ss = 0.f;
#pragma unroll
                for (int bj = 0; bj < 2; ++bj) { const int col = u.pn * 256 + EPI_CB(bj); const f32x4 b0 = *(const f32x4*)(b + col), b1 = *(const f32x4*)(b + col + 4);
                    const f32x4 v0 = b0 + acc[ai][bj][m][0], v1 = b1 + acc[ai][bj][m][1];
                    *(f32x4*)(o + col) = v0; *(f32x4*)(o + col + 4) = v1;
                    if (xw) { const f32x4 w0 = *(const f32x4*)(nw + col), w1 = *(const f32x4*)(nw + col + 4); *(u32x4*)(xw + (size_t)row * DM + col) = pack8(v0 * w0, v1 * w1);
                        ss += (v0[0] * v0[0] + v0[1] * v0[1]) + (v0[2] * v0[2] + v0[3] * v0[3]) + (v1[0] * v1[0] + v1[1] * v1[1]) + (v1[2] * v1[2] + v1[3] * v1[3]); } }
                if (xw) { ss += __shfl_xor(ss, 16); ss += __shfl_xor(ss, 32); if (fq == 0) part[(size_t)row * 16 + u.pn * 4 + wc] = ss; } }
    }
};

struct EpiRelu2 {
    static constexpr bool PERM = true, AFTER_DRAIN = false;
    bf16* O; int ldc; const float* part;
    __device__ __forceinline__ void operator()(const pg8::f32x4 (&acc)[2][2][4][2], const pg8::Unit& u, int wr, int wc, int fr, int fq) const {
#pragma unroll
        for (int ai = 0; ai < 2; ++ai)
#pragma unroll
            for (int m = 0; m < 4; ++m) { const int row = EPI_ROW(u, ai, m); const f32x4* pp = (const f32x4*)(part + (size_t)row * 16);
                const f32x4 s4 = (pp[0] + pp[1]) + (pp[2] + pp[3]); const float rstd = rsqrtf(((s4[0] + s4[1]) + (s4[2] + s4[3])) * (1.f / DM) + EPS);
#pragma unroll
                for (int bj = 0; bj < 2; ++bj) { f32x4 v0 = acc[ai][bj][m][0], v1 = acc[ai][bj][m][1];
#pragma unroll
                    for (int i = 0; i < 4; ++i) { const float a0 = fmaxf(v0[i], 0.f) * rstd, a1 = fmaxf(v1[i], 0.f) * rstd; v0[i] = a0 * a0; v1[i] = a1 * a1; }
                    *(u32x4*)(O + (size_t)row * ldc + u.pn * 256 + EPI_CB(bj)) = pack8(v0, v1); } }
    }
};

template <class Epi> __device__ __forceinline__ void run_gemm(LAS unsigned char* lds, const bf16* A, const bf16* Bt, int N, int K, const Epi& E, int M = MT) {
    pg8::Gemm g{A, Bt, M, N, K}; pg8::StaticOrder S; S.init(M, N, (int)gridDim.x, (int)blockIdx.x);
    pg8::gemm_phase<Epi, pg8::StaticOrder, true, true>(lds, g, S, E);
}
template <int MODE, int NCB = 16> __device__ __forceinline__ void mini_gemm(const Args& a, LAS unsigned char* lds, const bf16* A, const bf16* Bt, const int K, const bf16* Gt, const bf16* T, bf16* O, bf16* XW, float* part) {
    const int tid = threadIdx.x, lane = tid & 63, wid = __builtin_amdgcn_readfirstlane(tid >> 6), fr = lane & 15, fq = lane >> 4;
    LAS float* RED = (LAS float*)lds;
    typedef float f32x2v __attribute__((ext_vector_type(2)));
    for (int pc = blockIdx.x; pc < 16 * NCB; pc += gridDim.x) {
        const int row0 = MP + 16 * (pc / NCB), col0 = 64 * (pc % NCB), KS = K >> 8;
        f32x4 acc[4];
#pragma unroll
        for (int ct = 0; ct < 4; ++ct) acc[ct] = (f32x4){0.f, 0.f, 0.f, 0.f};
        const bf16* ap = A + (size_t)(row0 + fr) * K + (size_t)wid * (K >> 3) + 8 * fq;
        const bf16* bp = Bt + (size_t)(col0 + fr) * K + (size_t)wid * (K >> 3) + 8 * fq;
        for (int s0 = 0; s0 < KS; s0 += 4) {
            bf16x8 av[4], bv[4][4];
#pragma unroll
            for (int s = 0; s < 4; ++s) { av[s] = *(const bf16x8*)(ap + (s0 + s) * 32);
#pragma unroll
                for (int ct = 0; ct < 4; ++ct) bv[s][ct] = *(const bf16x8*)(bp + (size_t)(16 * ct) * K + (s0 + s) * 32); }
#pragma unroll
            for (int s = 0; s < 4; ++s)
#pragma unroll
                for (int ct = 0; ct < 4; ++ct) acc[ct] = __builtin_amdgcn_mfma_f32_16x16x32_bf16(bv[s][ct], av[s], acc[ct], 0, 0, 0);
        }
#pragma unroll
        for (int ct = 0; ct < 4; ++ct) *(LAS f32x4*)(RED + (wid * 16 + fr) * 64 + 16 * ct + 4 * fq) = acc[ct];
        __syncthreads();
        const int r = tid >> 5, c2 = (tid & 31) * 2; float v0 = 0.f, v1 = 0.f;
#pragma unroll
        for (int w = 0; w < 8; ++w) { const f32x2v t = *(const LAS f32x2v*)(RED + (w * 16 + r) * 64 + c2); v0 += t.x; v1 += t.y; }
        const int row = row0 + r, col = col0 + c2; const size_t off = (size_t)row * DM + col;
        if (MODE == 0 || MODE == 1) { const unsigned g = *(const unsigned*)(Gt + off); v0 *= bflo(g); v1 *= bfhi(g);
            if (MODE == 1) { const unsigned t = *(const unsigned*)(T + off); v0 += bflo(t); v1 += bfhi(t); }
            *(unsigned*)(O + off) = pk2(v0, v1); }
        if (MODE == 2) { const f32x2v x = *(const f32x2v*)(a.x_sample + (size_t)(row - MP) * DM + col), w = *(const f32x2v*)(a.norm2_w + col); v0 += x.x; v1 += x.y;
            *(f32x2v*)(a.out + off) = (f32x2v){v0, v1}; *(unsigned*)(XW + off) = pk2(v0 * w.x, v1 * w.y);
            float ss = v0 * v0 + v1 * v1;
#pragma unroll
            for (int o = 1; o < 32; o <<= 1) ss += __shfl_xor(ss, o);
            if ((tid & 31) == 0) part[(size_t)row * 16 + (pc & 15)] = ss; }
        if (MODE == 3) { f32x2v y = *(const f32x2v*)(a.out + off); y.x += v0; y.y += v1; *(f32x2v*)(a.out + off) = y; }
        if (MODE == 4) { const f32x4* pp = (const f32x4*)(part + (size_t)row * 16); const f32x4 s4 = (pp[0] + pp[1]) + (pp[2] + pp[3]); const float rstd = rsqrtf(((s4[0] + s4[1]) + (s4[2] + s4[3])) * (1.f / DM) + EPS);
            const float a0 = fmaxf(v0, 0.f) * rstd, a1 = fmaxf(v1, 0.f) * rstd; *(unsigned*)(O + (size_t)row * (64 * NCB) + col) = pk2(a0 * a0, a1 * a1); }
        __syncthreads();
    }
}

__device__ __forceinline__ float logf_at(const Args& a, const float* LOGF, int smp, int b, int t, int h, float bf) {
    if (smp) return t < PAST ? a.cache_logf[((size_t)b * PAST + t) * 16 + h] : -softplusf_(-(LOGF[((size_t)MP + b * TS + (t - PAST)) * 16 + h] + bf));
    return -softplusf_(-(LOGF[((size_t)b * TP + t) * 16 + h] + bf));
}
constexpr size_t WS_BTOT = WS_SEGDEC + 8192;
__device__ __forceinline__ void cumsum_item(const Args& a, LAS unsigned char* lds, int item) {
    const int tid = threadIdx.x, h = tid & 15, j = tid >> 4;
    LAS float* S = (LAS float*)lds;
    const float* LOGF = (const float*)(a.ws + WS_LOGF);
    const int smp = item >= NBP * 16; const int b = smp ? (item - NBP * 16) / 5 : item >> 4, blk = smp ? (item - NBP * 16) % 5 : item & 15;
    const int sl = smp ? 13 : 16, t0 = blk * 32 * sl;
    float* dst = smp ? (float*)(a.ws + WS_CUMS) + (size_t)b * SKV * 16 : (float*)(a.ws + WS_CUMP) + (size_t)b * TP * 16;
    const float bf = a.b_f[h];
    float off = 0.f;
    const int nit = smp ? (t0 >> 5) : 0;
    for (int i0 = 0; i0 < nit; i0 += 8) { float pv[8];
#pragma unroll
        for (int u = 0; u < 8; ++u) pv[u] = (i0 + u < nit) ? logf_at(a, LOGF, smp, b, j + 32 * (i0 + u), h, bf) : 0.f;
#pragma unroll
        for (int u = 0; u < 8; ++u) off += pv[u]; }
    float v[16]; float s = 0.f;
#pragma unroll
    for (int i = 0; i < 16; ++i) { v[i] = (i < sl) ? logf_at(a, LOGF, smp, b, t0 + j * sl + i, h, bf) : 0.f; s += v[i]; }
    S[j * 16 + h] = off; S[512 + j * 16 + h] = s; __syncthreads();
    float run = 0.f;
    for (int k = 0; k < 32; ++k) run += S[k * 16 + h];
    for (int k = 0; k < j; ++k) run += S[512 + k * 16 + h];
#pragma unroll
    for (int i = 0; i < 16; ++i) if (i < sl) { const int t = t0 + j * sl + i; run += v[i]; if (smp) dst[(size_t)t * 16 + h] = run; else dst[((size_t)h * TP) + t] = run;
        if (!smp) a.out[O_LP + ((size_t)b * TP + t) * 16 + h] = v[i]; else if (t >= PAST) a.out[O_LS + ((size_t)b * TS + (t - PAST)) * 16 + h] = v[i]; }
    if (j == 31) ((float*)(a.ws + WS_BTOT))[item * 16 + h] = run;
    __syncthreads();
}
__device__ __forceinline__ void cumsum_fixup(const Args& a, LAS unsigned char* lds) {
    const int tid = threadIdx.x;
    LAS float* OFF = (LAS float*)lds;
    const float* BT = (const float*)(a.ws + WS_BTOT);
    for (int e = tid; e < NBP * 16 * 16; e += 512) { const int blk = (e >> 4) & 15; float o = 0.f;
        for (int k = 0; k < blk; ++k) o += BT[e - 16 * (blk - k)];
        OFF[e] = o; }
    __syncthreads();
    float* CP = (float*)(a.ws + WS_CUMP);
    for (int e = blockIdx.x * 512 + tid; e < NBP * 16 * TP; e += gridDim.x * 512) CP[e] = -(CP[e] + OFF[((((e >> 17) << 4) + ((e >> 9) & 15)) << 4) + ((e >> 13) & 15)]) * LOG2E;
    __syncthreads();
}
__device__ __forceinline__ void phase_gate_norm(const Args& a) {
    const int tid = threadIdx.x, lane = tid & 63, wid = tid >> 6, G = gridDim.x;
    bf16* Z = (bf16*)(a.out + O_Y); const bf16* YR = (const bf16*)(a.ws + WS_BIG);
    for (int m = blockIdx.x * 8 + wid; m < MT; m += G * 8) {
#pragma unroll 2
        for (int gi = 0; gi < 8; ++gi) { const size_t off = (size_t)m * DI + gi * 256 + 4 * lane;
            const u32x2 yr = *(const u32x2*)(YR + off), zz = *(const u32x2*)(Z + off); const f32x4 wv = *(const f32x4*)(a.ssm_norm_w + gi * 256 + 4 * lane);
            float y[4] = {bflo(yr.x), bfhi(yr.x), bflo(yr.y), bfhi(yr.y)}; const float z[4] = {bflo(zz.x), bfhi(zz.x), bflo(zz.y), bfhi(zz.y)};
            float ss = 0.f;
#pragma unroll
            for (int i = 0; i < 4; ++i) { y[i] = y[i] * z[i] * sigmoidf_(z[i]); ss += y[i] * y[i]; }
            const float rstd = rsqrtf(wave_sum(ss) * (1.f / 256.f) + EPS);
            u32x2 o; o.x = pk2(y[0] * rstd * wv.x, y[1] * rstd * wv.y); o.y = pk2(y[2] * rstd * wv.z, y[3] * rstd * wv.w); *(u32x2*)(Z + off) = o; }
    }
}
#ifndef ATT_THRL
#define ATT_THRL 90
#endif
#include <hip/hip_bf16.h>
namespace attn_body {
using bf16=__hip_bfloat16;
using bf16x8=__attribute__((ext_vector_type(8)))short;
using s16x4=__attribute__((ext_vector_type(4)))short;
using f32x16=__attribute__((ext_vector_type(16)))float;
using u32x4=__attribute__((ext_vector_type(4)))unsigned;
constexpr int BATCH=4,NHEAD=16,SEQ=8192,D=64,DM=NHEAD*D;
constexpr int NW=8,QBLK=32,QB=QBLK*NW,KVBLK=64,NQB=SEQ/QB;
constexpr int ATTN_PITCH=DM, ATTN_UNIT_ROWS=QB;
__device__ __forceinline__ int crow(int r,int hi){return (r&3)+8*(r>>2)+4*hi;}
#define SBAR() __builtin_amdgcn_sched_barrier(0)
__device__ __forceinline__ void cmask(f32x16&p0,f32x16&p1,int jb,int qrel,int hi){
  const float NEG=-INFINITY; int kb=64*jb+4*hi;
  #pragma unroll
  for(int r=0;r<16;++r){int kv=kb+(r&3)+8*(r>>2); if(kv>qrel)p0[r]=NEG; if(kv+32>qrel)p1[r]=NEG;}
}

constexpr int NSLOT=3, SLOTB=8192;
constexpr int LDS_K=0, LDS_V=NSLOT*SLOTB, LDS_WS=2*NSLOT*SLOTB, LDS_OST=LDS_WS+NW*64*4, LDS_BYTES=LDS_OST+NW*4096, LDS_BIAS=86016;
constexpr float C2=0.125f*1.4426950408889634f;
__device__ __forceinline__ void glds16(const void*gsrc,unsigned lds_dst){unsigned keep;
  asm volatile("s_mov_b32 %0, m0\n\ts_mov_b32 m0, %2\n\ts_nop 0\n\tglobal_load_lds_dwordx4 %1, off\n\ts_mov_b32 m0, %0":"=&s"(keep):"v"(gsrc),"s"(lds_dst):"memory");}
__device__ __forceinline__ float max3f(float a,float b,float c){float r;asm("v_max3_f32 %0, %1, %2, %3":"=v"(r):"v"(a),"v"(b),"v"(c));return r;}
__device__ __forceinline__ float max2f(float a,float b){float r;asm("v_max_f32_e32 %0, %1, %2":"=v"(r):"v"(a),"v"(b));return r;}
__device__ __forceinline__ float fadd_s(float a,float b){float r;asm("v_add_f32_e32 %0, %1, %2":"=v"(r):"v"(a),"v"(b));return r;}
__device__ __forceinline__ float fsub_s(float a,float b){float r;asm("v_sub_f32_e32 %0, %1, %2":"=v"(r):"v"(a),"v"(b));return r;}
typedef float f32x2_t __attribute__((ext_vector_type(2))); typedef __bf16 bf16x2_t __attribute__((ext_vector_type(2)));
__device__ __forceinline__ unsigned cvtpk_s(float lo,float hi){f32x2_t v={lo,hi};bf16x2_t b=__builtin_convertvector(v,bf16x2_t);return __builtin_bit_cast(unsigned,b);}
#define WAIT_BAR(N) asm volatile("s_waitcnt vmcnt(" #N ") lgkmcnt(0)\n\ts_barrier":::"memory")

__device__ __forceinline__ void qkt(f32x16&p0,f32x16&p1,const char*Kslot,const bf16x8*qr,const f32x16&i0,const f32x16&i1,int r32,int hi){
  const char*kb=Kslot+hi*1024+r32*16;
  #pragma unroll
  for(int d0=0;d0<4;++d0){
    const bf16x8 b0=*reinterpret_cast<const bf16x8*>(kb+d0*2048);
    const bf16x8 b1=*reinterpret_cast<const bf16x8*>(kb+d0*2048+512);
    if(d0==0){p0=__builtin_amdgcn_mfma_f32_32x32x16_bf16(b0,qr[0],i0,0,0,0);p1=__builtin_amdgcn_mfma_f32_32x32x16_bf16(b1,qr[0],i1,0,0,0);}
    else{p0=__builtin_amdgcn_mfma_f32_32x32x16_bf16(b0,qr[d0],p0,0,0,0);p1=__builtin_amdgcn_mfma_f32_32x32x16_bf16(b1,qr[d0],p1,0,0,0);}}
}
typedef __attribute__((address_space(3))) const char* lds_cptr;
typedef short v4i16_t __attribute__((ext_vector_type(4)));
__device__ __forceinline__ void kload8(bf16x8*kf,lds_cptr kp){
  kf[0]=*(const __attribute__((address_space(3))) bf16x8*)(kp);      kf[1]=*(const __attribute__((address_space(3))) bf16x8*)(kp+512);
  kf[2]=*(const __attribute__((address_space(3))) bf16x8*)(kp+2048); kf[3]=*(const __attribute__((address_space(3))) bf16x8*)(kp+2560);
  kf[4]=*(const __attribute__((address_space(3))) bf16x8*)(kp+4096); kf[5]=*(const __attribute__((address_space(3))) bf16x8*)(kp+4608);
  kf[6]=*(const __attribute__((address_space(3))) bf16x8*)(kp+6144); kf[7]=*(const __attribute__((address_space(3))) bf16x8*)(kp+6656);
}
__device__ __forceinline__ void kload2(bf16x8*kf,lds_cptr kp,int j){ kf[2*j]=*(const __attribute__((address_space(3))) bf16x8*)(kp+j*2048); kf[2*j+1]=*(const __attribute__((address_space(3))) bf16x8*)(kp+j*2048+512); }
__device__ __forceinline__ s16x4 vtr(lds_cptr p){ return __builtin_bit_cast(s16x4,__builtin_amdgcn_ds_read_tr16_b64_v4i16((__attribute__((address_space(3))) v4i16_t*)p)); }
__device__ __forceinline__ float rowmax(const f32x16&p0,const f32x16&p1){
  float a=max3f(p0[0],p0[1],p1[0]),b=max3f(p0[2],p0[3],p1[1]);a=max3f(a,p1[2],p1[3]);
  #pragma unroll
  for(int r=4;r<16;r+=4){a=max3f(a,p0[r],p0[r+1]);b=max3f(b,p0[r+2],p0[r+3]);a=max3f(a,p1[r],p1[r+1]);b=max3f(b,p1[r+2],p1[r+3]);}
  const float m=max2f(a,b);
  auto rr=__builtin_amdgcn_permlane32_swap(__float_as_uint(m),__float_as_uint(m),false,false);
  return max2f(__uint_as_float(rr[0]),__uint_as_float(rr[1]));
}
__device__ __forceinline__ void pv(f32x16*o,int vb,bf16x8 pa0,bf16x8 pa1,bf16x8 pa2,bf16x8 pa3){
  #pragma unroll
  for(int d0=0;d0<2;++d0){s16x4 lo[4],hi[4];
    #pragma unroll
    for(int ks=0;ks<4;++ks){
      asm volatile("ds_read_b64_tr_b16 %0,%1 offset:%c2":"=&v"(lo[ks]):"v"(vb),"i"(d0*4096+ks*1024):"memory");
      asm volatile("ds_read_b64_tr_b16 %0,%1 offset:%c2":"=&v"(hi[ks]):"v"(vb),"i"(d0*4096+ks*1024+512):"memory");}
    asm volatile("s_waitcnt lgkmcnt(0)":::"memory");SBAR();
    #define PK(k) (bf16x8){lo[k][0],lo[k][1],lo[k][2],lo[k][3],hi[k][0],hi[k][1],hi[k][2],hi[k][3]}
    o[d0]=__builtin_amdgcn_mfma_f32_32x32x16_bf16(pa0,PK(0),o[d0],0,0,0);
    o[d0]=__builtin_amdgcn_mfma_f32_32x32x16_bf16(pa1,PK(1),o[d0],0,0,0);
    o[d0]=__builtin_amdgcn_mfma_f32_32x32x16_bf16(pa2,PK(2),o[d0],0,0,0);
    o[d0]=__builtin_amdgcn_mfma_f32_32x32x16_bf16(pa3,PK(3),o[d0],0,0,0);
    #undef PK
  }
}

#ifndef ATTN_STORE16
#define ATTN_STORE16(p,v) (*(u32x4*)(p)=(v))
#endif
template<int THRL> __device__ __forceinline__ void attn_unit(int b,int h,int qb,const bf16*Q,const bf16*__restrict__ K,const bf16*__restrict__ V,bf16*O,const float*__restrict__ BL2,char*shm){
  const int tid=threadIdx.x,lane=tid&63,r32=lane&31,hi=lane>>5; const int wid=__builtin_amdgcn_readfirstlane(tid>>6);
  const long rowbase=(long)b*SEQ; const int q0=qb*QB;
  const bf16*Qw=Q+(rowbase+q0+wid*QBLK)*DM+h*D;
  const bf16*Kh=K+rowbase*DM+h*D,*Vh=V+rowbase*DM+h*D;
  const unsigned lds0=(unsigned)(uintptr_t)shm;
  float*wsf=(float*)(shm+LDS_WS)+wid*64;
  const bf16*ksrc=Kh+(long)lane*DM+wid*8;
  const bf16*vsrc=Vh+(long)(16*(wid&3)+(lane>>2))*DM+(wid>>2)*32+(lane&3)*8;
  const unsigned kdst=lds0+LDS_K+wid*1024, vdst=lds0+LDS_V+wid*1024;
  #define DMA_K(t,slot) glds16(ksrc+(long)(t)*KVBLK*DM,(unsigned)__builtin_amdgcn_readfirstlane(kdst+(slot)))
  #define DMA_V(t,slot) glds16(vsrc+(long)(t)*KVBLK*DM,(unsigned)__builtin_amdgcn_readfirstlane(vdst+(slot)))
  const int vb0=(int)(lds0+LDS_V)+((lane>>4)&1)*32+(lane&3)*8+(4*hi+((lane&15)>>2))*64;
  const char*Kbase=shm+LDS_K; bf16x8 kf[8];
  const lds_cptr shm3=(lds_cptr)shm; const lds_cptr kp0=shm3+LDS_K+hi*1024+r32*16; const lds_cptr vp0=shm3+LDS_V+((lane>>4)&1)*32+(lane&3)*8+(4*hi+((lane&15)>>2))*64;
  const int NT=(q0+QB)/KVBLK;
  const float*blh=(const float*)(shm+LDS_BIAS)+4*hi;
  #define BINIT1(C,t,o) do{ const float*bp_=blh+64*(t)+(o); \
    _Pragma("unroll") for(int g_=0;g_<4;++g_){ typedef float f32x4_t __attribute__((ext_vector_type(4))); const f32x4_t b0_=*(const f32x4_t*)(bp_+8*g_); \
      _Pragma("unroll") for(int i_=0;i_<4;++i_){ C[4*g_+i_]=b0_[i_]-mhat; } } }while(0)
  #define BINIT(C0,C1,t) do{ BINIT1(C0,t,0); BINIT1(C1,t,32); }while(0)
  #define BG(G,C,t,o,g_) do{ if(G){ typedef float f32x4_t __attribute__((ext_vector_type(4))); const f32x4_t b0_=*(const f32x4_t*)(blh+64*(t)+(o)+8*(g_)); \
      const f32x2_t m2_={mhat,mhat}; const f32x2_t lo_=(f32x2_t){b0_[0],b0_[1]}-m2_, hi_=(f32x2_t){b0_[2],b0_[3]}-m2_; \
      C[4*(g_)]=lo_[0]; C[4*(g_)+1]=lo_[1]; C[4*(g_)+2]=hi_[0]; C[4*(g_)+3]=hi_[1]; SBAR(); } }while(0)
  DMA_K(0,0);DMA_V(0,0);DMA_K(1,SLOTB);
  { typedef float f32x4_t __attribute__((ext_vector_type(4))); float*bl=(float*)(shm+LDS_BIAS); const int nch=(q0+QB)/4;
    for(int c=tid;c<nch;c+=NW*64){ const f32x4_t v=*(const f32x4_t*)(BL2+4*c); *(f32x4_t*)(bl+4*c)=v; }
    asm volatile("s_waitcnt vmcnt(0)":::"memory"); }
  bf16x8 qr[4];
  #pragma unroll
  for(int d0=0;d0<4;++d0)qr[d0]=*reinterpret_cast<const bf16x8*>(&Qw[(long)r32*DM+d0*16+hi*8]);
  float mhat=0.f,l_reg=0.f;f32x16 o[2];o[0]=f32x16{};o[1]=f32x16{};
  const int qrel=wid*QBLK+r32;
  #define CMASK(P0,P1,t) do{int jb_=(t)-(NT-4); if(jb_>=0)cmask(P0,P1,jb_,qrel,hi);}while(0)
  bool resc=false;
  #define START(P0,P1) do{ const float rm=rowmax(P0,P1); resc=false; \
    { const float dl=rm; mhat=fadd_s(mhat,dl); \
      _Pragma("unroll") for(int r=0;r<16;++r){P0[r]=fsub_s(P0[r],dl);P1[r]=fsub_s(P1[r],dl);} } \
    _Pragma("unroll") for(int r=0;r<16;++r)P0[r]=__builtin_amdgcn_exp2f(P0[r]); }while(0)
  #define RESC() do{ if(resc){ asm volatile("s_waitcnt lgkmcnt(0)":::"memory"); \
      _Pragma("unroll") for(int d_=0;d_<2;++d_) _Pragma("unroll") for(int r=0;r<16;++r)o[d_][r]*=wsf[crow(r,hi)]; } }while(0)
  f32x16 pA0,pA1,pB0,pB1;
  int sl_prev=0,sl_cur=0,sl_next=SLOTB;
  #define ROT() do{sl_prev=sl_cur;sl_cur=sl_next;sl_next=(sl_next==(NSLOT-1)*SLOTB)?0:sl_next+SLOTB;}while(0)
  DMA_K(2,2*SLOTB);
  WAIT_BAR(3);
  { f32x16 i0_,i1_; BINIT(i0_,i1_,0); qkt(pA0,pA1,Kbase,qr,i0_,i1_,r32,hi); } asm volatile("s_nop 15\n\ts_nop 7":"+v"(pA0),"+v"(pA1));CMASK(pA0,pA1,0);
  START(pA0,pA1);
  _Pragma("unroll") for(int r=0;r<16;++r)pA1[r]=__builtin_amdgcn_exp2f(pA1[r]);
  WAIT_BAR(0);
  DMA_K(3,0);DMA_V(1,SLOTB);
  ROT();
  kload8(kf,kp0+sl_cur);
  WAIT_BAR(2);
  s16x4 vlo[8],vhi[8]; u32x4 pw0,pw1,pw2,pw3;
  #define PKW(P,B) cvtpk_s(P[B],P[B+1])
  #define PAF(k) __builtin_bit_cast(bf16x8,pw##k)
  #define VFR(i) (bf16x8){vlo[i][0],vlo[i][1],vlo[i][2],vlo[i][3],vhi[i][0],vhi[i][1],vhi[i][2],vhi[i][3]}
  #define PIN(x) asm volatile("":"+v"(x))
  #define MX3(a,b,c) __builtin_fmaxf(__builtin_fmaxf((a),(b)),(c))
  #define GAPA(MF,A0,A1,A2,A3,W0,W1,PW) do{ MF; sacc+=A0; sacc+=A1; sacc+=A2; sacc+=A3; PIN(sacc); W0; W1; PIN(PW); SBAR(); }while(0)
  #define EX(v) __builtin_amdgcn_exp2f(v)
  #define GAPB(MF,X,B) do{ MF; X[B]=EX(X[B]); X[B+1]=EX(X[B+1]); X[B+2]=EX(X[B+2]); X[B+3]=EX(X[B+3]); PIN(X); SBAR(); }while(0)
  #define VRD(i) do{ vlo[i]=vtr(vp_+(((i)>>2)*4096+((i)&3)*1024)); vhi[i]=vtr(vp_+(((i)>>2)*4096+((i)&3)*1024+512)); }while(0)
  #define KRD(G,j) do{ if(G){ kload2(kf,kp0+sl_next,j); SBAR(); } }while(0)
  #define STEP(C0,C1,P0,P1,t,GK,GV,GL) do{ SBAR(); \
    const lds_cptr vp_=vp0+sl_prev; \
    VRD(0); SBAR(); float sacc=(P0[0]+P0[1]); \
    GAPA(C0=__builtin_amdgcn_mfma_f32_32x32x16_bf16(kf[0],qr[0],C0,0,0,0), P0[2],P0[3],P0[4],P0[5],     pw0[0]=PKW(P0,0), pw0[1]=PKW(P0,2), pw0); \
    VRD(4); SBAR(); GAPA(C1=__builtin_amdgcn_mfma_f32_32x32x16_bf16(kf[1],qr[0],C1,0,0,0), P0[6],P0[7],P0[8],P0[9],     pw0[2]=PKW(P0,4), pw0[3]=PKW(P0,6), pw0); \
    VRD(1); SBAR(); GAPA(C0=__builtin_amdgcn_mfma_f32_32x32x16_bf16(kf[2],qr[1],C0,0,0,0),   P0[10],P0[11],P0[12],P0[13], pw1[0]=PKW(P0,8), pw1[1]=PKW(P0,10), pw1); \
    VRD(5); SBAR(); GAPA(C1=__builtin_amdgcn_mfma_f32_32x32x16_bf16(kf[3],qr[1],C1,0,0,0),   P0[14],P0[15],P1[0],P1[1],   pw1[2]=PKW(P0,12),pw1[3]=PKW(P0,14), pw1); \
    VRD(2); SBAR(); GAPA(C0=__builtin_amdgcn_mfma_f32_32x32x16_bf16(kf[4],qr[2],C0,0,0,0),   P1[2],P1[3],P1[4],P1[5],     pw2[0]=PKW(P1,0), pw2[1]=PKW(P1,2), pw2); \
    VRD(6); SBAR(); GAPA(C1=__builtin_amdgcn_mfma_f32_32x32x16_bf16(kf[5],qr[2],C1,0,0,0),   P1[6],P1[7],P1[8],P1[9],     pw2[2]=PKW(P1,4), pw2[3]=PKW(P1,6), pw2); \
    VRD(3); SBAR(); GAPA(C0=__builtin_amdgcn_mfma_f32_32x32x16_bf16(kf[6],qr[3],C0,0,0,0),   P1[10],P1[11],P1[12],P1[13], pw3[0]=PKW(P1,8), pw3[1]=PKW(P1,10), pw3); \
    VRD(7); SBAR(); GAPA(C1=__builtin_amdgcn_mfma_f32_32x32x16_bf16(kf[7],qr[3],C1,0,0,0),   P1[14],P1[15],0.f,0.f,       pw3[2]=PKW(P1,12),pw3[3]=PKW(P1,14), pw3); \
    l_reg+=sacc; \
    if(GK){DMA_K((t)+3,sl_cur);} if(GV){DMA_V((t)+1,sl_next);} \
    CMASK(C0,C1,t); \
    { float a=MX3(C0[0],C0[1],C1[0]),b=MX3(C0[2],C0[3],C1[1]); a=MX3(a,C1[2],C1[3]); \
      _Pragma("unroll") for(int r=4;r<16;r+=4){a=MX3(a,C0[r],C0[r+1]);b=MX3(b,C0[r+2],C0[r+3]);a=MX3(a,C1[r],C1[r+1]);b=MX3(b,C1[r+2],C1[r+3]);} \
      float rm=__builtin_fmaxf(a,b); { auto rr=__builtin_amdgcn_permlane32_swap(__float_as_uint(rm),__float_as_uint(rm),false,false); rm=__builtin_fmaxf(__uint_as_float(rr[0]),__uint_as_float(rr[1])); } \
      resc=false; \
      if(__builtin_expect(__any(rm>(float)THRL),0)){ const float dl=__builtin_fmaxf(rm,0.f); mhat+=dl; \
        _Pragma("unroll") for(int r=0;r<16;++r){C0[r]-=dl;C1[r]-=dl;} \
        const float f=__builtin_amdgcn_exp2f(-dl); l_reg*=f; if(hi==0)wsf[r32]=f; resc=true; } } \
    SBAR(); \
    GAPB(o[0]=__builtin_amdgcn_mfma_f32_32x32x16_bf16(PAF(0),VFR(0),o[0],0,0,0), C0,0); BG(GL,P0,(t)+1,0,0); \
    GAPB(o[1]=__builtin_amdgcn_mfma_f32_32x32x16_bf16(PAF(0),VFR(4),o[1],0,0,0), C0,4); BG(GL,P0,(t)+1,0,1); \
    KRD(GL,0); GAPB(o[0]=__builtin_amdgcn_mfma_f32_32x32x16_bf16(PAF(1),VFR(1),o[0],0,0,0), C0,8); BG(GL,P0,(t)+1,0,2); \
    KRD(GL,1); GAPB(o[1]=__builtin_amdgcn_mfma_f32_32x32x16_bf16(PAF(1),VFR(5),o[1],0,0,0), C0,12); BG(GL,P0,(t)+1,0,3); \
    KRD(GL,2); GAPB(o[0]=__builtin_amdgcn_mfma_f32_32x32x16_bf16(PAF(2),VFR(2),o[0],0,0,0), C1,0); BG(GL,P1,(t)+1,32,0); \
    KRD(GL,3); GAPB(o[1]=__builtin_amdgcn_mfma_f32_32x32x16_bf16(PAF(2),VFR(6),o[1],0,0,0), C1,4); BG(GL,P1,(t)+1,32,1); \
    GAPB(o[0]=__builtin_amdgcn_mfma_f32_32x32x16_bf16(PAF(3),VFR(3),o[0],0,0,0), C1,8); BG(GL,P1,(t)+1,32,2); \
    GAPB(o[1]=__builtin_amdgcn_mfma_f32_32x32x16_bf16(PAF(3),VFR(7),o[1],0,0,0), C1,12); BG(GL,P1,(t)+1,32,3); \
    }while(0)
  int t=1;
  BINIT(pB0,pB1,1);
  #undef CMASK
  #define CMASK(P0,P1,t) do{}while(0)
  for(;t+5<NT;t+=2){
    STEP(pB0,pB1,pA0,pA1,t,true,true,true);     WAIT_BAR(2); RESC(); ROT();
    STEP(pA0,pA1,pB0,pB1,t+1,true,true,true);   WAIT_BAR(2); RESC(); ROT();
  }
  #undef CMASK
  #define CMASK(P0,P1,t) do{int jb_=(t)-(NT-4); if(jb_>=0)cmask(P0,P1,jb_,qrel,hi);}while(0)
  #define ENDW(tt) do{ if((tt)+3<NT){WAIT_BAR(2);} else if((tt)+2<NT){WAIT_BAR(1);} else {WAIT_BAR(0);} }while(0)
  for(;t+1<NT;t+=2){
    STEP(pB0,pB1,pA0,pA1,t,(t+3<NT),(t+1<NT),(t+1<NT));       ENDW(t);   RESC(); ROT();
    STEP(pA0,pA1,pB0,pB1,t+1,(t+4<NT),(t+2<NT),(t+2<NT));     ENDW(t+1); RESC(); ROT();
  }
  STEP(pB0,pB1,pA0,pA1,NT-1,false,false,false); RESC();
  { float sacc=pB0[0]+pB0[1]; _Pragma("unroll") for(int r=2;r<16;++r)sacc+=pB0[r]; _Pragma("unroll") for(int r=0;r<16;++r)sacc+=pB1[r]; l_reg+=sacc;
    pw0=(u32x4){PKW(pB0,0),PKW(pB0,2),PKW(pB0,4),PKW(pB0,6)};pw1=(u32x4){PKW(pB0,8),PKW(pB0,10),PKW(pB0,12),PKW(pB0,14)};pw2=(u32x4){PKW(pB1,0),PKW(pB1,2),PKW(pB1,4),PKW(pB1,6)};pw3=(u32x4){PKW(pB1,8),PKW(pB1,10),PKW(pB1,12),PKW(pB1,14)};
    SBAR(); pv(o,vb0+sl_cur,PAF(0),PAF(1),PAF(2),PAF(3)); }
  #undef PKW
  #undef PAF
  #undef VFR
  #undef PIN
  #undef MX3
  #undef GAPA
  #undef GAPB
  #undef EX
  #undef VRD
  #undef KRD
  #undef STEP
  #undef ENDW
  {auto rr=__builtin_amdgcn_permlane32_swap(__float_as_uint(l_reg),__float_as_uint(l_reg),false,false);l_reg=__uint_as_float(rr[0])+__uint_as_float(rr[1]);}
  if(hi==0)wsf[32+r32]=l_reg;asm volatile("s_waitcnt lgkmcnt(0)":::"memory");
  float rli[16];
  #pragma unroll
  for(int r=0;r<16;++r)rli[r]=__builtin_amdgcn_rcpf(wsf[32+crow(r,hi)]);
  bf16*Ow=O+(rowbase+q0+wid*QBLK)*DM+h*D;
  { bf16*stg=(bf16*)(shm+LDS_OST)+wid*2048;
    #pragma unroll
    for(int r=0;r<16;++r){const int orow=crow(r,hi);
      #pragma unroll
      for(int d0=0;d0<2;++d0)stg[orow*64+d0*32+r32]=__float2bfloat16(o[d0][r]*rli[r]);}
    asm volatile("s_waitcnt lgkmcnt(0)":::"memory");
    #pragma unroll
    for(int i=0;i<4;++i){const int row=i*8+(lane>>3),ch=lane&7; const u32x4 v=*(const u32x4*)(stg+row*64+ch*8); ATTN_STORE16(Ow+(long)row*DM+ch*8,v);} }
  asm volatile("s_waitcnt lgkmcnt(0)\n\ts_barrier":::"memory");
  #undef BINIT
  #undef BINIT1
  #undef BG
  #undef DMA_K
  #undef DMA_V
  #undef CMASK
  #undef START
  #undef RESC
  #undef ROT
}
constexpr int ATTN_LDS_BYTES=LDS_BYTES;
struct AttnTensors { const bf16* Q; const bf16* K; const bf16* V; bf16* O; const float* BL2; };
struct AttnUnit { int bh; int qb; };
struct StaticOrder {
  int vcu;
  __device__ __forceinline__ explicit StaticOrder(int grid,int block):vcu((block%8)*(grid/8)+block/8){}
  __device__ __forceinline__ bool next(int i,AttnUnit&u)const{ if(i>=8)return false; const int s=vcu&7,j=i&3; u.bh=(vcu>>3)+32*(i>>2); u.qb=(j==0)?31-s:(j==1)?16+s:(j==2)?15-s:s; return true; }
  __device__ __forceinline__ void a_ready(const AttnUnit&)const{}
  __device__ __forceinline__ void done(const AttnUnit&)const{}
};
template<class Sched,int THRL=ATT_THRL> __device__ __forceinline__ void attn_phase(char*lds,const AttnTensors&T,const Sched&S){
  AttnUnit u;
  for(int i=0;S.next(i,u);++i){ S.a_ready(u); attn_unit<THRL>(u.bh/NHEAD,u.bh%NHEAD,u.qb,T.Q,T.K,T.V,T.O,T.BL2+(long)u.bh*SEQ,lds); S.done(u); }
}
#undef SBAR
#undef WAIT_BAR
}

#define XB_TMO      128
#define XB_XCNT(j)  (256  + 64 * (j))
#define XB_XSUB(j)  (1280 + 64 * (j))
#define XB_XGEN(j)  (2304 + 64 * (j))
#define XB_TOP      3328
#define XB_TOPGEN   3392
#define XCD_BAR_WORDS 3456
#define XB_SPIN_CAP (1u << 18)

__device__ __forceinline__ unsigned xb_ld(unsigned* p)              { return __hip_atomic_load(p, __ATOMIC_RELAXED, __HIP_MEMORY_SCOPE_AGENT); }
__device__ __forceinline__ unsigned xb_add(unsigned* p, unsigned v) { return __hip_atomic_fetch_add(p, v, __ATOMIC_RELAXED, __HIP_MEMORY_SCOPE_AGENT); }
__device__ __forceinline__ unsigned xb_xcc_id() { return (unsigned)__builtin_amdgcn_s_getreg((3 << 11) | 20) & 0xFu; }
#define XB_SPIN(cond, bar) do { unsigned _sp = 0; while (cond) { __builtin_amdgcn_s_sleep(1); \
    if ((++_sp & 255u) == 0u) { if (xb_ld(&(bar)[XB_TMO])) break; if (_sp > XB_SPIN_CAP) { atomicAdd(&(bar)[XB_TMO], 1u); break; } } } } while (0)

struct XcdBarrier {
    unsigned* bar; unsigned x;
    volatile LAS unsigned* st;
};

__device__ __forceinline__ XcdBarrier xcd_barrier_post(unsigned* bar, volatile LAS unsigned* st) {
    XcdBarrier b; b.bar = bar; b.x = xb_xcc_id(); b.st = st;
    if (threadIdx.x == 0) (void)xb_add(&bar[XB_XCNT(b.x)], 1u);
    return b;
}
__device__ __forceinline__ void xcd_barrier_complete(unsigned* bar, unsigned x, unsigned& nloc, unsigned& nx) {
    const unsigned G = gridDim.x * gridDim.y * gridDim.z;
    unsigned sum, cnt, mine, sp = 0u;
    for (;;) {
        sum = 0u; cnt = 0u; mine = 0u;
#pragma unroll
        for (unsigned j = 0; j < 16; ++j) { const unsigned c = xb_ld(&bar[XB_XCNT(j)]); sum += c; cnt += (c > 0u) ? 1u : 0u; mine = (j == x) ? c : mine; }
        if (sum == G) break;
        __builtin_amdgcn_s_sleep(1);
        if ((++sp & 255u) == 0u) { if (xb_ld(&bar[XB_TMO])) break; if (sp > XB_SPIN_CAP) { atomicAdd(&bar[XB_TMO], 1u); break; } }
    }
    nloc = mine > 0u ? mine : 1u; nx = cnt > 0u ? cnt : 1u;
}

__device__ __forceinline__ void xcd_barrier(const XcdBarrier& b) {
    asm volatile("s_waitcnt vmcnt(0)" ::: "memory");
    __syncthreads();
    if (threadIdx.x == 0) {
        unsigned* bar = b.bar;
        __builtin_amdgcn_s_waitcnt(0);
        unsigned nloc = b.st[0], nx = b.st[1];
        if (nloc == 0u) { xcd_barrier_complete(bar, b.x, nloc, nx); b.st[0] = nloc; b.st[1] = nx; }
        const unsigned old = xb_add(&bar[XB_XSUB(b.x)], 1u);
        const unsigned gen = old / nloc;
        if (old + 1u == (gen + 1u) * nloc) {
            __builtin_amdgcn_fence(__ATOMIC_RELEASE, "agent");
            asm volatile("s_waitcnt vmcnt(0)" ::: "memory");
            const unsigned og = xb_add(&bar[XB_TOP], 1u);
            const unsigned tg = og / nx;
            if (og + 1u == (tg + 1u) * nx) xb_add(&bar[XB_TOPGEN], 1u);
            else XB_SPIN(xb_ld(&bar[XB_TOPGEN]) == tg, bar);
            __builtin_amdgcn_fence(__ATOMIC_ACQUIRE, "agent");
            xb_add(&bar[XB_XGEN(b.x)], 1u);
            asm volatile("s_waitcnt vmcnt(0)" ::: "memory");
        } else {
            XB_SPIN(xb_ld(&bar[XB_XGEN(b.x)]) == gen, bar);
            __builtin_amdgcn_fence(__ATOMIC_ACQUIRE, "agent");
            asm volatile("s_waitcnt vmcnt(0)" ::: "memory");
        }
    }
    __syncthreads();
}


#ifndef MK_UNROLL
#define MK_UNROLL 1
#endif
#ifndef DIS
#define DIS 0
#endif
#ifndef SSD_LT_UNROLL
#define SSD_LT_UNROLL 4
#endif
#define MFMA16(A, B, C) __builtin_amdgcn_mfma_f32_16x16x32_bf16((A), (B), (C), 0, 0, 0)
#define MFMA32(A, B, C) __builtin_amdgcn_mfma_f32_32x32x16_bf16((A), (B), (C), 0, 0, 0)
__device__ __forceinline__ bf16* bcc_row(const Args& a, size_t m) { return m < (size_t)MP ? (bf16*)(a.out + O_KP) + m * 2048 : (bf16*)(a.out + O_VP) + (m - MP) * 2048; }
__device__ __forceinline__ float* segst_ptr(const Args& a) { return a.out + O_VP + (1u << 20); }

__device__ __forceinline__ void conv8x8(const u32x4 (&xr)[11], const float (&cw)[4][8], const float (&cbias)[8], int nvalid, u32x4 (&orow)[8], u32x4 (&otr)[8]) {
#pragma unroll
    for (int j2 = 0; j2 < 4; ++j2) { float xl[11], xh[11];
#pragma unroll
        for (int i = 0; i < 11; ++i) { xl[i] = bflo(xr[i][j2]); xh[i] = bfhi(xr[i][j2]); }
        float ol[8], oh[8];
#pragma unroll
        for (int tt = 0; tt < 8; ++tt) { float v0 = cbias[2 * j2] + cw[0][2 * j2] * xl[tt] + cw[1][2 * j2] * xl[tt + 1] + cw[2][2 * j2] * xl[tt + 2] + cw[3][2 * j2] * xl[tt + 3];
            float v1 = cbias[2 * j2 + 1] + cw[0][2 * j2 + 1] * xh[tt] + cw[1][2 * j2 + 1] * xh[tt + 1] + cw[2][2 * j2 + 1] * xh[tt + 2] + cw[3][2 * j2 + 1] * xh[tt + 3];
            v0 = v0 * sigmoidf_(v0); v1 = v1 * sigmoidf_(v1); if (tt >= nvalid) { v0 = 0.f; v1 = 0.f; } ol[tt] = v0; oh[tt] = v1; orow[tt][j2] = pk2(v0, v1); }
#pragma unroll
        for (int t2 = 0; t2 < 4; ++t2) { otr[2 * j2][t2] = pk2(ol[2 * t2], ol[2 * t2 + 1]); otr[2 * j2 + 1][t2] = pk2(oh[2 * t2], oh[2 * t2 + 1]); } }
}
__device__ __forceinline__ u32x4 xbc_row8(const Args& a, const bf16* XBC, size_t seqbase, int smp, int b, int ts, int cc) {
    if (ts >= 0 && (!smp || ts < TS)) return *(const u32x4*)(XBC + (seqbase + ts) * CONVD + cc);
    if (smp && ts < 0) { const float* sp = a.state_conv + ((size_t)b * 3 + (ts + 3)) * CONVD + cc; return pack8(*(const f32x4*)sp, *(const f32x4*)(sp + 4)); }
    return (u32x4){0u, 0u, 0u, 0u};
}
__device__ __forceinline__ void phase_bc_conv(const Args& a, const int do_prompt, const int sid) {
    const int tid = threadIdx.x, G = gridDim.x, cc = 8 * tid;
    const bf16* XBC = (const bf16*)(a.ws + WS_BIG); bf16* XC = (bf16*)(a.ws + WS_SG);
    float cw[4][8], cbias[8];
#pragma unroll
    for (int i = 0; i < 4; ++i)
#pragma unroll
        for (int j = 0; j < 8; ++j) cw[i][j] = a.conv_w[(size_t)i * CONVD + cc + j];
#pragma unroll
    for (int j = 0; j < 8; ++j) cbias[j] = a.conv_b[cc + j];
    const int nP = MP / 8, nS = MS / 8;
    const bool contig = (nP % G) == 0; const int per = !do_prompt ? 0 : (contig ? nP / G : (nP - (int)blockIdx.x + G - 1) / G), nsm = (sid >= 0 && sid < nS) ? 1 : 0, nst = per + nsm;
#define BCC_IT(j) ((j) < per ? (contig ? (int)blockIdx.x * per + (j) : (int)blockIdx.x + (j) * G) : nP + sid)
    u32x4 xn[11];
#define BCC_LD(itv, lo) do { const int smp_ = (itv) >= nP, to_ = smp_ ? (itv) - nP : (itv); const int b_ = smp_ ? to_ / (TS / 8) : to_ / (TP / 8), t0_ = smp_ ? (to_ % (TS / 8)) * 8 : (to_ % (TP / 8)) * 8; \
        const size_t sb_ = smp_ ? (size_t)MP + (size_t)b_ * TS : (size_t)b_ * TP; _Pragma("unroll") for (int i_ = 0; i_ < 11; ++i_) if (i_ >= (lo)) xn[i_] = xbc_row8(a, XBC, sb_, smp_, b_, t0_ - 3 + i_, cc); } while (0)
    if (nst > 0) BCC_LD(BCC_IT(0), 0);
    for (int j = 0; j < nst; ++j) {
        const int it = BCC_IT(j);
        const int smp = it >= nP; const int to = smp ? it - nP : it;
        const int b = smp ? to / (TS / 8) : to / (TP / 8), t0 = smp ? (to % (TS / 8)) * 8 : (to % (TP / 8)) * 8;
        const size_t seqbase = smp ? (size_t)MP + (size_t)b * TS : (size_t)b * TP;
        u32x4 xr[11];
#pragma unroll
        for (int i = 0; i < 11; ++i) xr[i] = xn[i];
        if (j + 1 < nst) { const int itn = BCC_IT(j + 1);
            if (contig && itn == it + 1 && (itn % (TP / 8)) != 0) { xn[0] = xr[8]; xn[1] = xr[9]; xn[2] = xr[10]; BCC_LD(itn, 3); } else BCC_LD(itn, 0); }
        u32x4 orow[8], otr[8]; conv8x8(xr, cw, cbias, 8, orow, otr);
        if (tid < 256) {
#pragma unroll
            for (int tt = 0; tt < 8; ++tt) *(u32x4*)(XC + (seqbase + t0 + tt) * 2048 + cc) = orow[tt];
        } else {
#pragma unroll
            for (int tt = 0; tt < 8; ++tt) *(u32x4*)(bcc_row(a, seqbase + t0 + tt) + (cc - 2048)) = orow[tt];
        }
        const int tl = smp ? TS : TP;
        if (t0 + 8 == tl) { float* cs = smp ? a.out + O_CS + (size_t)b * 3 * CONVD : a.out + O_CP + (size_t)b * 3 * CONVD;
#pragma unroll
            for (int i = 0; i < 3; ++i) { const u32x4 w = xr[8 + i]; float* o = cs + (size_t)i * CONVD + cc;
                *(f32x4*)o = (f32x4){bflo(w.x), bfhi(w.x), bflo(w.y), bfhi(w.y)}; *(f32x4*)(o + 4) = (f32x4){bflo(w.z), bfhi(w.z), bflo(w.w), bfhi(w.w)}; } }
    }
#undef BCC_LD
#undef BCC_IT
}

constexpr int SSD_CS = 0, SSD_BS = 17408, SSD_BT = 34816, SSD_XT = 53248, SSD_MM = 90112, SSD_FA = 126976;
__device__ __forceinline__ void ssd_item(const Args& a, LAS unsigned char* lds, const int mode, const int smp, const int b, const int seg, const int g) {
    const int tid = threadIdx.x, lane = tid & 63, wid = __builtin_amdgcn_readfirstlane(tid >> 6), fr = lane & 15, fq = lane >> 4, hh = wid >> 1, ph = wid & 1, head = 4 * g + hh;
    LAS bf16* Cs = (LAS bf16*)(lds + SSD_CS); LAS bf16* Bs = (LAS bf16*)(lds + SSD_BS); LAS bf16* BT = (LAS bf16*)(lds + SSD_BT);
    LAS bf16* XTh = (LAS bf16*)(lds + SSD_XT) + hh * 4608; LAS bf16* MMh = (LAS bf16*)(lds + SSD_MM) + hh * 4608;
    LAS float* FAh = (LAS float*)(lds + SSD_FA) + hh * 256;
    const size_t seqbase = smp ? (size_t)MP + (size_t)b * TS : (size_t)b * TP;
    const int tseg = smp ? 0 : seg * 1024, nch = smp ? 1 : 16;
    const float Dh = a.D_skip[head];
    const bf16* XBC = (const bf16*)(a.ws + WS_BIG);
    const float* DTW = (const float*)(a.ws + WS_DT);
    float* SEGST = segst_ptr(a); float* SEGDEC = (float*)(a.ws + WS_SEGDEC);
    f32x4 st[8][2];
    if (mode == 1 && smp) { const float* h0 = a.state_ssm + ((size_t)b * NHS + head) * 8192;
#pragma unroll
        for (int nt = 0; nt < 8; ++nt)
#pragma unroll
            for (int pt2 = 0; pt2 < 2; ++pt2) st[nt][pt2] = *(const f32x4*)(h0 + (32 * ph + 16 * pt2 + fr) * 128 + 16 * nt + 4 * fq);
    } else if (mode == 1) {
#pragma unroll
        for (int nt = 0; nt < 8; ++nt)
#pragma unroll
            for (int pt2 = 0; pt2 < 2; ++pt2) st[nt][pt2] = (f32x4){0.f, 0.f, 0.f, 0.f};
#pragma unroll 1
        for (int s = 0; s < seg; ++s) { const float* h0 = SEGST + (((size_t)b * 8 + s) * NHS + head) * 8192; const float dec = SEGDEC[(b * 8 + s) * NHS + head];
#pragma unroll
            for (int nt = 0; nt < 8; ++nt)
#pragma unroll
                for (int pt2 = 0; pt2 < 2; ++pt2) st[nt][pt2] = st[nt][pt2] * dec + *(const f32x4*)(h0 + (32 * ph + 16 * pt2 + fr) * 128 + 16 * nt + 4 * fq); }
    } else {
#pragma unroll
        for (int nt = 0; nt < 8; ++nt)
#pragma unroll
            for (int pt2 = 0; pt2 < 2; ++pt2) st[nt][pt2] = (f32x4){0.f, 0.f, 0.f, 0.f};
    }
    const int xco = tid & 31, xtq = (tid >> 5) & 7, bno = tid & 15, btq = (tid >> 4) & 7;
    const bool isX = tid < 256, isB = !isX && tid < 384, ldact = isX || isB || mode == 1;
    const int tq = isX ? xtq : btq;
    const bf16* rbase = isX ? (const bf16*)(a.ws + WS_SG) + (seqbase + tseg + 8 * tq) * 2048 + g * 256 + 8 * xco
                            : bcc_row(a, seqbase + tseg + 8 * tq) + (isB ? 0 : 1024) + g * 128 + 8 * bno;
    u32x4 pf[8];
#define SSD_PF(cn) do { _Pragma("unroll") for (int tt_ = 0; tt_ < 8; ++tt_) pf[tt_] = (ldact && (!smp || 8 * tq + tt_ < TS)) ? *(const u32x4*)(rbase + ((size_t)(cn) * 64 + tt_) * 2048) : (u32x4){0u, 0u, 0u, 0u}; \
        } while (0)
    SSD_PF(0);
    if (mode == 1) { for (int e = lane + 64 * ph; e < 64 * 72 / 2; e += 128) ((LAS unsigned*)MMh)[e] = 0u; }
    const float Ah = -expf(a.A_log[4 * g + (wid & 3)]), dtb = a.dt_bias[4 * g + (wid & 3)];
    float decsum = 0.f;
    bf16* ZB = (bf16*)(a.out + O_Y); LAS float* NS = (LAS float*)(lds + 131072);
    int ypend = -1;
#define SSD_YFIN() do { if (mode == 1 && ypend >= 0) { const float* nwp_ = a.ssm_norm_w + head * 64 + 32 * ph + 4 * fq; const f32x4 nw0_ = *(const f32x4*)nwp_, nw1_ = *(const f32x4*)(nwp_ + 16); \
        const float nwv[8] = {nw0_[0], nw0_[1], nw0_[2], nw0_[3], nw1_[0], nw1_[1], nw1_[2], nw1_[3]}; _Pragma("unroll") for (int lt = 0; lt < 4; ++lt) { const int l = 16 * lt + fr; float tot = 0.f; \
        _Pragma("unroll") for (int w = 0; w < 8; ++w) tot += NS[w * 64 + l]; const float rs = rsqrtf(tot * (1.f / 256.f) + EPS); \
        if (!smp || l < TS) { bf16* zo = ZB + (seqbase + ypend + l) * DI + head * 64 + 32 * ph + 4 * fq; const u32x2 g0 = *(const u32x2*)zo, g1 = *(const u32x2*)(zo + 16); \
            *(u32x2*)zo = (u32x2){pk2(bflo(g0.x) * rs * nwv[0], bfhi(g0.x) * rs * nwv[1]), pk2(bflo(g0.y) * rs * nwv[2], bfhi(g0.y) * rs * nwv[3])}; \
            *(u32x2*)(zo + 16) = (u32x2){pk2(bflo(g1.x) * rs * nwv[4], bfhi(g1.x) * rs * nwv[5]), pk2(bflo(g1.y) * rs * nwv[6], bfhi(g1.y) * rs * nwv[7])}; } } } } while (0)
    for (int c = 0; c < nch; ++c) {
        const int t0 = tseg + c * 64;
        const float dtraw = (tid >= 256 && (!smp || lane < TS)) ? DTW[(seqbase + t0 + lane) * 32 + 4 * g + (wid & 3)] : -1e30f;
        SSD_YFIN();
        if (isX || isB) {
            LAS bf16* T = isX ? (LAS bf16*)(lds + SSD_XT) + (xco >> 3) * 4608 + (8 * (xco & 7)) * 72 + 8 * tq : BT + (8 * bno) * 72 + 8 * tq;
#pragma unroll
            for (int j = 0; j < 8; ++j) { u32x4 w;
#pragma unroll
                for (int t2 = 0; t2 < 4; ++t2) { const unsigned lo = pf[2 * t2][j >> 1], hi = pf[2 * t2 + 1][j >> 1]; w[t2] = (j & 1) ? ((lo >> 16) | (hi & 0xffff0000u)) : ((lo & 0xffffu) | (hi << 16)); }
                *(LAS u32x4*)(T + j * 72) = w; }
        }
        if (!isX && mode == 1) { LAS bf16* R = isB ? Bs : Cs;
#pragma unroll
            for (int tt = 0; tt < 8; ++tt) *(LAS u32x4*)(R + (8 * tq + tt) * 136 + 8 * bno) = pf[tt]; }
        if (tid >= 256) {
            LAS float* F = (LAS float*)(lds + SSD_FA) + (wid & 3) * 256;
            const float dtv = dtraw > -1e29f ? softplusf_(dtraw + dtb) : 0.f; float av = dtv * Ah;
#pragma unroll
            for (int o = 1; o < 64; o <<= 1) { const float tv = __shfl_up(av, o); if (lane >= o) av += tv; }
            const float alast = __shfl(av, 63);
            F[lane] = dtv; F[64 + lane] = av; F[128 + lane] = __expf(av); F[192 + lane] = __expf(alast - av) * dtv; }
        if (c + 1 < nch) SSD_PF(c + 1);
        __syncthreads();
        const float acl = FAh[64 + 63]; if (mode == 0) decsum += acl;
        u32x2 zpre[4][2];
        if (mode == 1) {
#pragma unroll
            for (int lt = 0; lt < 4; ++lt) { const int l = 16 * lt + fr; if (!smp || l < TS) { const bf16* zp = ZB + (seqbase + t0 + l) * DI + head * 64 + 32 * ph + 4 * fq; zpre[lt][0] = *(const u32x2*)zp; zpre[lt][1] = *(const u32x2*)(zp + 16); } else { zpre[lt][0] = (u32x2){0u, 0u}; zpre[lt][1] = (u32x2){0u, 0u}; } }
        }
        if (mode == 1 && !(DIS & 4)) {
#pragma unroll MK_UNROLL
            for (int k = 0; k < 2; ++k) { const int lt = ph ? 1 + k : 3 * k;
_Pragma("unroll 1")
                for (int jt = 0; jt <= lt; ++jt) { f32x4 acc = {0.f, 0.f, 0.f, 0.f};
#pragma unroll
                    for (int ks = 0; ks < 4; ++ks) { const bf16x8 A = *(const LAS bf16x8*)(Cs + (16 * lt + fr) * 136 + 32 * ks + 8 * fq), B = *(const LAS bf16x8*)(Bs + (16 * jt + fr) * 136 + 32 * ks + 8 * fq); acc = MFMA16(A, B, acc); }
                    const int s = 16 * jt + fr; const float as_ = FAh[64 + s], ds = FAh[s];
#pragma unroll
                    for (int r = 0; r < 4; ++r) { const int l = 16 * lt + 4 * fq + r; float v = (l >= s) ? acc[r] * __expf(FAh[64 + l] - as_) * ds : 0.f; if (l == s) v += Dh; MMh[l * 72 + s] = (bf16)f2bf(v); } } }
            __syncthreads();
            if (!(DIS & 8)) {
            u32x2 hp[4][2][2];
#pragma unroll
            for (int kk = 0; kk < 4; ++kk)
#pragma unroll
                for (int pt2 = 0; pt2 < 2; ++pt2) { hp[kk][pt2][0] = (u32x2){pk2(st[2 * kk][pt2][0], st[2 * kk][pt2][1]), pk2(st[2 * kk][pt2][2], st[2 * kk][pt2][3])};
                    hp[kk][pt2][1] = (u32x2){pk2(st[2 * kk + 1][pt2][0], st[2 * kk + 1][pt2][1]), pk2(st[2 * kk + 1][pt2][2], st[2 * kk + 1][pt2][3])}; }
#pragma unroll SSD_LT_UNROLL
            for (int lt = 0; lt < 4; ++lt) { f32x4 y0 = {0.f, 0.f, 0.f, 0.f}, y1 = y0;
#pragma unroll
                for (int kk = 0; kk < 4; ++kk) { const LAS bf16* cp = Cs + (16 * lt + fr) * 136 + 32 * kk + 4 * fq; const u32x2 c0 = *(const LAS u32x2*)cp, c1 = *(const LAS u32x2*)(cp + 16);
                    const bf16x8 Bc = __builtin_bit_cast(bf16x8, (u32x4){c0.x, c0.y, c1.x, c1.y});
                    const bf16x8 A0 = __builtin_bit_cast(bf16x8, (u32x4){hp[kk][0][0].x, hp[kk][0][0].y, hp[kk][0][1].x, hp[kk][0][1].y}), A1 = __builtin_bit_cast(bf16x8, (u32x4){hp[kk][1][0].x, hp[kk][1][0].y, hp[kk][1][1].x, hp[kk][1][1].y});
                    y0 = MFMA16(A0, Bc, y0); y1 = MFMA16(A1, Bc, y1); }
                const int l = 16 * lt + fr; const float e = FAh[128 + l]; y0 = y0 * e; y1 = y1 * e;
#pragma unroll
                for (int ks = 0; ks < 2; ++ks) { const bf16x8 Bm = *(const LAS bf16x8*)(MMh + (16 * lt + fr) * 72 + 32 * ks + 8 * fq);
                    const bf16x8 A0 = *(const LAS bf16x8*)(XTh + (32 * ph + fr) * 72 + 32 * ks + 8 * fq), A1 = *(const LAS bf16x8*)(XTh + (32 * ph + 16 + fr) * 72 + 32 * ks + 8 * fq);
                    y0 = MFMA16(A0, Bm, y0); y1 = MFMA16(A1, Bm, y1); }
                float ss = 0.f;
                if (!smp || l < TS) { bf16* zp = ZB + (seqbase + t0 + l) * DI + head * 64 + 32 * ph + 4 * fq; const u32x2 z0 = zpre[lt][0], z1 = zpre[lt][1];
                    const float zf[8] = {bflo(z0.x), bfhi(z0.x), bflo(z0.y), bfhi(z0.y), bflo(z1.x), bfhi(z1.x), bflo(z1.y), bfhi(z1.y)};
#pragma unroll
                    for (int r = 0; r < 4; ++r) { y0[r] = y0[r] * zf[r] * sigmoidf_(zf[r]); y1[r] = y1[r] * zf[4 + r] * sigmoidf_(zf[4 + r]); ss += y0[r] * y0[r] + y1[r] * y1[r]; }
                    *(u32x2*)zp = (u32x2){pk2(y0[0], y0[1]), pk2(y0[2], y0[3])}; *(u32x2*)(zp + 16) = (u32x2){pk2(y1[0], y1[1]), pk2(y1[2], y1[3])}; }
                ss += __shfl_xor(ss, 16); ss += __shfl_xor(ss, 32);
                if (fq == 0) NS[wid * 64 + l] = ss; }
            ypend = t0;
            }
        }
        if (!(DIS & 16)) { const float cd = __expf(acl);
#pragma unroll
            for (int nt = 0; nt < 8; ++nt) { st[nt][0] = st[nt][0] * cd; st[nt][1] = st[nt][1] * cd; }
#pragma unroll
            for (int ks = 0; ks < 2; ++ks) { const f32x4 w0 = *(const LAS f32x4*)(FAh + 192 + 32 * ks + 8 * fq), w1 = *(const LAS f32x4*)(FAh + 192 + 32 * ks + 8 * fq + 4);
                bf16x8 Bx[2];
#pragma unroll
                for (int pt2 = 0; pt2 < 2; ++pt2) { const u32x4 x = *(const LAS u32x4*)(XTh + (32 * ph + 16 * pt2 + fr) * 72 + 32 * ks + 8 * fq);
                    Bx[pt2] = __builtin_bit_cast(bf16x8, (u32x4){pk2(bflo(x.x) * w0[0], bfhi(x.x) * w0[1]), pk2(bflo(x.y) * w0[2], bfhi(x.y) * w0[3]), pk2(bflo(x.z) * w1[0], bfhi(x.z) * w1[1]), pk2(bflo(x.w) * w1[2], bfhi(x.w) * w1[3])}); }
#pragma unroll
                for (int nt = 0; nt < 8; ++nt) { const bf16x8 An = *(const LAS bf16x8*)(BT + (16 * nt + fr) * 72 + 32 * ks + 8 * fq); st[nt][0] = MFMA16(An, Bx[0], st[nt][0]); st[nt][1] = MFMA16(An, Bx[1], st[nt][1]); if (nt & 1) __builtin_amdgcn_sched_barrier(0); } } }
        __syncthreads();
    }
    SSD_YFIN();
#undef SSD_YFIN
    float* dst = nullptr;
    if (mode == 0) { dst = SEGST + (((size_t)b * 8 + seg) * NHS + head) * 8192; if (lane == 0 && ph == 0) SEGDEC[(b * 8 + seg) * NHS + head] = expf(decsum); }
    else if (smp) dst = a.out + O_SS + ((size_t)b * NHS + head) * 8192;
    else if (seg == 7) dst = a.out + O_SP + ((size_t)b * NHS + head) * 8192;
    if (dst) {
#pragma unroll
        for (int nt = 0; nt < 8; ++nt)
#pragma unroll
            for (int pt2 = 0; pt2 < 2; ++pt2) *(f32x4*)(dst + (32 * ph + 16 * pt2 + fr) * 128 + 16 * nt + 4 * fq) = st[nt][pt2];
    }
#undef SSD_PF
    __syncthreads();
}
__device__ __forceinline__ void phase_ssd_b(const Args& a) {
    float* SEGST = segst_ptr(a); const float* SEGDEC = (const float*)(a.ws + WS_SEGDEC);
    const int n = NBP * NHS * 8192;
    for (int e = blockIdx.x * 512 + threadIdx.x; e < n; e += gridDim.x * 512) { const int b = e / (NHS * 8192), rem = e % (NHS * 8192), head = rem / 8192; float H = 0.f;
#pragma unroll
        for (int s = 0; s < 8; ++s) { const size_t idx = ((size_t)b * 8 + s) * NHS * 8192 + rem; const float loc = s < 7 ? SEGST[idx] : 0.f; SEGST[idx] = H; H = H * SEGDEC[(b * 8 + s) * NHS + head] + loc; } }
}

#ifndef ATT_THRL
#define ATT_THRL 60
#endif
template <bool SMP> __device__ __forceinline__ void attn_unit(const Args& a, LAS unsigned char* lds, const int b, const int h, const int qb) {
    const int tid = threadIdx.x, lane = tid & 63, r32 = lane & 31, hi = lane >> 5, wid = __builtin_amdgcn_readfirstlane(tid >> 6);
    bf16* QB = (bf16*)(a.ws + WS_BIG); const bf16* KB = QB + (size_t)MT * DM; const bf16* VB = KB + (size_t)MT * DM;
    bf16* OB = QB + (size_t)3 * MT * DM;
    if (SMP) { QB = (bf16*)(a.ws + WS_QS) - (size_t)MP * DM; KB = (const bf16*)(a.ws + WS_KS) - (size_t)MP * DM; VB = (const bf16*)(a.ws + WS_VS) - (size_t)MP * DM; }
    LAS bf16* Ks = (LAS bf16*)lds; LAS bf16* VT = (LAS bf16*)(lds + 18432); LAS float* CBs = (LAS float*)(lds + 36864);
    const int NT = SMP ? (SKV + 63) / 64 : 4 * qb + 4;
    const bool active = SMP ? (wid == 0) : true;
    const size_t qrow0 = SMP ? (size_t)MP + (size_t)b * TS : (size_t)b * TP + (size_t)qb * 256 + wid * 32;
    const int qpos0 = SMP ? PAST : qb * 256 + wid * 32;
    const float* CUM = SMP ? (const float*)(a.ws + WS_CUMS) + (size_t)b * SKV * 16 + h : (const float*)(a.ws + WS_CUMP) + (size_t)b * TP * 16 + h;
    bf16x8 qr[4];
#pragma unroll
    for (int d0 = 0; d0 < 4; ++d0) qr[d0] = active ? *(const bf16x8*)(QB + (qrow0 + r32) * DM + h * 64 + 16 * d0 + 8 * hi) : (bf16x8){0, 0, 0, 0, 0, 0, 0, 0};
    float mrun = -1e30f, lrun = 0.f; f32x16 o0, o1;
#pragma unroll
    for (int r = 0; r < 16; ++r) { o0[r] = 0.f; o1[r] = 0.f; }
    const int srow = tid >> 3, sch = tid & 7;
    u32x4 kreg, vreg; float breg = 0.f;
#define ATT_LOAD(t) do { const int kv0_ = 64 * (t); \
        if (!SMP) { const size_t ro = ((size_t)b * TP + kv0_ + srow) * DM + h * 64 + sch * 8; kreg = *(const u32x4*)(KB + ro); vreg = *(const u32x4*)(VB + ro); if (tid < 64) breg = -CUM[(size_t)(kv0_ + tid) * 16] * LOG2E; } \
        else if (kv0_ < PAST) { const size_t ro = (((size_t)b * PAST + kv0_ + srow) * NH + h) * 64 + sch * 8; const f32x4 k0 = *(const f32x4*)(a.cache_k + ro), k1 = *(const f32x4*)(a.cache_k + ro + 4), v0 = *(const f32x4*)(a.cache_v + ro), v1 = *(const f32x4*)(a.cache_v + ro + 4); \
            kreg = pack8(k0, k1); vreg = pack8(v0, v1); if (tid < 64) breg = -CUM[(size_t)(kv0_ + tid) * 16] * LOG2E; } \
        else { if (srow < TS) { const size_t ro = ((size_t)MP + (size_t)b * TS + srow) * DM + h * 64 + sch * 8; kreg = *(const u32x4*)(KB + ro); vreg = *(const u32x4*)(VB + ro); } else { kreg = (u32x4){0u, 0u, 0u, 0u}; vreg = kreg; } \
            if (tid < 64) breg = tid < TS ? -CUM[(size_t)(kv0_ + tid) * 16] * LOG2E : 0.f; } } while (0)
#define ATT_STORE(buf) do { *(LAS u32x4*)(Ks + (buf) * 4608 + srow * 72 + sch * 8) = kreg; LAS bf16* vt_ = VT + (buf) * 4608 + (sch * 8) * 72 + srow; \
        vt_[0] = (bf16)(vreg.x & 0xffffu); vt_[72] = (bf16)(vreg.x >> 16); vt_[144] = (bf16)(vreg.y & 0xffffu); vt_[216] = (bf16)(vreg.y >> 16); \
        vt_[288] = (bf16)(vreg.z & 0xffffu); vt_[360] = (bf16)(vreg.z >> 16); vt_[432] = (bf16)(vreg.w & 0xffffu); vt_[504] = (bf16)(vreg.w >> 16); \
        if (tid < 64) CBs[(buf) * 64 + tid] = breg; } while (0)
    ATT_LOAD(0); ATT_STORE(0); __syncthreads();
    for (int t = 0; t < NT; ++t) {
        const int buf = t & 1, kv0 = 64 * t;
        if (t + 1 < NT) ATT_LOAD(t + 1);
        if (active && kv0 <= qpos0 + 31) {
            const LAS bf16* kb = Ks + buf * 4608; const LAS bf16* vb = VT + buf * 4608; const LAS float* cb = CBs + buf * 64;
            f32x16 p0, p1;
#pragma unroll
            for (int r = 0; r < 16; ++r) { p0[r] = 0.f; p1[r] = 0.f; }
#pragma unroll
            for (int d0 = 0; d0 < 4; ++d0) { const bf16x8 a0 = *(const LAS bf16x8*)(kb + r32 * 72 + 16 * d0 + 8 * hi), a1 = *(const LAS bf16x8*)(kb + (32 + r32) * 72 + 16 * d0 + 8 * hi);
                p0 = MFMA32(a0, qr[d0], p0); p1 = MFMA32(a1, qr[d0], p1); }
#pragma unroll
            for (int gq = 0; gq < 4; ++gq) { const f32x4 b0 = *(const LAS f32x4*)(cb + 8 * gq + 4 * hi), b1 = *(const LAS f32x4*)(cb + 32 + 8 * gq + 4 * hi);
#pragma unroll
                for (int i = 0; i < 4; ++i) { p0[4 * gq + i] += b0[i]; p1[4 * gq + i] += b1[i]; } }
            if (kv0 + 63 > qpos0) { const int q = qpos0 + r32;
#pragma unroll
                for (int r = 0; r < 16; ++r) { const int kv = kv0 + (r & 3) + 8 * (r >> 2) + 4 * hi; if (kv > q) p0[r] = -INFINITY; if (kv + 32 > q) p1[r] = -INFINITY; } }
            float mx = fmaxf(p0[0], p1[0]);
#pragma unroll
            for (int r = 1; r < 16; ++r) mx = fmaxf(mx, fmaxf(p0[r], p1[r]));
            mx = fmaxf(mx, __shfl_xor(mx, 32));
            const float mnew = fmaxf(mrun, mx), alpha = __builtin_amdgcn_exp2f(mrun - mnew); mrun = mnew;
            float sum = 0.f;
#pragma unroll
            for (int r = 0; r < 16; ++r) { p0[r] = __builtin_amdgcn_exp2f(p0[r] - mnew); p1[r] = __builtin_amdgcn_exp2f(p1[r] - mnew); sum += p0[r] + p1[r]; }
            lrun = lrun * alpha + sum;
#pragma unroll
            for (int r = 0; r < 16; ++r) { o0[r] *= alpha; o1[r] *= alpha; }
            u32x4 pw[2][2];
#pragma unroll
            for (int hf = 0; hf < 2; ++hf) { pw[0][hf] = (u32x4){pk2(p0[8 * hf], p0[8 * hf + 1]), pk2(p0[8 * hf + 2], p0[8 * hf + 3]), pk2(p0[8 * hf + 4], p0[8 * hf + 5]), pk2(p0[8 * hf + 6], p0[8 * hf + 7])};
                pw[1][hf] = (u32x4){pk2(p1[8 * hf], p1[8 * hf + 1]), pk2(p1[8 * hf + 2], p1[8 * hf + 3]), pk2(p1[8 * hf + 4], p1[8 * hf + 5]), pk2(p1[8 * hf + 6], p1[8 * hf + 7])}; }
#pragma unroll
            for (int kt = 0; kt < 2; ++kt)
#pragma unroll
                for (int hf = 0; hf < 2; ++hf) { const bf16x8 pb = __builtin_bit_cast(bf16x8, pw[kt][hf]);
                    { const LAS bf16* vp = vb + r32 * 72 + 32 * kt + 16 * hf + 4 * hi; const s16x4 lo = *(const LAS s16x4*)vp, h4 = *(const LAS s16x4*)(vp + 8);
                      const bf16x8 av = {lo[0], lo[1], lo[2], lo[3], h4[0], h4[1], h4[2], h4[3]}; o0 = MFMA32(av, pb, o0); }
                    { const LAS bf16* vp = vb + (32 + r32) * 72 + 32 * kt + 16 * hf + 4 * hi; const s16x4 lo = *(const LAS s16x4*)vp, h4 = *(const LAS s16x4*)(vp + 8);
                      const bf16x8 av = {lo[0], lo[1], lo[2], lo[3], h4[0], h4[1], h4[2], h4[3]}; o1 = MFMA32(av, pb, o1); } }
        }
        if (t + 1 < NT) ATT_STORE(buf ^ 1);
        __syncthreads();
    }
    if (active) { const float lt = lrun + __shfl_xor(lrun, 32), inv = 1.f / lt; bf16* orow = OB + (qrow0 + r32) * DM + h * 64;
#pragma unroll
        for (int gq = 0; gq < 4; ++gq) { u32x2 w0, w1; w0.x = pk2(o0[4 * gq] * inv, o0[4 * gq + 1] * inv); w0.y = pk2(o0[4 * gq + 2] * inv, o0[4 * gq + 3] * inv);
            w1.x = pk2(o1[4 * gq] * inv, o1[4 * gq + 1] * inv); w1.y = pk2(o1[4 * gq + 2] * inv, o1[4 * gq + 3] * inv);
            *(u32x2*)(orow + 8 * gq + 4 * hi) = w0; *(u32x2*)(orow + 32 + 8 * gq + 4 * hi) = w1; } }
#undef ATT_LOAD
#undef ATT_STORE
}
__device__ __forceinline__ void phase_attention(const Args& a, LAS unsigned char* lds, char* lds_gen) {
    const attn_body::AttnTensors AT{(const attn_body::bf16*)(a.ws + WS_BIG), (const attn_body::bf16*)(a.ws + WS_BIG) + (size_t)MT * DM, (const attn_body::bf16*)(a.ws + WS_BIG) + (size_t)2 * MT * DM,
                                    (attn_body::bf16*)(a.ws + WS_BIG) + (size_t)3 * MT * DM, (const float*)(a.ws + WS_CUMP)};
    const attn_body::StaticOrder S((int)gridDim.x, (int)blockIdx.x);
    attn_body::attn_phase<attn_body::StaticOrder>(lds_gen, AT, S);
    for (int u = blockIdx.x; u < NBS * NH; u += gridDim.x) attn_unit<true>(a, lds, u >> 4, u & 15, 0);
}

struct SampleOrder {
    int pn;
    __device__ __forceinline__ bool next(int i, pg8::Unit& u) const { if (i > 0 || pn < 0) return false; u.pm = MP / 256; u.pn = pn; return true; }
    __device__ __forceinline__ void a_ready(const pg8::Unit&) const {}
    __device__ __forceinline__ void done(const pg8::Unit&) const {}
};
constexpr int N_PHASES = 14;
__global__ void __launch_bounds__(512, 2) fox_ssd_fwd(Args a) {
    extern __shared__ __attribute__((aligned(16))) unsigned char lds_raw[];
    LAS unsigned char* lds = (LAS unsigned char*)lds_raw;
    const int lo = a.ph_lo, hi = a.ph_hi, G = gridDim.x, bx = blockIdx.x, tid = threadIdx.x;
#ifndef REPMASK
#define REPMASK 0
#endif
#ifndef PHMASK
#define PHMASK 0x3fff
#endif
#define IN(k) (((PHMASK >> (k)) & 1) && lo <= (k) && (k) < hi)
#ifndef FAST_BAR
#define FAST_BAR 1
#endif
#define SEAM(k) do { if (IN(k) && IN((k) + 1)) { if (a.coop) { if (!FAST_BAR || ((k) == 0 && a.pad != 0)) cg::this_grid().sync(); else xcd_barrier(xbar); } } } while (0)
    XcdBarrier xbar; xbar.bar = (unsigned*)a.ws; xbar.x = 0; xbar.st = nullptr;
    if (FAST_BAR && a.coop) { volatile LAS unsigned* stw = (volatile LAS unsigned*)(lds + 139264); if (tid < 2) stw[tid] = 0u; __syncthreads(); xbar = xcd_barrier_post((unsigned*)a.ws, stw); }
    bf16* WIN = (bf16*)(a.ws + WS_WIN); bf16* XN = (bf16*)(a.ws + WS_XN); bf16* BIG = (bf16*)(a.ws + WS_BIG); bf16* SG = (bf16*)(a.ws + WS_SG);
    bf16* QB = BIG; bf16* KB = BIG + (size_t)MT * DM; bf16* VB = KB + (size_t)MT * DM; bf16* TMP = VB + (size_t)MT * DM; bf16* SGA = SG; bf16* SGS = SG + (size_t)MT * DM;
    bf16* Z = (bf16*)(a.out + O_Y);
    if (IN(0)) for (int rep_ = 0; rep_ <= ((REPMASK >> 0) & 1); ++rep_) phase_prologue(a);
    SEAM(0);
    if (IN(1)) for (int rep_ = 0; rep_ <= ((REPMASK >> 1) & 1); ++rep_) { EpiP1 E{Z, BIG, (float*)(a.ws + WS_LOGF), (float*)(a.ws + WS_DT), a.out, a.b_f, a.dt_bias}; run_gemm(lds, XN, WIN, 25 * 256, DM, E);
        { const int spn = (int)bx - (G - 20); SampleOrder SO{(G == 256 && spn >= 0) ? spn : -1};
          EpiP3 ES{(bf16*)(a.ws + WS_QS) - (size_t)MP * DM, (bf16*)(a.ws + WS_KS) - (size_t)MP * DM, (bf16*)(a.ws + WS_VS) - (size_t)MP * DM, (bf16*)(a.ws + WS_SGAS) - (size_t)MP * DM, (bf16*)(a.ws + WS_SGSS) - (size_t)MP * DM, a.out, a.q_norm_w, a.k_norm_w};
          pg8::Gemm gs{XN, WIN + (size_t)25 * 256 * DM, MT, 20 * 256, DM};
          pg8::gemm_phase<EpiP3, SampleOrder, true, true>(lds, gs, SO, ES); } }
    SEAM(1);
    if (IN(2)) for (int rep_ = 0; rep_ <= ((REPMASK >> 2) & 1); ++rep_) {
        phase_bc_conv(a, 1, (G > NBP * 7 * 8) ? -1 : (int)bx);
        if (G <= NBP * 7 * 8) { const int nC = NBP * 16 + NBS * 5; for (int it = G - 1 - bx; it < nC; it += G) cumsum_item(a, lds, it); }
    }
    SEAM(2);
    if (IN(3)) {
        const int nA = NBP * 7 * 8;
        for (int rep = 0; rep <= ((REPMASK >> 3) & 1); ++rep)
        for (int it = bx; it < nA; it += G) { const int g = it & 7, r = it >> 3; ssd_item(a, lds, 0, 0, r / 7, r % 7, g); }
        if (G > nA && bx >= nA) { phase_bc_conv(a, 0, (int)bx - nA); const int nC = NBP * 16 + NBS * 5; for (int it = bx - nA; it < nC; it += G - nA) cumsum_item(a, lds, it); }

    }
    SEAM(3);
    if (IN(5)) {
        const int nP = NBP * 8 * 8, nS = NBS * 8;
        for (int rep = 0; rep <= ((REPMASK >> 5) & 1); ++rep)
        for (int it = bx; it < nP + nS; it += G) { if (it < nP) { const int g = it & 7, r = it >> 3; ssd_item(a, lds, 1, 0, r >> 3, r & 7, g); } else { const int r = it - nP; ssd_item(a, lds, 1, 1, r >> 3, 0, r & 7); } }
    }
    SEAM(5);
    if (IN(7)) cumsum_fixup(a, lds);
    if (IN(7)) for (int rep_ = 0; rep_ <= ((REPMASK >> 7) & 1); ++rep_) { EpiP3 E{QB, KB, VB, SGA, SGS, a.out, a.q_norm_w, a.k_norm_w}; run_gemm(lds, XN, WIN + (size_t)25 * 256 * DM, 20 * 256, DM, E, MP); }
    SEAM(7);
    if (IN(8)) { for (int rep = 0; rep <= ((REPMASK >> 8) & 1); ++rep) phase_attention(a, lds, (char*)lds_raw); }
    SEAM(8);
    if (IN(9)) for (int rep_ = 0; rep_ <= ((REPMASK >> 9) & 1); ++rep_) { EpiGate<0> E{SGA, nullptr, VB}; run_gemm(lds, TMP, (const bf16*)(a.ws + WS_WPA), DM, DM, E, MP); mini_gemm<0>(a, lds, TMP, (const bf16*)(a.ws + WS_WPA), DM, (const bf16*)(a.ws + WS_SGAS) - (size_t)MP * DM, nullptr, VB, nullptr, nullptr); }
    if (IN(10)) for (int rep_ = 0; rep_ <= ((REPMASK >> 10) & 1); ++rep_) { EpiGate<1> E{SGS, VB, KB}; run_gemm(lds, Z, (const bf16*)(a.ws + WS_WPB), DM, DI, E, MP); mini_gemm<1>(a, lds, Z, (const bf16*)(a.ws + WS_WPB), DI, (const bf16*)(a.ws + WS_SGSS) - (size_t)MP * DM, VB, KB, nullptr, nullptr); }
    SEAM(10);
    if (IN(11)) for (int rep_ = 0; rep_ <= ((REPMASK >> 11) & 1); ++rep_) { EpiRes E{a.x_prompt, a.x_sample, a.out, 1, XN, a.norm2_w, (float*)(a.ws + WS_LOGF)}; run_gemm(lds, KB, (const bf16*)(a.ws + WS_WOUT), DM, DM, E, MP); mini_gemm<2>(a, lds, KB, (const bf16*)(a.ws + WS_WOUT), DM, nullptr, nullptr, nullptr, XN, (float*)(a.ws + WS_LOGF)); }
    SEAM(11);
    if (IN(12)) for (int rep_ = 0; rep_ <= ((REPMASK >> 12) & 1); ++rep_) { EpiRelu2 E{BIG, FF, (const float*)(a.ws + WS_LOGF)}; run_gemm(lds, XN, (const bf16*)(a.ws + WS_WUP), FF, DM, E); }
    SEAM(12);
    if (IN(13)) { EpiRes E{nullptr, nullptr, a.out, 0, nullptr, nullptr, nullptr}; run_gemm(lds, BIG, (const bf16*)(a.ws + WS_WDN), DM, FF, E, MP); mini_gemm<3>(a, lds, BIG, (const bf16*)(a.ws + WS_WDN), FF, nullptr, nullptr, nullptr, nullptr, nullptr); }
#undef IN
#undef SEAM
}

extern "C" void kernel_launch(void* const* d_in, const int* in_sizes, int n_in, void* d_out, int out_size, void* d_ws, size_t ws_size, hipStream_t stream) {
    static int grid = 0;
    if (grid == 0) {
        if (n_in != 24 || (size_t)out_size != O_END || ws_size < WS_END) { fprintf(stderr, "kernel_launch: unexpected shapes: n_in %d out %d ws %zu\n", n_in, out_size, ws_size); grid = -1; return; }
        int dev = 0, cus = 0, per_cu = 0;
        if (hipGetDevice(&dev) != hipSuccess || hipDeviceGetAttribute(&cus, hipDeviceAttributeMultiprocessorCount, dev) != hipSuccess) { grid = -1; return; }
        if (hipFuncSetAttribute((const void*)fox_ssd_fwd, hipFuncAttributeMaxDynamicSharedMemorySize, LDS_BYTES) != hipSuccess) { fprintf(stderr, "kernel_launch: hipFuncSetAttribute failed\n"); grid = -1; return; }
        if (hipOccupancyMaxActiveBlocksPerMultiprocessor(&per_cu, (const void*)fox_ssd_fwd, 512, LDS_BYTES) != hipSuccess || per_cu < 1) per_cu = 1;
        (void)hipGetLastError();
        grid = cus * per_cu;
    }
    if (grid < 0) return;
    Args a{};
    const float** pp = (const float**)&a;
    for (int i = 0; i < 24; ++i) pp[i] = (const float*)d_in[i];
    a.out = (float*)d_out; a.ws = (unsigned char*)d_ws;
#if MK_MULTI
    for (int p = 0; p < N_PHASES; ++p) { a.ph_lo = p; a.ph_hi = p + 1; a.coop = 0; hipLaunchKernelGGL(fox_ssd_fwd, dim3(grid), dim3(512), LDS_BYTES, stream, a); }
#else
    a.ph_lo = 0; a.ph_hi = N_PHASES; a.coop = 1;
    (void)hipMemsetAsync(d_ws, 0, 16384, stream);
    void* args[] = {&a};
    hipError_t e = hipLaunchCooperativeKernel((const void*)fox_ssd_fwd, dim3(grid), dim3(512), args, LDS_BYTES, stream);
    if (e != hipSuccess) fprintf(stderr, "cooperative launch failed: %s (grid %d)\n", hipGetErrorString(e), grid);
#endif
}
```
